# Optimizing an MI355X kernel written in HIP

```python
import math
import jax, jax.numpy as jnp
from jax import lax
import numpy as np

D_MODEL = 1024
BATCH = 4
SEQ = 8192
DEPTH = 1

MIX_WIDTH = D_MODEL
GLA_WIDTH = MIX_WIDTH // 2
GMLP_WIDTH = MIX_WIDTH - GLA_WIDTH
GLA_HEADS = 4
GLA_DV = GLA_WIDTH // GLA_HEADS
GLA_DK = GLA_DV // 2
GLA_KEY_WIDTH = GLA_HEADS * GLA_DK
GLA_LOWRANK = 16
GLA_TAU = 16.0
GLA_CHUNK = 64
GMLP_GROUPS = 4
GMLP_GROUP_DIM = GMLP_WIDTH // GMLP_GROUPS
GMLP_CHUNK = 128
D_FF = int(math.ceil(8 * D_MODEL / 3 / 256) * 256)
EPS = 1e-6

PROJ_SIZES = [GLA_KEY_WIDTH, GLA_KEY_WIDTH, GLA_WIDTH, GLA_WIDTH,
              GLA_LOWRANK, GLA_LOWRANK, 2 * GMLP_WIDTH]
PROJ_WIDTH = sum(PROJ_SIZES)
PROJ_SPLITS = [int(v) for v in np.cumsum(PROJ_SIZES)[:-1]]

kernel_name = "hybrid_gla_gmlp_encoder_block"


def rmsnorm(x, g):
    xf = x.astype(jnp.float32)
    y = xf * lax.rsqrt(jnp.mean(xf * xf, axis=-1, keepdims=True) + EPS)
    return (y * g.astype(jnp.float32)).astype(x.dtype)


def layernorm(x, g, b):
    xf = x.astype(jnp.float32)
    mu = jnp.mean(xf, axis=-1, keepdims=True)
    xc = xf - mu
    y = xc * lax.rsqrt(jnp.mean(xc * xc, axis=-1, keepdims=True) + EPS)
    return (y * g.astype(jnp.float32) + b.astype(jnp.float32)).astype(x.dtype)


def gla_one_direction(q, k, v, log_a):
    B, S, H, DK = q.shape
    DV = v.shape[-1]
    C = GLA_CHUNK
    N = S // C
    f32 = jnp.float32
    q = q.astype(f32).reshape(B, N, C, H, DK)
    k = k.astype(f32).reshape(B, N, C, H, DK)
    v = v.astype(f32).reshape(B, N, C, H, DV)
    b = jnp.cumsum(log_a.astype(f32).reshape(B, N, C, H, DK), axis=2)
    b_last = b[:, :, -1]
    q_dec = q * jnp.exp(b)
    k_dec = k * jnp.exp(-b)
    k_to_end = k * jnp.exp(b_last[:, :, None] - b)
    scores = jnp.einsum('bnthd,bnshd->bnhts', q_dec, k_dec)
    tril = jnp.tril(jnp.ones((C, C), dtype=bool))
    scores = jnp.where(tril, scores, 0.0)
    o_intra = jnp.einsum('bnhts,bnshv->bnthv', scores, v)
    d_state = jnp.einsum('bnshd,bnshv->bnhdv', k_to_end, v)
    chunk_decay = jnp.exp(b_last)

    def step(state, inp):
        ds, dec = inp
        return dec[..., None] * state + ds, state

    state0 = jnp.zeros((B, H, DK, DV), f32)
    _, states_before = lax.scan(step, state0,
                                (jnp.moveaxis(d_state, 1, 0), jnp.moveaxis(chunk_decay, 1, 0)))
    states_before = jnp.moveaxis(states_before, 0, 1)
    o_inter = jnp.einsum('bnthd,bnhdv->bnthv', q_dec, states_before)
    return (o_intra + o_inter).reshape(B, S, H, DV)


def gla_mixer(h_q, h_k, h_v, h_g, lr_f, lr_b, w_decay_f, b_decay_f, w_decay_b, b_decay_b, gla_norm_g):
    B, S, _ = h_q.shape
    f32 = jnp.float32
    q = h_q.reshape(B, S, GLA_HEADS, GLA_DK) * (GLA_DK ** -0.5)
    k = h_k.reshape(B, S, GLA_HEADS, GLA_DK)
    v = h_v.reshape(B, S, GLA_HEADS, GLA_DV)
    la_f = (jax.nn.log_sigmoid((lr_f @ w_decay_f + b_decay_f).astype(f32)) / GLA_TAU
            ).reshape(B, S, GLA_HEADS, GLA_DK)
    la_b = (jax.nn.log_sigmoid((lr_b @ w_decay_b + b_decay_b).astype(f32)) / GLA_TAU
            ).reshape(B, S, GLA_HEADS, GLA_DK)
    o_fwd = gla_one_direction(q, k, v, la_f)
    o_bwd = jnp.flip(gla_one_direction(jnp.flip(q, 1), jnp.flip(k, 1), jnp.flip(v, 1),
                                       jnp.flip(la_b, 1)), 1)
    o = o_fwd + o_bwd
    o = o * lax.rsqrt(jnp.mean(o * o, axis=-1, keepdims=True) + EPS)
    o = o.reshape(B, S, GLA_WIDTH) * gla_norm_g.astype(f32)
    return (o * jax.nn.silu(h_g.astype(f32))).astype(h_q.dtype)


def gmlp_mixer(h_uv, ln_g, ln_b, w_spatial, b_spatial):
    B, S, _ = h_uv.shape
    z = jax.nn.gelu(h_uv, approximate=False)
    u, v = jnp.split(z, 2, axis=-1)
    v = layernorm(v, ln_g, ln_b)
    v = v.reshape(B, S // GMLP_CHUNK, GMLP_CHUNK, GMLP_GROUPS, GMLP_GROUP_DIM)
    s = jnp.einsum('gij,bnjgc->bnigc', w_spatial, v) + b_spatial.T[None, None, :, :, None]
    return u * s.reshape(B, S, GMLP_WIDTH)


def setup_inputs(seed: int = 0) -> dict:
    key = jax.random.key(seed)
    ks = jax.random.split(key, 20)
    L = DEPTH
    nrm = lambda k, shape, fan_in: jax.random.normal(k, shape, jnp.float32) * (fan_in ** -0.5)
    gain = lambda k, shape: 1.0 + 0.02 * jax.random.normal(k, shape, jnp.float32)
    small = lambda k, shape: 0.01 * jax.random.normal(k, shape, jnp.float32)
    return {
        "x": jax.random.normal(ks[0], (BATCH, SEQ, D_MODEL), jnp.float32),
        "norm1_g": gain(ks[1], (L, D_MODEL)),
        "w_in": nrm(ks[2], (L, D_MODEL, PROJ_WIDTH), D_MODEL),
        "w_decay_f": nrm(ks[3], (L, GLA_LOWRANK, GLA_KEY_WIDTH), GLA_LOWRANK),
        "b_decay_f": small(ks[4], (L, GLA_KEY_WIDTH)),
        "w_decay_b": nrm(ks[5], (L, GLA_LOWRANK, GLA_KEY_WIDTH), GLA_LOWRANK),
        "b_decay_b": small(ks[6], (L, GLA_KEY_WIDTH)),
        "gla_norm_g": gain(ks[7], (L, GLA_WIDTH)),
        "gmlp_ln_g": gain(ks[8], (L, GMLP_WIDTH)),
        "gmlp_ln_b": small(ks[9], (L, GMLP_WIDTH)),
        "w_spatial": nrm(ks[10], (L, GMLP_GROUPS, GMLP_CHUNK, GMLP_CHUNK), GMLP_CHUNK),
        "b_spatial": gain(ks[11], (L, GMLP_GROUPS, GMLP_CHUNK)),
        "w_out": nrm(ks[12], (L, MIX_WIDTH, D_MODEL), MIX_WIDTH),
        "norm2_g": gain(ks[13], (L, D_MODEL)),
        "w_gate": nrm(ks[14], (L, D_MODEL, D_FF), D_MODEL),
        "w_up": nrm(ks[15], (L, D_MODEL, D_FF), D_MODEL),
        "w_down": nrm(ks[16], (L, D_FF, D_MODEL), D_FF),
        "final_norm_g": gain(ks[17], (D_MODEL,)),
    }


def reference(x, norm1_g, w_in, w_decay_f, b_decay_f, w_decay_b, b_decay_b, gla_norm_g,
              gmlp_ln_g, gmlp_ln_b, w_spatial, b_spatial, w_out, norm2_g, w_gate, w_up,
              w_down, final_norm_g):
    for l in range(DEPTH):
        h = rmsnorm(x, norm1_g[l])
        p = h @ w_in[l]
        h_q, h_k, h_v, h_g, lr_f, lr_b, h_uv = jnp.split(p, PROJ_SPLITS, axis=-1)
        y_a = gla_mixer(h_q, h_k, h_v, h_g, lr_f, lr_b, w_decay_f[l], b_decay_f[l],
                        w_decay_b[l], b_decay_b[l], gla_norm_g[l])
        y_b = gmlp_mixer(h_uv, gmlp_ln_g[l], gmlp_ln_b[l], w_spatial[l], b_spatial[l])
        x = x + jnp.concatenate([y_a, y_b.astype(y_a.dtype)], axis=-1) @ w_out[l]
        h2 = rmsnorm(x, norm2_g[l])
        x = x + (jax.nn.silu(h2 @ w_gate[l]) * (h2 @ w_up[l])) @ w_down[l]
    return rmsnorm(x, final_norm_g)
```

```cpp
#include <hip/hip_runtime.h>
#include <hip/hip_cooperative_groups.h>
#include <cstdio>
#include <cstdint>
namespace pg8 {
#define PG8_LAS __attribute__((address_space(3)))
typedef unsigned short bf16_t;
typedef short bf16x8 __attribute__((ext_vector_type(8)));
typedef float f32x4 __attribute__((ext_vector_type(4)));
typedef unsigned u32x4 __attribute__((ext_vector_type(4)));
constexpr int BM = 256, BK = 64, HALF = 128, HTB = HALF * BK * 2  , STAGE_BYTES = 8 * HTB, NXCD = 8, WGM = 8;

__host__ __device__ __forceinline__ int lds_byte(int r, int c) { const int st = (r >> 4) * 2 + (c >> 5), rr = r & 15, cc = c & 31, ob = rr * 64 + cc * 2; return st * 1024 + (ob ^ (((ob >> 9) & 1) << 5)); }
__host__ __device__ __forceinline__ void stage_rc(int b, int& R, int& C) { const int st = b / 1024, sb = b % 1024, swz = sb ^ (((sb >> 9) & 1) << 5); R = (st >> 1) * 16 + swz / 64; C = (st & 1) * 32 + (swz % 64) / 2; }
__host__ __device__ __forceinline__ int perm32(int rho) { const int n = rho >> 4, i = rho & 15; return 8 * (i >> 2) + 4 * n + (i & 3); }

struct Unit { int pm, pn; };
struct Gemm { const bf16_t* A; const bf16_t* Bt; int M, N, K; };

struct StaticOrder {
    int nM, nN, nwg, G, c;
    __host__ __device__ void init(int M, int N, int G_, int c_) { nM = M / BM; nN = N / BM; nwg = nM * nN; G = G_; c = c_; }
    __host__ __device__ bool next(int i, Unit& u) const {
        const long L = (long)i * G + c; if (L >= nwg) return false;
        int wgid = (int)L; { const int q = nwg / NXCD, r = nwg % NXCD, xcd = wgid % NXCD, off = wgid / NXCD; wgid = (xcd < r ? xcd * (q + 1) : r * (q + 1) + (xcd - r) * q) + off; }
        const int nig = WGM * nN, gid = wgid / nig, fm = gid * WGM, gsz = (nM - fm) < WGM ? (nM - fm) : WGM;
        u.pm = fm + ((wgid % nig) % gsz); u.pn = (wgid % nig) / gsz; return true;
    }
    __device__ __forceinline__ void a_ready(const Unit&) const {}
    __device__ __forceinline__ void done(const Unit&) const {}
};
__device__ __forceinline__ unsigned cvt_pk_bf16(float lo, float hi) { unsigned r; asm volatile("v_cvt_pk_bf16_f32 %0, %1, %2" : "=v"(r) : "v"(lo), "v"(hi)); return r; }
typedef float f32x2 __attribute__((ext_vector_type(2)));
__device__ __forceinline__ f32x2 gelu_pk(f32x2 v) {
    const f32x2 av = __builtin_elementwise_abs(v), d = av * 0.2316418882f + 1.0f;
    f32x2 t; t.x = __builtin_amdgcn_rcpf(d.x); t.y = __builtin_amdgcn_rcpf(d.y);
    f32x2 q = t * 0.5307027145f + (-0.7265760135f); q = q * t + 0.7107068705f; q = q * t + (-0.142248368f); q = q * t + 0.127414796f; q = q * t;
    const f32x2 s = (v * v) * (-0.72134752044f);
    f32x2 e; e.x = __builtin_amdgcn_exp2f(s.x); e.y = __builtin_amdgcn_exp2f(s.y);
    const f32x2 m = v * (q * e), r = v - m;
    f32x2 o; o.x = v.x < 0.f ? m.x : r.x; o.y = v.y < 0.f ? m.y : r.y; return o;
}
template <class Epi, class Sched, bool ALIGN_EPI = false, bool SP2 = false, int NARROW_PN = -1  >
__device__ __forceinline__ void gemm_phase(PG8_LAS unsigned char* lds, const Gemm g, const Sched& S, const Epi& E) {
    const int tid = threadIdx.x, wid = __builtin_amdgcn_readfirstlane(tid >> 6), lane = tid & 63, wr = wid >> 2, wc = wid & 3, fr = lane & 15, fq = lane >> 4;
    const int K = g.K, nt = K / BK;
    unsigned voffA[2], voffB[2];
#pragma unroll
    for (int i = 0; i < 2; ++i) { int R, C; stage_rc(tid * 16 + i * 8192, R, C); const int Rb = Epi::PERM ? ((R & ~31) + perm32(R & 31)) : R;
        voffA[i] = (unsigned)(R * K + C) * 2u; voffB[i] = (unsigned)(Rb * K + C) * 2u; }
    const size_t kstep = (size_t)(BK * 2);
    const size_t hstep = (size_t)HALF * K * 2;
    const size_t tstep = 2 * hstep;
    const unsigned ldsw = (unsigned)wid * 1024u;
    const int aoff = lds_byte(wr * 64 + fr, fq * 8), boff = lds_byte(wc * 32 + fr, fq * 8);
#define PG8_SA(b, h) (((b) * 2 + (h)) * HTB)
#define PG8_SB(b, h) ((4 + (b) * 2 + (h)) * HTB)
#define PG8_STAGE(bufoff, gbase, voff) do { _Pragma("unroll") for (int _i = 0; _i < 2; ++_i) \
        __builtin_amdgcn_global_load_lds((const unsigned*)((const char*)(gbase) + (voff)[_i]), (PG8_LAS unsigned*)(lds + (bufoff) + ldsw + _i * 8192), 16, 0, 0); } while (0)
#define PG8_LDA(dst, b, h) do { _Pragma("unroll") for (int m = 0; m < 4; ++m) _Pragma("unroll") for (int k = 0; k < 2; ++k) dst[m][k] = *(const PG8_LAS bf16x8*)(lds + PG8_SA(b, h) + aoff + m * 2048 + k * 1024); } while (0)
#define PG8_LDB(dst, b, h) do { _Pragma("unroll") for (int n = 0; n < 2; ++n) _Pragma("unroll") for (int k = 0; k < 2; ++k) dst[n][k] = *(const PG8_LAS bf16x8*)(lds + PG8_SB(b, h) + boff + n * 2048 + k * 1024); } while (0)
#define PG8_MMA(ai, bj, At, Bt) do { __builtin_amdgcn_s_setprio(1); _Pragma("unroll") for (int m = 0; m < 4; ++m) _Pragma("unroll") for (int n = 0; n < 2; ++n) _Pragma("unroll") for (int k = 0; k < 2; ++k) \
        acc[ai][bj][m][n] = __builtin_amdgcn_mfma_f32_16x16x32_bf16(Bt[n][k], At[m][k], acc[ai][bj][m][n], 0, 0, 0); __builtin_amdgcn_s_setprio(0); } while (0)
#define PG8_WAIT_V(n) asm volatile("s_waitcnt vmcnt(" #n ")" ::: "memory")
#define PG8_WAIT_L(n) asm volatile("s_waitcnt lgkmcnt(" #n ")" ::: "memory")
#define PG8_BAR __builtin_amdgcn_s_barrier()
#define PG8_SCHED __builtin_amdgcn_sched_barrier(0)
    Unit cur, nxt; int ui = 0;
    if (!S.next(0, cur)) return;
    f32x4 acc[2][2][4][2];
#pragma unroll
    for (int a = 0; a < 2; ++a)
#pragma unroll
        for (int b = 0; b < 2; ++b)
#pragma unroll
            for (int m = 0; m < 4; ++m)
#pragma unroll
                for (int n = 0; n < 2; ++n) acc[a][b][m][n] = (f32x4){0.f, 0.f, 0.f, 0.f};
    bf16x8 At[4][2], B0[2][2], B1[2][2];
    const char* cA = (const char*)g.A + (size_t)cur.pm * tstep; const char* cB = (const char*)g.Bt + (size_t)cur.pn * tstep;
    S.a_ready(cur);
    if constexpr (SP2) {
        PG8_STAGE(PG8_SB(0, 0), cB, voffB); PG8_STAGE(PG8_SB(0, 1), cB + hstep, voffB); PG8_STAGE(PG8_SA(0, 0), cA, voffA); PG8_STAGE(PG8_SA(0, 1), cA + hstep, voffA);
        if (wr == 1) PG8_BAR;
        PG8_WAIT_V(2); PG8_BAR;
        PG8_STAGE(PG8_SB(1, 0), cB + kstep, voffB); PG8_STAGE(PG8_SA(1, 0), cA + kstep, voffA); PG8_STAGE(PG8_SB(1, 1), cB + hstep + kstep, voffB);
        PG8_WAIT_V(6); PG8_BAR;
    } else {
        PG8_STAGE(PG8_SB(0, 0), cB, voffB); PG8_STAGE(PG8_SA(0, 0), cA, voffA); PG8_STAGE(PG8_SB(0, 1), cB + hstep, voffB); PG8_STAGE(PG8_SA(0, 1), cA + hstep, voffA);
        if (wr == 1) PG8_BAR;
        PG8_WAIT_V(4); PG8_BAR;
        PG8_STAGE(PG8_SB(1, 0), cB + kstep, voffB); PG8_STAGE(PG8_SA(1, 0), cA + kstep, voffA); PG8_STAGE(PG8_SB(1, 1), cB + hstep + kstep, voffB);
        PG8_WAIT_V(6); PG8_BAR;
    }
    for (;;) {
        const bool has_next = S.next(ui + 1, nxt); const bool narrow = (NARROW_PN >= 0) && (cur.pn == NARROW_PN);
        const char* nA = has_next ? (const char*)g.A + (size_t)nxt.pm * tstep : cA; const char* nB = has_next ? (const char*)g.Bt + (size_t)nxt.pn * tstep : cB;
        for (int t = 0; t < nt; t += 2) {
            const bool last = (t == nt - 2);
            const char* a1 = cA + (size_t)(t + 1) * kstep;
            const char* a2 = last ? nA : cA + (size_t)(t + 2) * kstep; const char* b2 = last ? nB : cB + (size_t)(t + 2) * kstep;
            const char* a3 = a2 + kstep; const char* b3 = b2 + kstep;
            if (last && has_next) S.a_ready(nxt);
            if constexpr (SP2) {
            PG8_LDB(B0, 0, 0); PG8_LDB(B1, 0, 1); PG8_SCHED; PG8_LDA(At, 0, 0); PG8_STAGE(PG8_SA(1, 1), a1 + hstep, voffA);
            PG8_WAIT_V(8); PG8_WAIT_L(0); PG8_BAR; PG8_MMA(0, 0, At, B0); if (NARROW_PN < 0 || !narrow) PG8_MMA(0, 1, At, B1); PG8_BAR; PG8_SCHED;
            PG8_LDA(At, 0, 1); PG8_STAGE(PG8_SB(0, 0), b2, voffB); PG8_STAGE(PG8_SB(0, 1), b2 + hstep, voffB); PG8_STAGE(PG8_SA(0, 0), a2, voffA);
            PG8_WAIT_V(8); PG8_WAIT_L(0); PG8_BAR; PG8_MMA(1, 0, At, B0); if (NARROW_PN < 0 || !narrow) PG8_MMA(1, 1, At, B1); PG8_BAR; PG8_SCHED;
            PG8_LDB(B0, 1, 0); PG8_LDB(B1, 1, 1); PG8_SCHED; PG8_LDA(At, 1, 0); PG8_STAGE(PG8_SA(0, 1), a2 + hstep, voffA);
            PG8_WAIT_V(8); PG8_WAIT_L(0); PG8_BAR; PG8_MMA(0, 0, At, B0); if (NARROW_PN < 0 || !narrow) PG8_MMA(0, 1, At, B1); PG8_BAR; PG8_SCHED;
            PG8_LDA(At, 1, 1); PG8_STAGE(PG8_SB(1, 0), b3, voffB); PG8_STAGE(PG8_SB(1, 1), b3 + hstep, voffB); PG8_STAGE(PG8_SA(1, 0), a3, voffA);
            PG8_WAIT_V(8); PG8_WAIT_L(0); PG8_BAR; PG8_MMA(1, 0, At, B0); if (NARROW_PN < 0 || !narrow) PG8_MMA(1, 1, At, B1); PG8_BAR; PG8_SCHED;
            } else {
            PG8_LDB(B0, 0, 0); PG8_SCHED; PG8_LDA(At, 0, 0); PG8_STAGE(PG8_SA(1, 1), a1 + hstep, voffA);
            PG8_WAIT_L(8); PG8_BAR; PG8_WAIT_L(0); PG8_MMA(0, 0, At, B0); PG8_BAR; PG8_SCHED;
            PG8_LDB(B1, 0, 1); PG8_STAGE(PG8_SB(0, 0), b2, voffB);
            PG8_BAR; PG8_WAIT_L(0); PG8_MMA(0, 1, At, B1); PG8_BAR;
            PG8_LDA(At, 0, 1); PG8_STAGE(PG8_SA(0, 0), a2, voffA);
            PG8_BAR; PG8_WAIT_L(0); PG8_MMA(1, 0, At, B0); PG8_BAR; PG8_SCHED;
            PG8_STAGE(PG8_SB(0, 1), b2 + hstep, voffB);
            PG8_WAIT_V(6); PG8_BAR; PG8_MMA(1, 1, At, B1); PG8_BAR;
            PG8_LDB(B0, 1, 0); PG8_SCHED; PG8_LDA(At, 1, 0); PG8_STAGE(PG8_SA(0, 1), a2 + hstep, voffA);
            PG8_WAIT_L(8); PG8_BAR; PG8_WAIT_L(0); PG8_MMA(0, 0, At, B0); PG8_BAR; PG8_SCHED;
            PG8_LDB(B1, 1, 1); PG8_STAGE(PG8_SB(1, 0), b3, voffB);
            PG8_BAR; PG8_WAIT_L(0); PG8_MMA(0, 1, At, B1); PG8_BAR;
            PG8_LDA(At, 1, 1); PG8_STAGE(PG8_SA(1, 0), a3, voffA);
            PG8_BAR; PG8_WAIT_L(0); PG8_MMA(1, 0, At, B0); PG8_BAR; PG8_SCHED;
            PG8_STAGE(PG8_SB(1, 1), b3 + hstep, voffB);
            PG8_WAIT_V(6); PG8_BAR; PG8_MMA(1, 1, At, B1); PG8_BAR;
            }
        }
        if constexpr (ALIGN_EPI) { if (wr == 0) PG8_BAR; }
        if constexpr (!Epi::AFTER_DRAIN) { E(acc, cur, wr, wc, fr, fq); S.done(cur); }
        if (!has_next) break;
#pragma unroll
        for (int a = 0; a < 2; ++a)
#pragma unroll
            for (int b = 0; b < 2; ++b)
#pragma unroll
                for (int m = 0; m < 4; ++m)
#pragma unroll
                    for (int n = 0; n < 2; ++n) acc[a][b][m][n] = (f32x4){0.f, 0.f, 0.f, 0.f};
        cur = nxt; cA = nA; cB = nB; ++ui;
        if constexpr (ALIGN_EPI) { if (wr == 1) PG8_BAR; }
    }
    PG8_WAIT_V(0);
    if constexpr (!ALIGN_EPI) { if (wr == 0) PG8_BAR; }
    PG8_BAR;
    if constexpr (Epi::AFTER_DRAIN) { E.fused(acc, cur, wr, wc, fr, fq, lds, wid, lane); S.done(cur); }
#undef PG8_SA
#undef PG8_SB
#undef PG8_STAGE
#undef PG8_LDA
#undef PG8_LDB
#undef PG8_MMA
#undef PG8_WAIT_V
#undef PG8_WAIT_L
#undef PG8_BAR
#undef PG8_SCHED
}
}

namespace cg = cooperative_groups;
#define LAS __attribute__((address_space(3)))
#define DI __device__ __forceinline__
typedef unsigned short bf16;
typedef short bf16x8 __attribute__((ext_vector_type(8)));
typedef float f32x4 __attribute__((ext_vector_type(4)));
typedef unsigned u32x4 __attribute__((ext_vector_type(4)));
typedef unsigned u32x2 __attribute__((ext_vector_type(2)));

#ifndef MK_N_LAUNCHES
#define MK_N_LAUNCHES 1
#endif
#define PROBE_DUP 0
#define DUP(bit) for (int rep_ = 0; rep_ < (((PROBE_DUP) >> (bit)) & 1) + 1; ++rep_)
constexpr int NPH = 10;
constexpr int NTOK = 32768, DM = 1024, PWSRC = 2592, N1 = 2816, PHS = 384, PUS = 1024, DFF = 2816, N3 = 5632;
constexpr float EPS = 1e-6f;
constexpr size_t MiB = 1u << 20;
constexpr size_t WS_SSQ1 = 0, WS_SSQ2 = 128 * 1024, WS_XSC = 256 * 1024, WS_WSB = 1 * MiB, WS_RSW = 1 * MiB + 256 * 1024, WS_BT1 = 2 * MiB, WS_BT2 = 8 * MiB, WS_BT3 = 10 * MiB, WS_BT4 = 21 * MiB,
                 WS_DEC = 27 * MiB, WS_LR = 28 * MiB, WS_H = 32 * MiB  , WS_ST = 96 * MiB  ,
                 WS_P = 160 * MiB  , WS_Y = 336 * MiB  , WS_END = 400 * MiB;
constexpr size_t WS_BAR = 512 * 1024, WS_CNT = WS_BAR + 16384, WS_BAR_BYTES = 16384 + 32768;
constexpr size_t WS_PU = WS_P + (size_t)4 * NTOK * PHS * 2;
constexpr int LDS_BYTES = 151552;

typedef float f32x2_t __attribute__((ext_vector_type(2))); typedef __bf16 bf16x2_t __attribute__((ext_vector_type(2)));
DI unsigned pk2(float lo, float hi) { f32x2_t v = {lo, hi}; bf16x2_t b = __builtin_convertvector(v, bf16x2_t); return __builtin_bit_cast(unsigned, b); }
DI float bflo(unsigned u) { return __uint_as_float(u << 16); }
DI float bfhi(unsigned u) { return __uint_as_float(u & 0xffff0000u); }
DI float silu_f(float g) { return g * __builtin_amdgcn_rcpf(1.0f + __expf(-g)); }
DI float logsig(float z) { return fminf(z, 0.f) - __logf(1.0f + __expf(-fabsf(z))); }
DI void lds_barrier() { asm volatile("s_waitcnt lgkmcnt(0)" ::: "memory"); __builtin_amdgcn_s_barrier(); asm volatile("" ::: "memory"); }
DI bf16x8 lds_frag(LAS const unsigned char* p) { return *(LAS const bf16x8*)p; }
DI f32x4 mfma16(bf16x8 a, bf16x8 b, f32x4 c) { return __builtin_amdgcn_mfma_f32_16x16x32_bf16(a, b, c, 0, 0, 0); }

#define XB_TMO      128
#define XB_XCNT(j)  (256  + 64 * (j))
#define XB_XSUB(j)  (1280 + 64 * (j))
#define XB_XGEN(j)  (2304 + 64 * (j))
#define XB_TOP      3328
#define XB_TOPGEN   3392
#define XCD_BAR_WORDS 3456
#define XB_SPIN_CAP (1u << 18)

__device__ __forceinline__ unsigned xb_ld(unsigned* p)              { return __hip_atomic_load(p, __ATOMIC_RELAXED, __HIP_MEMORY_SCOPE_AGENT); }
__device__ __forceinline__ unsigned xb_add(unsigned* p, unsigned v) { return __hip_atomic_fetch_add(p, v, __ATOMIC_RELAXED, __HIP_MEMORY_SCOPE_AGENT); }
__device__ __forceinline__ unsigned xb_xcc_id() { return (unsigned)__builtin_amdgcn_s_getreg((3 << 11) | 20) & 0xFu; }
#define XB_SPIN(cond, bar) do { unsigned _sp = 0; while (cond) { __builtin_amdgcn_s_sleep(1); \
    if ((++_sp & 255u) == 0u) { if (xb_ld(&(bar)[XB_TMO])) break; if (_sp > XB_SPIN_CAP) { atomicAdd(&(bar)[XB_TMO], 1u); break; } } } } while (0)

struct XcdBarrier {
    unsigned* bar; unsigned x;
    volatile LAS unsigned* st;
};

__device__ __forceinline__ XcdBarrier xcd_barrier_post(unsigned* bar, volatile LAS unsigned* st) {
    XcdBarrier b; b.bar = bar; b.x = xb_xcc_id(); b.st = st;
    if (threadIdx.x == 0) (void)xb_add(&bar[XB_XCNT(b.x)], 1u);
    return b;
}
__device__ __forceinline__ void xcd_barrier_complete(unsigned* bar, unsigned x, unsigned& nloc, unsigned& nx) {
    const unsigned G = gridDim.x * gridDim.y * gridDim.z;
    unsigned sum, cnt, mine, sp = 0u;
    for (;;) {
        sum = 0u; cnt = 0u; mine = 0u;
#pragma unroll
        for (unsigned j = 0; j < 16; ++j) { const unsigned c = xb_ld(&bar[XB_XCNT(j)]); sum += c; cnt += (c > 0u) ? 1u : 0u; mine = (j == x) ? c : mine; }
        if (sum == G) break;
        __builtin_amdgcn_s_sleep(1);
        if ((++sp & 255u) == 0u) { if (xb_ld(&bar[XB_TMO])) break; if (sp > XB_SPIN_CAP) { atomicAdd(&bar[XB_TMO], 1u); break; } }
    }
    nloc = mine > 0u ? mine : 1u; nx = cnt > 0u ? cnt : 1u;
}

__device__ __forceinline__ void xcd_barrier(const XcdBarrier& b) {
    asm volatile("s_waitcnt vmcnt(0)" ::: "memory");
    __syncthreads();
    if (threadIdx.x == 0) {
        unsigned* bar = b.bar;
        __builtin_amdgcn_s_waitcnt(0);
        unsigned nloc = b.st[0], nx = b.st[1];
        if (nloc == 0u) { xcd_barrier_complete(bar, b.x, nloc, nx); b.st[0] = nloc; b.st[1] = nx; }
        const unsigned old = xb_add(&bar[XB_XSUB(b.x)], 1u);
        const unsigned gen = old / nloc;
        if (old + 1u == (gen + 1u) * nloc) {
            __builtin_amdgcn_fence(__ATOMIC_RELEASE, "agent");
            asm volatile("s_waitcnt vmcnt(0)" ::: "memory");
            const unsigned og = xb_add(&bar[XB_TOP], 1u);
            const unsigned tg = og / nx;
            if (og + 1u == (tg + 1u) * nx) xb_add(&bar[XB_TOPGEN], 1u);
            else XB_SPIN(xb_ld(&bar[XB_TOPGEN]) == tg, bar);
            __builtin_amdgcn_fence(__ATOMIC_ACQUIRE, "agent");
            xb_add(&bar[XB_XGEN(b.x)], 1u);
            asm volatile("s_waitcnt vmcnt(0)" ::: "memory");
        } else {
            XB_SPIN(xb_ld(&bar[XB_XGEN(b.x)]) == gen, bar);
            __builtin_amdgcn_fence(__ATOMIC_ACQUIRE, "agent");
            asm volatile("s_waitcnt vmcnt(0)" ::: "memory");
        }
    }
    __syncthreads();
}

struct OrderG1 { pg8::StaticOrder full, all; bool special; int c;
    __device__ void init(int G, int c_) { special = (G == 256); c = c_; full.init(NTOK, 2560, G, c_); all.init(NTOK, N1, G, c_); }
    __device__ bool next(int i, pg8::Unit& u) const { if (!special) return all.next(i, u); if (i < 5) return full.next(i, u); if (i == 5 && c < 128) { u.pm = c; u.pn = 10; return true; } return false; }
    __device__ __forceinline__ void a_ready(const pg8::Unit&) const {}
    __device__ __forceinline__ void done(const pg8::Unit&) const {}
};
struct Args { const float* in[18]; float* out; unsigned char* ws; int ph_lo, ph_hi; };

struct Epi1 {
    static constexpr bool PERM = true, AFTER_DRAIN = false;
    bf16* P; bf16* PU; bf16* LR;
    DI void operator()(const f32x4 (&acc)[2][2][4][2], const pg8::Unit& u, int wr, int wc, int fr, int fq) const {
        const int row0 = u.pm * 256 + wr * 64 + fr;
        if (u.pn == 10) {
            if (wc == 0) {
#pragma unroll
                for (int ai = 0; ai < 2; ++ai)
#pragma unroll
                    for (int m = 0; m < 4; ++m) { bf16* p = LR + (size_t)(row0 + ai * 128 + m * 16) * 64 + (fq >> 1) * 32 + (fq & 1) * 8; u32x4 hv, lv;
#pragma unroll
                        for (int e = 0; e < 4; ++e) { const float x0 = acc[ai][0][m][e >> 1][(e & 1) * 2], x1 = acc[ai][0][m][e >> 1][(e & 1) * 2 + 1]; const unsigned hp = pk2(x0, x1);
                            hv[e] = hp; lv[e] = pk2(x0 - bflo(hp), x1 - bfhi(hp)); }
                        *(u32x4*)p = hv; *(u32x4*)(p + 16) = lv; }
            }
            return;
        }
        const bool act = u.pn >= 6;
        const int col0 = u.pn * 256 + wc * 32 + 8 * fq;
#pragma unroll
        for (int ai = 0; ai < 2; ++ai)
#pragma unroll
            for (int m = 0; m < 4; ++m) { const int row = row0 + ai * 128 + m * 16;
#pragma unroll
                for (int bj = 0; bj < 2; ++bj) { const int col = col0 + bj * 128;
                    bf16* dst = act ? PU + (size_t)row * PUS + (col - 1536) : P + ((size_t)(col / 384) * NTOK + row) * PHS + col % 384;
                    f32x4 v0 = acc[ai][bj][m][0], v1 = acc[ai][bj][m][1];
                    if (act) { pg8::f32x2 a = pg8::gelu_pk((pg8::f32x2){v0[0], v0[1]}), b = pg8::gelu_pk((pg8::f32x2){v0[2], v0[3]}), c = pg8::gelu_pk((pg8::f32x2){v1[0], v1[1]}), d = pg8::gelu_pk((pg8::f32x2){v1[2], v1[3]});
                        v0 = (f32x4){a.x, a.y, b.x, b.y}; v1 = (f32x4){c.x, c.y, d.x, d.y}; }
                    u32x4 w; w.x = pk2(v0[0], v0[1]); w.y = pk2(v0[2], v0[3]); w.z = pk2(v1[0], v1[1]); w.w = pk2(v1[2], v1[3]);
                    *(u32x4*)dst = w; } }
    }
};
template <int MODE> struct EpiRes {
    static constexpr bool PERM = false, AFTER_DRAIN = false;
    const float* xsc; const bf16* baseb; const float* aux  ; bf16* ob; float* ssq;
    DI void operator()(const f32x4 (&acc)[2][2][4][2], const pg8::Unit& u, int wr, int wc, int fr, int fq) const {
        const int row0 = u.pm * 256 + wr * 64 + fr, col0 = u.pn * 256 + wc * 32 + 4 * fq;
        f32x4 gi[2][2];
        if (MODE == 0) {
#pragma unroll
            for (int bj = 0; bj < 2; ++bj)
#pragma unroll
                for (int n = 0; n < 2; ++n) { const f32x4 gq = *(const f32x4*)(aux + col0 + bj * 128 + n * 16); gi[bj][n] = (f32x4){1.0f / gq[0], 1.0f / gq[1], 1.0f / gq[2], 1.0f / gq[3]}; } }
#pragma unroll
        for (int ai = 0; ai < 2; ++ai) {
            u32x2 bw[4][2][2]; float sc[4];
#pragma unroll
            for (int m = 0; m < 4; ++m) { if (MODE == 0) sc[m] = xsc[row0 + ai * 128 + m * 16];
#pragma unroll
                for (int bj = 0; bj < 2; ++bj)
#pragma unroll
                    for (int n = 0; n < 2; ++n) bw[m][bj][n] = *(const u32x2*)(baseb + (size_t)(row0 + ai * 128 + m * 16) * DM + col0 + bj * 128 + n * 16); }
#pragma unroll
            for (int m = 0; m < 4; ++m) { const int row = row0 + ai * 128 + m * 16; float s = 0.f;
#pragma unroll
                for (int bj = 0; bj < 2; ++bj)
#pragma unroll
                    for (int n = 0; n < 2; ++n) { const size_t o = (size_t)row * DM + col0 + bj * 128 + n * 16; const u32x2 w = bw[m][bj][n];
                        f32x4 v = (f32x4){bflo(w.x), bfhi(w.x), bflo(w.y), bfhi(w.y)};
                        if (MODE == 0) v = v * sc[m] * gi[bj][n];
                        v = v + acc[ai][bj][m][n];
                        s += (v[0] * v[0] + v[1] * v[1]) + (v[2] * v[2] + v[3] * v[3]);
                        if (MODE == 0) { u32x2 wo; wo.x = pk2(v[0], v[1]); wo.y = pk2(v[2], v[3]); *(u32x2*)(ob + o) = wo; } else *(f32x4*)((float*)aux + o) = v; }
                s += __shfl_xor(s, 16); s += __shfl_xor(s, 32);
                if (fq == 0) atomicAdd(ssq + row, s); }
        }
    }
};
struct EpiFinal {
    static constexpr bool PERM = false, AFTER_DRAIN = false;
    const bf16* base; float* out; float* ssq; unsigned* cnt; const float* gf;
    DI void operator()(f32x4 (&acc)[2][2][4][2], const pg8::Unit& u, int wr, int wc, int fr, int fq) const {
        const int row0 = u.pm * 256 + wr * 64 + fr, col0 = u.pn * 256 + wc * 32 + 4 * fq;
        u32x2 bw[2][4][2][2];
#pragma unroll
        for (int ai = 0; ai < 2; ++ai)
#pragma unroll
            for (int m = 0; m < 4; ++m)
#pragma unroll
                for (int bj = 0; bj < 2; ++bj)
#pragma unroll
                    for (int n = 0; n < 2; ++n) bw[ai][m][bj][n] = *(const u32x2*)(base + (size_t)(row0 + ai * 128 + m * 16) * DM + col0 + bj * 128 + n * 16);
        f32x4 gv[2][2];
#pragma unroll
        for (int bj = 0; bj < 2; ++bj)
#pragma unroll
            for (int n = 0; n < 2; ++n) gv[bj][n] = *(const f32x4*)(gf + col0 + bj * 128 + n * 16);
#pragma unroll
        for (int ai = 0; ai < 2; ++ai)
#pragma unroll
            for (int m = 0; m < 4; ++m) { const int row = row0 + ai * 128 + m * 16; float s = 0.f;
#pragma unroll
                for (int bj = 0; bj < 2; ++bj)
#pragma unroll
                    for (int n = 0; n < 2; ++n) { const u32x2 w = bw[ai][m][bj][n]; const f32x4 v = (f32x4){bflo(w.x), bfhi(w.x), bflo(w.y), bfhi(w.y)} + acc[ai][bj][m][n]; acc[ai][bj][m][n] = v;
                        s += (v[0] * v[0] + v[1] * v[1]) + (v[2] * v[2] + v[3] * v[3]); }
                s += __shfl_xor(s, 16); s += __shfl_xor(s, 32);
                if (fq == 0) atomicAdd(ssq + row, s); }
        asm volatile("s_waitcnt vmcnt(0)" ::: "memory");
        unsigned* c = cnt + 64 * u.pm;
        if (fr == 0 && fq == 0) __hip_atomic_fetch_add(c, 1u, __ATOMIC_RELAXED, __HIP_MEMORY_SCOPE_AGENT);
        { unsigned sp = 0; while ((unsigned)__builtin_amdgcn_readfirstlane(__hip_atomic_load(c, __ATOMIC_RELAXED, __HIP_MEMORY_SCOPE_AGENT)) < 32u) { __builtin_amdgcn_s_sleep(2); if (++sp > (1u << 22)) break; } }
        float sv[8];
#pragma unroll
        for (int i = 0; i < 8; ++i) sv[i] = __hip_atomic_load(ssq + row0 + (i >> 2) * 128 + (i & 3) * 16, __ATOMIC_RELAXED, __HIP_MEMORY_SCOPE_AGENT);
#pragma unroll
        for (int ai = 0; ai < 2; ++ai)
#pragma unroll
            for (int m = 0; m < 4; ++m) { const int row = row0 + ai * 128 + m * 16; const float rs = rsqrtf(sv[ai * 4 + m] * (1.0f / 1024.0f) + EPS);
#pragma unroll
                for (int bj = 0; bj < 2; ++bj)
#pragma unroll
                    for (int n = 0; n < 2; ++n) *(f32x4*)(out + (size_t)row * DM + col0 + bj * 128 + n * 16) = acc[ai][bj][m][n] * rs * gv[bj][n]; }
    }
};
struct Epi3 {
    static constexpr bool PERM = true, AFTER_DRAIN = false;
    bf16* ACT; const float* ssq;
    DI void operator()(const f32x4 (&acc)[2][2][4][2], const pg8::Unit& u, int wr, int wc, int fr, int fq) const {
        const int row0 = u.pm * 256 + wr * 64 + fr, col0 = u.pn * 128 + wc * 32 + 8 * fq;
        float sv[8];
#pragma unroll
        for (int i = 0; i < 8; ++i) sv[i] = ssq[row0 + (i >> 2) * 128 + (i & 3) * 16];
#pragma unroll
        for (int ai = 0; ai < 2; ++ai)
#pragma unroll
            for (int m = 0; m < 4; ++m) { const int row = row0 + ai * 128 + m * 16; const float rs = rsqrtf(sv[ai * 4 + m] * (1.0f / 1024.0f) + EPS);
                float o[8];
#pragma unroll
                for (int n = 0; n < 2; ++n)
#pragma unroll
                    for (int e = 0; e < 4; ++e) o[n * 4 + e] = silu_f(acc[ai][0][m][n][e] * rs) * (acc[ai][1][m][n][e] * rs);
                u32x4 w; w.x = pk2(o[0], o[1]); w.y = pk2(o[2], o[3]); w.z = pk2(o[4], o[5]); w.w = pk2(o[6], o[7]);
                *(u32x4*)(ACT + (size_t)row * DFF + col0) = w; }
    }
};

DI void p0_item(const Args& A, int it, LAS float* scr, int tid) {
    int mat, ntile, kt;
    if (it < 704) { mat = 1; ntile = it >> 4; kt = it & 15; }
    else if (it < 960) { it -= 704; mat = 2; ntile = it >> 4; kt = it & 15; }
    else if (it < 2368) { it -= 960; mat = 3; ntile = it >> 4; kt = it & 15; }
    else { it -= 2368; mat = 4; ntile = it / 44; kt = it % 44; }
    const int kl = tid >> 3, n8 = tid & 7, nd = ntile * 64 + n8 * 8, k = kt * 64 + kl;
    const float* src = nullptr; int ldw = 0, sc = 0; float scale = 1.f; bf16* dst; int K = 1024;
    if (mat == 1) { ldw = PWSRC; dst = (bf16*)(A.ws + WS_BT1);
        if (nd < 1536) { const int hh = nd / 384, c = nd % 384; sc = c < 64 ? hh * 64 + c : (c < 128 ? 256 + hh * 64 + (c - 64) : (c < 256 ? 512 + hh * 128 + (c - 128) : 1024 + hh * 128 + (c - 256))); if (c < 64) scale = 0.125f; }
        else if (nd < 2560) sc = nd + 32; else if (nd < 2592) sc = nd - 2560 + 1536; else sc = -1;
        if (sc >= 0) src = A.in[2]; }
    else if (mat == 2) { ldw = 1024; dst = (bf16*)(A.ws + WS_BT2); sc = nd; src = A.in[12]; }
    else if (mat == 3) { ldw = DFF; dst = (bf16*)(A.ws + WS_BT3); const int tl = nd >> 8, r = nd & 255; if (r < 128) { src = A.in[14]; sc = tl * 128 + r; } else { src = A.in[15]; sc = tl * 128 + r - 128; } scale = A.in[13][k]; }
    else { ldw = 1024; dst = (bf16*)(A.ws + WS_BT4); sc = nd; src = A.in[16]; K = DFF; }
    f32x4 a = (f32x4){0.f, 0.f, 0.f, 0.f}, b = a;
    if (src) { const float* p = src + (size_t)k * ldw + sc; a = *(const f32x4*)p * scale; b = *(const f32x4*)(p + 4) * scale; }
    LAS float* w = scr + kl * 65 + n8 * 8;
    w[0] = a[0]; w[1] = a[1]; w[2] = a[2]; w[3] = a[3]; w[4] = b[0]; w[5] = b[1]; w[6] = b[2]; w[7] = b[3];
    __syncthreads();
    const int nl = tid >> 3, k8 = tid & 7; float v[8];
#pragma unroll
    for (int j = 0; j < 8; ++j) v[j] = scr[(k8 * 8 + j) * 65 + nl];
    u32x4 o; o.x = pk2(v[0], v[1]); o.y = pk2(v[2], v[3]); o.z = pk2(v[4], v[5]); o.w = pk2(v[6], v[7]);
    *(u32x4*)(dst + (size_t)(ntile * 64 + nl) * K + kt * 64 + k8 * 8) = o;
    __syncthreads();
}
DI void p0_prologue(const Args& A, LAS unsigned char* lds, int tid) {
    const int G = gridDim.x, bx = blockIdx.x, lane = tid & 63, wid = tid >> 6;
    for (int i = bx * 512 + tid; i < 65536; i += G * 512) ((float*)(A.ws + WS_SSQ1))[i] = 0.f;
    for (int i = bx * 512 + tid; i < 65536; i += G * 512) { ((bf16*)(A.ws + WS_WSB))[i] = (bf16)(pk2(A.in[10][i], 0.f) & 0xffffu); }
    for (int i = bx * 512 + tid; i < 512; i += G * 512) { const float* w = A.in[10] + (size_t)i * 128; float r = 0.f;
        for (int j = 0; j < 128; j += 4) { const f32x4 v = *(const f32x4*)(w + j); r += (v[0] + v[1]) + (v[2] + v[3]); }
        ((float*)(A.ws + WS_RSW))[i] = r; }
    for (int it = bx; it < 3072; it += G) p0_item(A, it, (LAS float*)lds, tid);
    const float* x = A.in[0]; const float* g1 = A.in[1]; bf16* H = (bf16*)(A.ws + WS_H);
    f32x4 gv[4];
#pragma unroll
    for (int j = 0; j < 4; ++j) gv[j] = *(const f32x4*)(g1 + lane * 4 + 256 * j);
    for (int row = bx * 8 + wid; row < NTOK; row += G * 8) {
        const float* xr = x + (size_t)row * DM; f32x4 v[4]; float s = 0.f;
#pragma unroll
        for (int j = 0; j < 4; ++j) { v[j] = *(const f32x4*)(xr + lane * 4 + 256 * j); s += (v[j][0] * v[j][0] + v[j][1] * v[j][1]) + (v[j][2] * v[j][2] + v[j][3] * v[j][3]); }
#pragma unroll
        for (int o = 1; o < 64; o <<= 1) s += __shfl_xor(s, o);
        const float rs = rsqrtf(s * (1.0f / 1024.0f) + EPS);
        if (lane == 0) ((float*)(A.ws + WS_XSC))[row] = sqrtf(s * (1.0f / 1024.0f) + EPS);
#pragma unroll
        for (int j = 0; j < 4; ++j) { const f32x4 y = v[j] * rs * gv[j]; u32x2 w; w.x = pk2(y[0], y[1]); w.y = pk2(y[2], y[3]); *(u32x2*)(H + (size_t)row * DM + lane * 4 + 256 * j) = w; }
    }
}

constexpr int GM_VTS = 136, GM_PART = (128 * GM_VTS + 16) * 2  , GM_LN = 4 * GM_PART;
static_assert(GM_LN + 4096 <= 151552 - 16, "gMLP LDS map");
DI void gmlp_phase(const Args& A, LAS unsigned char* lds, int tid) {
    const int lane = tid & 63, wid = tid >> 6, fr = lane & 15, fq = lane >> 4;
    const bf16* PU = (const bf16*)(A.ws + WS_PU); bf16* Y = (bf16*)(A.ws + WS_Y); const bf16* WS = (const bf16*)(A.ws + WS_WSB); const float* RSW = (const float*)(A.ws + WS_RSW);
    const float* bsp = A.in[11];
    LAS float* LN = (LAS float*)(lds + GM_LN);
    for (int unit = blockIdx.x; unit < 256; unit += gridDim.x) {
        const int tok0 = unit * 128, j = tid >> 2, part = tid & 3, irow = wid * 16 + fr;
        u32x4 w[16];
        { const bf16* p = PU + (size_t)(tok0 + j) * PUS + 512 + part * 128;
#pragma unroll
          for (int i = 0; i < 16; ++i) w[i] = *(const u32x4*)(p + i * 8); }
        bf16x8 wfn[4]; u32x2 uvn[8];
#define GM_LOADG(g_) do { _Pragma("unroll") for (int ks_ = 0; ks_ < 4; ++ks_) wfn[ks_] = *(const bf16x8*)(WS + (size_t)(g_) * 16384 + irow * 128 + ks_ * 32 + fq * 8); \
        _Pragma("unroll") for (int ct_ = 0; ct_ < 8; ++ct_) uvn[ct_] = *(const u32x2*)(PU + (size_t)(tok0 + irow) * PUS + (g_) * 128 + ct_ * 16 + 4 * fq); } while (0)
        lds_barrier();
        LN[tid] = A.in[8][tid]; LN[512 + tid] = A.in[9][tid];
        float sm = 0.f, sq = 0.f;
#pragma unroll
        for (int i = 0; i < 16; ++i)
#pragma unroll
            for (int e = 0; e < 4; ++e) { const float a = bflo(w[i][e]), b = bfhi(w[i][e]); sm += a + b; sq += a * a + b * b; }
        sm += __shfl_xor(sm, 1); sm += __shfl_xor(sm, 2); sq += __shfl_xor(sq, 1); sq += __shfl_xor(sq, 2);
        const float mean = sm * (1.0f / 512.0f), rstd = rsqrtf(fmaxf(sq * (1.0f / 512.0f) - mean * mean, 0.f) + EPS);
        LAS unsigned short* vt = (LAS unsigned short*)(lds + part * GM_PART) + j;
#pragma unroll
        for (int i = 0; i < 16; ++i)
#pragma unroll
            for (int e = 0; e < 4; ++e) { const unsigned pv = pk2((bflo(w[i][e]) - mean) * rstd, (bfhi(w[i][e]) - mean) * rstd); const int c = i * 8 + e * 2;
                vt[c * GM_VTS] = (unsigned short)(pv & 0xffffu); vt[(c + 1) * GM_VTS] = (unsigned short)(pv >> 16); }
        GM_LOADG(0);
        lds_barrier();
        for (int g = 0; g < 4; ++g) {
            bf16x8 wf[4]; u32x2 uv[8];
#pragma unroll
            for (int ks = 0; ks < 4; ++ks) wf[ks] = wfn[ks];
#pragma unroll
            for (int ct = 0; ct < 8; ++ct) uv[ct] = uvn[ct];
            if (g < 3) GM_LOADG(g + 1);
            const float bias = bsp[g * 128 + irow], rsw = RSW[g * 128 + irow];
#pragma unroll
            for (int ct = 0; ct < 8; ++ct) { f32x4 acc = (f32x4){0.f, 0.f, 0.f, 0.f};
#pragma unroll
                for (int ks = 0; ks < 4; ++ks) acc = mfma16(lds_frag(lds + g * GM_PART + ((ct * 16 + fr) * GM_VTS + ks * 32 + fq * 8) * 2), wf[ks], acc);
                const int c = ct * 16 + 4 * fq; const f32x4 lg = *(LAS const f32x4*)(LN + g * 128 + c), lb = *(LAS const f32x4*)(LN + 512 + g * 128 + c); const u32x2 uu = uv[ct];
                u32x2 o; o.x = pk2(bflo(uu.x) * (lg[0] * acc[0] + lb[0] * rsw + bias), bfhi(uu.x) * (lg[1] * acc[1] + lb[1] * rsw + bias));
                o.y = pk2(bflo(uu.y) * (lg[2] * acc[2] + lb[2] * rsw + bias), bfhi(uu.y) * (lg[3] * acc[3] + lb[3] * rsw + bias));
                *(u32x2*)(Y + (size_t)(tok0 + irow) * DM + 512 + g * 128 + c) = o; }
        }
#undef GM_LOADG
    }
}

constexpr int G_LR = 0, G_WD = 8192, G_BD = 16384, G_SEG = 16896, G_LA = 18944, G_A0 = 52224, RS72 = 72;
constexpr int GA_KTF = G_A0, GA_KTB = G_A0 + 9216, GA_VT = G_A0 + 18432;
constexpr int GC_QDF = G_A0, GC_QDB = G_A0 + 9216, GC_KDF = G_A0 + 18432, GC_KDB = G_A0 + 27648, GC_VT = G_A0 + 36864, GC_SS = GC_VT + 18432, GC_RS = GC_SS + 9216;
constexpr int GC_STF = 0, GC_STB = 132096;
static_assert(GC_RS + 512 <= 131072 && GC_STF + 18432 <= G_LA && GC_STB + 18432 <= 151552 - 16, "GLA LDS map");
struct DecayW { bf16x8 bh, bl; float bias; };
DI unsigned hi16(float x) { return pk2(x, 0.f) & 0xffffu; }
DI DecayW gla_decay_w(const Args& A, int h, int wid, int fr, int fq) {
    const int dir = wid >> 2, d = h * 64 + 16 * (wid & 3) + fr; const float* w = (dir ? A.in[5] : A.in[3]) + ((fq & 1) * 8) * 256 + d;
    DecayW o; unsigned hh[8], ll[8];
#pragma unroll
    for (int j = 0; j < 8; ++j) { const float x = w[j * 256]; hh[j] = hi16(x); ll[j] = (fq < 2) ? hi16(x - __uint_as_float(hh[j] << 16)) : 0u; }
    u32x4 a, b;
#pragma unroll
    for (int e = 0; e < 4; ++e) { a[e] = hh[2 * e] | (hh[2 * e + 1] << 16); b[e] = ll[2 * e] | (ll[2 * e + 1] << 16); }
    o.bh = __builtin_bit_cast(bf16x8, a); o.bl = __builtin_bit_cast(bf16x8, b); o.bias = (dir ? A.in[6] : A.in[4])[d];
    return o;
}
struct LrRows { bf16x8 v[4]; };
DI LrRows gla_load_lr(const bf16* LRg, int tok0, int wid, int fr, int fq) {
    LrRows o; const bf16* p = LRg + (size_t)(tok0 + fr) * 64 + (wid >> 2) * 32 + fq * 8;
#pragma unroll
    for (int tt = 0; tt < 4; ++tt) o.v[tt] = *(const bf16x8*)(p + tt * 1024);
    return o;
}
DI void gla_decay(LAS unsigned char* lds, const LrRows& L, const DecayW& W, int wid, int fr, int fq) {
    LAS float* LA = (LAS float*)(lds + G_LA); const int dir = wid >> 2, d = 16 * (wid & 3) + fr;
    float la[4][4], p[4][4], S[4], ex[4], tot[4];
#pragma unroll
    for (int tt = 0; tt < 4; ++tt) {
        const bf16x8 a1 = L.v[tt]; const bf16x8 a2 = (fq < 2) ? a1 : (bf16x8){0, 0, 0, 0, 0, 0, 0, 0};
        f32x4 z = (f32x4){0.f, 0.f, 0.f, 0.f};
        z = mfma16(a1, W.bh, z); z = mfma16(a2, W.bl, z);
#pragma unroll
        for (int r = 0; r < 4; ++r) la[tt][r] = logsig(z[r] + W.bias) * (1.0f / 16.0f);
        p[tt][0] = la[tt][0]; p[tt][1] = p[tt][0] + la[tt][1]; p[tt][2] = p[tt][1] + la[tt][2]; p[tt][3] = p[tt][2] + la[tt][3]; S[tt] = p[tt][3];
    }
#pragma unroll
    for (int tt = 0; tt < 4; ++tt) { const float s1 = __shfl_xor(S[tt], 16), s2 = __shfl_xor(S[tt], 32), s3 = __shfl_xor(s1, 32);
        tot[tt] = (S[tt] + s1) + (s2 + s3); ex[tt] = fq == 0 ? 0.f : (fq == 1 ? s1 : (fq == 2 ? s2 + s3 : s1 + s2 + s3)); }
    const float T = (tot[0] + tot[1]) + (tot[2] + tot[3]); float base = 0.f;
#pragma unroll
    for (int tt = 0; tt < 4; ++tt) {
#pragma unroll
        for (int r = 0; r < 4; ++r) { const float pre = base + ex[tt] + p[tt][r]; LA[(dir * 64 + 16 * tt + 4 * fq + r) * 65 + d] = dir ? (T - pre + la[tt][r]) : pre; }
        base += tot[tt]; }
    lds_barrier();
}
DI void gla_build_vt(const u32x4 a, const u32x4 b, LAS unsigned char* vtb, int tid) {
    const int sp = tid & 31, dvb = tid >> 5; LAS unsigned* vt = (LAS unsigned*)vtb;
#pragma unroll
    for (int e = 0; e < 4; ++e) { const int dv = dvb * 8 + 2 * e;
        vt[dv * (RS72 / 2) + sp] = (a[e] & 0xffffu) | (b[e] << 16);
        vt[(dv + 1) * (RS72 / 2) + sp] = (a[e] >> 16) | (b[e] & 0xffff0000u); }
}
DI size_t st_off(int dir, int b, int h, int n) { return ((size_t)((dir * 4 + b) * 4 + h) * 128 + n) * 8192; }
DI void gla_pass_a(const Args& A, LAS unsigned char* lds, int tid) {
    const int lane = tid & 63, wid = tid >> 6, fr = lane & 15, fq = lane >> 4;
    const bf16* P = (const bf16*)(A.ws + WS_P); bf16* ST = (bf16*)(A.ws + WS_ST); float* DEC = (float*)(A.ws + WS_DEC);
    LAS float* LA = (LAS float*)(lds + G_LA);
    const bf16* LRg = (const bf16*)(A.ws + WS_LR); int h_loaded = -1; DecayW dw; dw.bh = (bf16x8){0,0,0,0,0,0,0,0}; dw.bl = dw.bh; dw.bias = 0.f;
    const int sp = tid & 31, db = tid >> 5;
    LrRows lrn; u32x2 k0n, k1n; u32x4 van, vbn;
#define GA_LOAD(un) do { const int h_ = (un) & 3, tok_ = ((un) >> 2) * 64; lrn = gla_load_lr(LRg, tok_, wid, fr, fq); \
        const bf16* kp_ = P + ((size_t)h_ * NTOK + tok_ + 2 * sp) * PHS + 64 + db * 4; k0n = *(const u32x2*)kp_; k1n = *(const u32x2*)(kp_ + PHS); \
        const bf16* vp_ = P + ((size_t)h_ * NTOK + tok_ + 2 * sp) * PHS + 128 + db * 8; van = *(const u32x4*)vp_; vbn = *(const u32x4*)(vp_ + PHS); } while (0)
    if (blockIdx.x < 2048) GA_LOAD(blockIdx.x);
    for (int unit = blockIdx.x; unit < 2048; unit += gridDim.x) {
        const int h = unit & 3, cn = unit >> 2, b = cn >> 7, n = cn & 127;
        if (h != h_loaded) { dw = gla_decay_w(A, h, wid, fr, fq); h_loaded = h; }
        const LrRows lrc = lrn; const u32x2 k0 = k0n, k1 = k1n; const u32x4 va = van, vb = vbn;
        if (unit + (int)gridDim.x < 2048) GA_LOAD(unit + gridDim.x);
        gla_decay(lds, lrc, dw, wid, fr, fq);
        {
            const float kk0[4] = {bflo(k0.x), bfhi(k0.x), bflo(k0.y), bfhi(k0.y)}, kk1[4] = {bflo(k1.x), bfhi(k1.x), bflo(k1.y), bfhi(k1.y)};
#pragma unroll
            for (int dir = 0; dir < 2; ++dir) { LAS unsigned* kt = (LAS unsigned*)(lds + (dir ? GA_KTB : GA_KTF));
#pragma unroll
                for (int j = 0; j < 4; ++j) { const int d = db * 4 + j; const float be = LA[(dir * 64 + (dir ? 0 : 63)) * 65 + d];
                    const float e0 = __expf(be - LA[(dir * 64 + 2 * sp) * 65 + d]), e1 = __expf(be - LA[(dir * 64 + 2 * sp + 1) * 65 + d]);
                    kt[d * (RS72 / 2) + sp] = pk2(kk0[j] * e0, kk1[j] * e1); } }
            if (tid < 128) { const int dir = tid >> 6, d = tid & 63; DEC[((size_t)((dir * 4 + b) * 4 + h) * 128 + n) * 64 + d] = __expf(LA[(dir * 64 + (dir ? 0 : 63)) * 65 + d]); }
        }
        gla_build_vt(va, vb, lds + GA_VT, tid);
        lds_barrier();
        {
            const int dir = wid >> 2, dvt0 = (wid & 3) * 2; LAS const unsigned char* kt = lds + (dir ? GA_KTB : GA_KTF);
            bf16x8 yv[2][2];
#pragma unroll
            for (int dvi = 0; dvi < 2; ++dvi)
#pragma unroll
                for (int ks = 0; ks < 2; ++ks) yv[dvi][ks] = lds_frag(lds + GA_VT + (((dvt0 + dvi) * 16 + fr) * RS72 + ks * 32 + fq * 8) * 2);
            bf16* stp = ST + st_off(dir, b, h, n);
#pragma unroll
            for (int dkt = 0; dkt < 4; ++dkt) { const bf16x8 x0 = lds_frag(kt + ((dkt * 16 + fr) * RS72 + fq * 8) * 2), x1 = lds_frag(kt + ((dkt * 16 + fr) * RS72 + 32 + fq * 8) * 2);
#pragma unroll
                for (int dvi = 0; dvi < 2; ++dvi) { f32x4 acc = (f32x4){0.f, 0.f, 0.f, 0.f}; acc = mfma16(x0, yv[dvi][0], acc); acc = mfma16(x1, yv[dvi][1], acc);
                    u32x2 w; w.x = pk2(acc[0], acc[1]); w.y = pk2(acc[2], acc[3]);
                    *(u32x2*)(stp + ((dvt0 + dvi) * 16 + fr) * 64 + dkt * 16 + 4 * fq) = w; } }
        }
    }
    lds_barrier();
#undef GA_LOAD
}
DI void gla_scan(const Args& A, LAS unsigned char* lds, int tid) {
    unsigned* ST = (unsigned*)(A.ws + WS_ST); const float* DEC = (const float*)(A.ws + WS_DEC); LAS float* DL = (LAS float*)lds;
    for (int g0 = blockIdx.x * 512; g0 < 131072; g0 += gridDim.x * 512) {
        const int gt = g0 + tid, seq = g0 >> 12, e2 = gt & 4095, dir = seq >> 4, dk = (2 * e2) & 63;
        __syncthreads();
#pragma unroll
        for (int i = 0; i < 4; ++i) *(LAS f32x4*)(DL + (tid + 512 * i) * 4) = *(const f32x4*)(DEC + (size_t)seq * 8192 + (tid + 512 * i) * 4);
        __syncthreads();
        unsigned* sp = ST + (size_t)seq * 128 * 4096 + e2;
        float s0 = 0.f, s1 = 0.f;
        unsigned nx[32];
#pragma unroll
        for (int j = 0; j < 32; ++j) { const int n = dir ? 127 - j : j; nx[j] = __builtin_nontemporal_load(sp + (size_t)n * 4096); }
#pragma unroll 1
        for (int i0 = 0; i0 < 128; i0 += 32) {
            unsigned ds[32];
#pragma unroll
            for (int j = 0; j < 32; ++j) ds[j] = nx[j];
            if (i0 + 32 < 128) {
#pragma unroll
                for (int j = 0; j < 32; ++j) { const int n = dir ? 127 - (i0 + 32 + j) : i0 + 32 + j; nx[j] = __builtin_nontemporal_load(sp + (size_t)n * 4096); } }
#pragma unroll
            for (int j = 0; j < 32; ++j) { const int n = dir ? 127 - (i0 + j) : i0 + j; const float d0 = DL[n * 64 + dk], d1 = DL[n * 64 + dk + 1];
                sp[(size_t)n * 4096] = pk2(s0, s1); s0 = d0 * s0 + bflo(ds[j]); s1 = d1 * s1 + bfhi(ds[j]); }
        }
    }
}
DI void gla_pass_c(const Args& A, LAS unsigned char* lds, int tid) {
    const int lane = tid & 63, wid = tid >> 6, fr = lane & 15, fq = lane >> 4;
    const bf16* P = (const bf16*)(A.ws + WS_P); const bf16* ST = (const bf16*)(A.ws + WS_ST); bf16* Y = (bf16*)(A.ws + WS_Y);
    LAS float* LA = (LAS float*)(lds + G_LA); LAS float* RS = (LAS float*)(lds + GC_RS);
    const bf16* LRg = (const bf16*)(A.ws + WS_LR); int h_loaded = -1; DecayW dw; dw.bh = (bf16x8){0,0,0,0,0,0,0,0}; dw.bl = dw.bh; dw.bias = 0.f;
    const int t = tid >> 3, d8 = (tid & 7) * 8, vsp = tid & 31, vdb = tid >> 5, ott = wid & 3, odvh = wid >> 2, ot = ott * 16 + fr;
    LrRows lrn; u32x4 qn, kn, van, vbn, stn[4]; u32x2 ggn[4]; f32x4 ngv[4];
#pragma unroll
    for (int i = 0; i < 4; ++i) ngv[i] = (f32x4){0.f, 0.f, 0.f, 0.f};
#define GC_LOAD(un) do { const int h_ = (un) & 3, cn_ = (un) >> 2, tok_ = cn_ * 64; lrn = gla_load_lr(LRg, tok_, wid, fr, fq); \
        const bf16* qp_ = P + ((size_t)h_ * NTOK + tok_ + t) * PHS + d8; qn = *(const u32x4*)qp_; kn = *(const u32x4*)(qp_ + 64); \
        const bf16* vp_ = P + ((size_t)h_ * NTOK + tok_ + 2 * vsp) * PHS + 128 + vdb * 8; van = *(const u32x4*)vp_; vbn = *(const u32x4*)(vp_ + PHS); \
        _Pragma("unroll") for (int i_ = 0; i_ < 4; ++i_) { const int ci_ = tid + 512 * i_; stn[i_] = *(const u32x4*)(ST + st_off(ci_ >> 10, cn_ >> 7, h_, cn_ & 127) + (ci_ & 1023) * 8); } \
        _Pragma("unroll") for (int dvi_ = 0; dvi_ < 4; ++dvi_) ggn[dvi_] = *(const u32x2*)(P + ((size_t)h_ * NTOK + tok_ + ot) * PHS + 256 + (odvh * 4 + dvi_) * 16 + 4 * fq); } while (0)
    if (blockIdx.x < 2048) GC_LOAD(blockIdx.x);
    for (int unit = blockIdx.x; unit < 2048; unit += gridDim.x) {
        const int h = unit & 3, cn = unit >> 2, tok0 = cn * 64;
        if (h != h_loaded) { dw = gla_decay_w(A, h, wid, fr, fq); h_loaded = h;
#pragma unroll
            for (int dvi = 0; dvi < 4; ++dvi) ngv[dvi] = *(const f32x4*)(A.in[7] + h * 128 + (odvh * 4 + dvi) * 16 + 4 * fq); }
        const LrRows lrc = lrn; const u32x4 q = qn, k = kn, va = van, vb = vbn; u32x4 stc[4]; u32x2 gg[4];
#pragma unroll
        for (int i = 0; i < 4; ++i) { stc[i] = stn[i]; gg[i] = ggn[i]; }
        if (unit + (int)gridDim.x < 2048) GC_LOAD(unit + gridDim.x);
        DUP(13) gla_decay(lds, lrc, dw, wid, fr, fq);
        DUP(10) {
#pragma unroll
            for (int dir = 0; dir < 2; ++dir) { u32x4 qo, ko;
#pragma unroll
                for (int e = 0; e < 4; ++e) { const float b0 = LA[(dir * 64 + t) * 65 + d8 + 2 * e], b1 = LA[(dir * 64 + t) * 65 + d8 + 2 * e + 1];
                    qo[e] = pk2(bflo(q[e]) * __expf(b0), bfhi(q[e]) * __expf(b1)); ko[e] = pk2(bflo(k[e]) * __expf(-b0), bfhi(k[e]) * __expf(-b1)); }
                *(LAS u32x4*)(lds + (dir ? GC_QDB : GC_QDF) + (t * RS72 + d8) * 2) = qo; *(LAS u32x4*)(lds + (dir ? GC_KDB : GC_KDF) + (t * RS72 + d8) * 2) = ko; }
        }
        gla_build_vt(va, vb, lds + GC_VT, tid);
#pragma unroll
        for (int i = 0; i < 4; ++i) { const int ci = tid + 512 * i, cc = ci & 1023; *(LAS u32x4*)(lds + ((ci >> 10) ? GC_STB : GC_STF) + ((cc >> 3) * RS72 + (cc & 7) * 8) * 2) = stc[i]; }
        lds_barrier();
        DUP(11) {
#pragma unroll
            for (int ti = 0; ti < 2; ++ti) { const int tile = wid * 2 + ti, tt = tile >> 2, st = tile & 3;
                f32x4 af = (f32x4){0.f, 0.f, 0.f, 0.f}, ab = af;
                if (st <= tt) {
#pragma unroll
                    for (int ks = 0; ks < 2; ++ks) af = mfma16(lds_frag(lds + GC_KDF + ((st * 16 + fr) * RS72 + ks * 32 + fq * 8) * 2), lds_frag(lds + GC_QDF + ((tt * 16 + fr) * RS72 + ks * 32 + fq * 8) * 2), af); }
                if (st >= tt) {
#pragma unroll
                    for (int ks = 0; ks < 2; ++ks) ab = mfma16(lds_frag(lds + GC_KDB + ((st * 16 + fr) * RS72 + ks * 32 + fq * 8) * 2), lds_frag(lds + GC_QDB + ((tt * 16 + fr) * RS72 + ks * 32 + fq * 8) * 2), ab); }
                const int t = tt * 16 + fr, s0 = st * 16 + 4 * fq; float v[4];
#pragma unroll
                for (int r = 0; r < 4; ++r) v[r] = ((s0 + r) <= t ? af[r] : 0.f) + ((s0 + r) >= t ? ab[r] : 0.f);
                u32x2 w; w.x = pk2(v[0], v[1]); w.y = pk2(v[2], v[3]);
                *(LAS u32x2*)(lds + GC_SS + (t * RS72 + s0) * 2) = w; }
        }
        lds_barrier();
        DUP(12) {
            const int tt = wid & 3, dvh = wid >> 2, t = tt * 16 + fr;
            bf16x8 yv[6];
#pragma unroll
            for (int ks = 0; ks < 2; ++ks) { yv[ks] = lds_frag(lds + GC_SS + (t * RS72 + ks * 32 + fq * 8) * 2); yv[2 + ks] = lds_frag(lds + GC_QDF + (t * RS72 + ks * 32 + fq * 8) * 2); yv[4 + ks] = lds_frag(lds + GC_QDB + (t * RS72 + ks * 32 + fq * 8) * 2); }
            f32x4 acc[4]; float q = 0.f;
#pragma unroll
            for (int dvi = 0; dvi < 4; ++dvi) { const int dvr = (dvh * 4 + dvi) * 16 + fr; f32x4 a = (f32x4){0.f, 0.f, 0.f, 0.f};
#pragma unroll
                for (int ks = 0; ks < 2; ++ks) { a = mfma16(lds_frag(lds + GC_VT + (dvr * RS72 + ks * 32 + fq * 8) * 2), yv[ks], a);
                    a = mfma16(lds_frag(lds + GC_STF + (dvr * RS72 + ks * 32 + fq * 8) * 2), yv[2 + ks], a); a = mfma16(lds_frag(lds + GC_STB + (dvr * RS72 + ks * 32 + fq * 8) * 2), yv[4 + ks], a); }
                acc[dvi] = a; q += (a[0] * a[0] + a[1] * a[1]) + (a[2] * a[2] + a[3] * a[3]); }
            q += __shfl_xor(q, 16); q += __shfl_xor(q, 32);
            if (fq == 0) RS[dvh * 64 + t] = q;
            lds_barrier();
            const float rn = rsqrtf((RS[t] + RS[64 + t]) * (1.0f / 128.0f) + EPS);
#pragma unroll
            for (int dvi = 0; dvi < 4; ++dvi) { const int col = h * 128 + (dvh * 4 + dvi) * 16 + 4 * fq;
                const f32x4 ng = ngv[dvi]; const f32x4 a = acc[dvi];
                u32x2 w; w.x = pk2(a[0] * rn * ng[0] * silu_f(bflo(gg[dvi].x)), a[1] * rn * ng[1] * silu_f(bfhi(gg[dvi].x))); w.y = pk2(a[2] * rn * ng[2] * silu_f(bflo(gg[dvi].y)), a[3] * rn * ng[3] * silu_f(bfhi(gg[dvi].y)));
                *(u32x2*)(Y + (size_t)(tok0 + t) * DM + col) = w; }
        }
    }
    lds_barrier();
#undef GC_LOAD
}
DI void final_norm(const Args& A, int tid, float* dst) {
    const int lane = tid & 63, wid = tid >> 6; const float* ssq = (const float*)(A.ws + WS_SSQ2); const float* gf = A.in[17];
    f32x4 gv[4];
#pragma unroll
    for (int j = 0; j < 4; ++j) gv[j] = *(const f32x4*)(gf + lane * 4 + 256 * j);
    for (int row = blockIdx.x * 8 + wid; row < NTOK; row += gridDim.x * 8) { float* xr = A.out + (size_t)row * DM; float* dr = dst + (size_t)row * DM; const float rs = rsqrtf(ssq[row] * (1.0f / 1024.0f) + EPS);
#pragma unroll
        for (int j = 0; j < 4; ++j) { const int o = lane * 4 + 256 * j; *(f32x4*)(dr + o) = *(const f32x4*)(xr + o) * rs * gv[j]; } }
}

__global__ void __launch_bounds__(512, 2) fwd_kernel(Args args) {
    extern __shared__ __attribute__((aligned(16))) unsigned char lds_raw[];
    LAS unsigned char* lds = (LAS unsigned char*)lds_raw;
    const int tid = threadIdx.x, lo = args.ph_lo, hi = args.ph_hi;
#define IN(k) (lo <= (k) && (k) < hi)
    volatile LAS unsigned* xst = (volatile LAS unsigned*)(lds + LDS_BYTES - 16);
    if (tid < 2) xst[tid] = 0u;
    __syncthreads();
    const XcdBarrier xbar = xcd_barrier_post((unsigned*)(args.ws + WS_BAR), xst);
    if (hi > NPH) cg::this_grid().sync();
#define SEAM(k) do { if (IN(k) && IN((k) + 1)) xcd_barrier(xbar); } while (0)
    if (IN(0)) { DUP(0) p0_prologue(args, lds, tid); } SEAM(0);
    if (IN(1)) { pg8::Gemm g{(const bf16*)(args.ws + WS_H), (const bf16*)(args.ws + WS_BT1), NTOK, N1, DM}; OrderG1 S; S.init(gridDim.x, blockIdx.x);
        Epi1 E{(bf16*)(args.ws + WS_P), (bf16*)(args.ws + WS_PU), (bf16*)(args.ws + WS_LR)};
        pg8::gemm_phase<Epi1, OrderG1, true, true, 10>(lds, g, S, E); } SEAM(1);
    if (IN(2)) { DUP(2) { gmlp_phase(args, lds, tid); __syncthreads(); } DUP(3) { gla_pass_a(args, lds, tid); } } SEAM(2);
    if (IN(3)) { gla_scan(args, lds, tid); if ((PROBE_DUP >> 9) & 1) { xcd_barrier(xbar); gla_pass_a(args, lds, tid); xcd_barrier(xbar); gla_scan(args, lds, tid); } } SEAM(3);
    if (IN(4)) { DUP(4) gla_pass_c(args, lds, tid); } SEAM(4);
    if (IN(5)) { pg8::Gemm g{(const bf16*)(args.ws + WS_Y), (const bf16*)(args.ws + WS_BT2), NTOK, DM, DM}; pg8::StaticOrder S; S.init(NTOK, DM, gridDim.x, blockIdx.x);
        EpiRes<0> E{(const float*)(args.ws + WS_XSC), (const bf16*)(args.ws + WS_H), args.in[1], (bf16*)(args.ws + WS_ST), (float*)(args.ws + WS_SSQ1)}; pg8::gemm_phase<EpiRes<0>, pg8::StaticOrder, true, true>(lds, g, S, E); } SEAM(5);
    if (IN(6)) { pg8::Gemm g{(const bf16*)(args.ws + WS_ST), (const bf16*)(args.ws + WS_BT3), NTOK, N3, DM}; pg8::StaticOrder S; S.init(NTOK, N3, gridDim.x, blockIdx.x);
        Epi3 E{(bf16*)(args.ws + WS_P), (const float*)(args.ws + WS_SSQ1)}; DUP(6) pg8::gemm_phase<Epi3, pg8::StaticOrder, true, true>(lds, g, S, E); } SEAM(6);
    if (IN(7)) { pg8::Gemm g{(const bf16*)(args.ws + WS_P), (const bf16*)(args.ws + WS_BT4), NTOK, DM, DFF}; pg8::StaticOrder S; S.init(NTOK, DM, gridDim.x, blockIdx.x);
        if (gridDim.x == 256) {
            EpiFinal E{(const bf16*)(args.ws + WS_ST), args.out, (float*)(args.ws + WS_SSQ2), (unsigned*)(args.ws + WS_CNT), args.in[17]}; pg8::gemm_phase<EpiFinal, pg8::StaticOrder, true, true>(lds, g, S, E); }
        else { EpiRes<1> E{nullptr, (const bf16*)(args.ws + WS_ST), (const float*)args.out, nullptr, (float*)(args.ws + WS_SSQ2)}; pg8::gemm_phase<EpiRes<1>, pg8::StaticOrder, true, true>(lds, g, S, E); } }
    if (gridDim.x != 256) SEAM(7);
    if (IN(8) && gridDim.x != 256) { final_norm(args, tid, args.out); }
#undef IN
#undef SEAM
}

extern "C" void kernel_launch(void* const* d_in, const int* in_sizes, int n_in, void* d_out, int out_size, void* d_ws, size_t ws_size, hipStream_t stream) {
    static int grid = 0;
    if (grid == 0) {
        if (n_in != 18 || out_size != NTOK * DM || ws_size < WS_END + (PROBE_DUP ? 128 * MiB : 0)) { fprintf(stderr, "kernel_launch: unexpected shapes (n_in %d out %d ws %zu)\n", n_in, out_size, ws_size); grid = -1; return; }
        int dev = 0, cus = 0, per_cu = 0;
        hipGetDevice(&dev); hipDeviceGetAttribute(&cus, hipDeviceAttributeMultiprocessorCount, dev);
        if (hipFuncSetAttribute((const void*)fwd_kernel, hipFuncAttributeMaxDynamicSharedMemorySize, LDS_BYTES) != hipSuccess) { fprintf(stderr, "kernel_launch: hipFuncSetAttribute failed\n"); grid = -1; return; }
        if (hipOccupancyMaxActiveBlocksPerMultiprocessor(&per_cu, (const void*)fwd_kernel, 512, LDS_BYTES) != hipSuccess || per_cu < 1) { fprintf(stderr, "kernel_launch: occupancy query says %d\n", per_cu); per_cu = 1; }
        (void)hipGetLastError();
        grid = cus * 1;
        fprintf(stderr, "kernel_launch: grid %d (cus %d, per_cu %d)\n", grid, cus, per_cu);
    }
    if (grid < 0) return;
    Args a{};
    for (int i = 0; i < 18; ++i) a.in[i] = (const float*)d_in[i];
    a.out = (float*)d_out; a.ws = (unsigned char*)d_ws;
    if (hipMemsetAsync((char*)d_ws + WS_BAR, 0, WS_BAR_BYTES, stream) != hipSuccess) { fprintf(stderr, "kernel_launch: memset failed\n"); return; }
#if MK_N_LAUNCHES == 1
    a.ph_lo = 0; a.ph_hi = NPH;
    void* kargs[] = {&a};
    hipError_t e = hipLaunchCooperativeKernel((const void*)fwd_kernel, dim3(grid), dim3(512), kargs, LDS_BYTES, stream);
    if (e != hipSuccess) fprintf(stderr, "kernel_launch: cooperative launch failed: %s (grid %d)\n", hipGetErrorString(e), grid);
#else
    for (int ph = 0; ph < 9; ++ph) { a.ph_lo = ph; a.ph_hi = ph + 1; hipLaunchKernelGGL(fwd_kernel, dim3(grid), dim3(512), LDS_BYTES, stream, a); }
#endif
}
```

```cpp
#include <hip/hip_runtime.h>
#include <hip/hip_cooperative_groups.h>
#include <cstdio>
#include <cstdint>
namespace pg8 {
#define PG8_LAS __attribute__((address_space(3)))
typedef unsigned short bf16_t;
typedef short bf16x8 __attribute__((ext_vector_type(8)));
typedef float f32x4 __attribute__((ext_vector_type(4)));
typedef unsigned u32x4 __attribute__((ext_vector_type(4)));
constexpr int BM = 256, BK = 64, HALF = 128, HTB = HALF * BK * 2  , STAGE_BYTES = 8 * HTB, NXCD = 8, WGM = 8;

__host__ __device__ __forceinline__ int lds_byte(int r, int c) { const int st = (r >> 4) * 2 + (c >> 5), rr = r & 15, cc = c & 31, ob = rr * 64 + cc * 2; return st * 1024 + (ob ^ (((ob >> 9) & 1) << 5)); }
__host__ __device__ __forceinline__ void stage_rc(int b, int& R, int& C) { const int st = b / 1024, sb = b % 1024, swz = sb ^ (((sb >> 9) & 1) << 5); R = (st >> 1) * 16 + swz / 64; C = (st & 1) * 32 + (swz % 64) / 2; }
__host__ __device__ __forceinline__ int perm32(int rho) { const int n = rho >> 4, i = rho & 15; return 8 * (i >> 2) + 4 * n + (i & 3); }

struct Unit { int pm, pn; };
struct Gemm { const bf16_t* A; const bf16_t* Bt; int M, N, K; };

struct StaticOrder {
    int nM, nN, nwg, G, c;
    __host__ __device__ void init(int M, int N, int G_, int c_) { nM = M / BM; nN = N / BM; nwg = nM * nN; G = G_; c = c_; }
    __host__ __device__ bool next(int i, Unit& u) const {
        const long L = (long)i * G + c; if (L >= nwg) return false;
        int wgid = (int)L; { const int q = nwg / NXCD, r = nwg % NXCD, xcd = wgid % NXCD, off = wgid / NXCD; wgid = (xcd < r ? xcd * (q + 1) : r * (q + 1) + (xcd - r) * q) + off; }
        const int nig = WGM * nN, gid = wgid / nig, fm = gid * WGM, gsz = (nM - fm) < WGM ? (nM - fm) : WGM;
        u.pm = fm + ((wgid % nig) % gsz); u.pn = (wgid % nig) / gsz; return true;
    }
    __device__ __forceinline__ void a_ready(const Unit&) const {}
    __device__ __forceinline__ void done(const Unit&) const {}
};
__device__ __forceinline__ unsigned cvt_pk_bf16(float lo, float hi) { unsigned r; asm volatile("v_cvt_pk_bf16_f32 %0, %1, %2" : "=v"(r) : "v"(lo), "v"(hi)); return r; }
typedef float f32x2 __attribute__((ext_vector_type(2)));
__device__ __forceinline__ f32x2 gelu_pk(f32x2 v) {
    const f32x2 av = __builtin_elementwise_abs(v), d = av * 0.2316418882f + 1.0f;
    f32x2 t; t.x = __builtin_amdgcn_rcpf(d.x); t.y = __builtin_amdgcn_rcpf(d.y);
    f32x2 q = t * 0.5307027145f + (-0.7265760135f); q = q * t + 0.7107068705f; q = q * t + (-0.142248368f); q = q * t + 0.127414796f; q = q * t;
    const f32x2 s = (v * v) * (-0.72134752044f);
    f32x2 e; e.x = __builtin_amdgcn_exp2f(s.x); e.y = __builtin_amdgcn_exp2f(s.y);
    const f32x2 m = v * (q * e), r = v - m;
    f32x2 o; o.x = v.x < 0.f ? m.x : r.x; o.y = v.y < 0.f ? m.y : r.y; return o;
}
template <class Epi, class Sched, bool ALIGN_EPI = false, bool SP2 = false, int NARROW_PN = -1  >
__device__ __forceinline__ void gemm_phase(PG8_LAS unsigned char* lds, const Gemm g, const Sched& S, const Epi& E) {
    const int tid = threadIdx.x, wid = __builtin_amdgcn_readfirstlane(tid >> 6), lane = tid & 63, wr = wid >> 2, wc = wid & 3, fr = lane & 15, fq = lane >> 4;
    const int K = g.K, nt = K / BK;
    unsigned voffA[2], voffB[2];
#pragma unroll
    for (int i = 0; i < 2; ++i) { int R, C; stage_rc(tid * 16 + i * 8192, R, C); const int Rb = Epi::PERM ? ((R & ~31) + perm32(R & 31)) : R;
        voffA[i] = (unsigned)(R * K + C) * 2u; voffB[i] = (unsigned)(Rb * K + C) * 2u; }
    const size_t kstep = (size_t)(BK * 2);
    const size_t hstep = (size_t)HALF * K * 2;
    const size_t tstep = 2 * hstep;
    const unsigned ldsw = (unsigned)wid * 1024u;
    const int aoff = lds_byte(wr * 64 + fr, fq * 8), boff = lds_byte(wc * 32 + fr, fq * 8);
#define PG8_SA(b, h) (((b) * 2 + (h)) * HTB)
#define PG8_SB(b, h) ((4 + (b) * 2 + (h)) * HTB)
#define PG8_STAGE(bufoff, gbase, voff) do { _Pragma("unroll") for (int _i = 0; _i < 2; ++_i) \
        __builtin_amdgcn_global_load_lds((const unsigned*)((const char*)(gbase) + (voff)[_i]), (PG8_LAS unsigned*)(lds + (bufoff) + ldsw + _i * 8192), 16, 0, 0); } while (0)
#define PG8_LDA(dst, b, h) do { _Pragma("unroll") for (int m = 0; m < 4; ++m) _Pragma("unroll") for (int k = 0; k < 2; ++k) dst[m][k] = *(const PG8_LAS bf16x8*)(lds + PG8_SA(b, h) + aoff + m * 2048 + k * 1024); } while (0)
#define PG8_LDB(dst, b, h) do { _Pragma("unroll") for (int n = 0; n < 2; ++n) _Pragma("unroll") for (int k = 0; k < 2; ++k) dst[n][k] = *(const PG8_LAS bf16x8*)(lds + PG8_SB(b, h) + boff + n * 2048 + k * 1024); } while (0)
#define PG8_MMA(ai, bj, At, Bt) do { __builtin_amdgcn_s_setprio(1); _Pragma("unroll") for (int m = 0; m < 4; ++m) _Pragma("unroll") for (int n = 0; n < 2; ++n) _Pragma("unroll") for (int k = 0; k < 2; ++k) \
        acc[ai][bj][m][n] = __builtin_amdgcn_mfma_f32_16x16x32_bf16(Bt[n][k], At[m][k], acc[ai][bj][m][n], 0, 0, 0); __builtin_amdgcn_s_setprio(0); } while (0)
#define PG8_WAIT_V(n) asm volatile("s_waitcnt vmcnt(" #n ")" ::: "memory")
#define PG8_WAIT_L(n) asm volatile("s_waitcnt lgkmcnt(" #n ")" ::: "memory")
#define PG8_BAR __builtin_amdgcn_s_barrier()
#define PG8_SCHED __builtin_amdgcn_sched_barrier(0)
    Unit cur, nxt; int ui = 0;
    if (!S.next(0, cur)) return;
    f32x4 acc[2][2][4][2];
#pragma unroll
    for (int a = 0; a < 2; ++a)
#pragma unroll
        for (int b = 0; b < 2; ++b)
#pragma unroll
            for (int m = 0; m < 4; ++m)
#pragma unroll
                for (int n = 0; n < 2; ++n) acc[a][b][m][n] = (f32x4){0.f, 0.f, 0.f, 0.f};
    bf16x8 At[4][2], B0[2][2], B1[2][2];
    const char* cA = (const char*)g.A + (size_t)cur.pm * tstep; const char* cB = (const char*)g.Bt + (size_t)cur.pn * tstep;
    S.a_ready(cur);
    if constexpr (SP2) {
        PG8_STAGE(PG8_SB(0, 0), cB, voffB); PG8_STAGE(PG8_SB(0, 1), cB + hstep, voffB); PG8_STAGE(PG8_SA(0, 0), cA, voffA); PG8_STAGE(PG8_SA(0, 1), cA + hstep, voffA);
        if (wr == 1) PG8_BAR;
        PG8_WAIT_V(2); PG8_BAR;
        PG8_STAGE(PG8_SB(1, 0), cB + kstep, voffB); PG8_STAGE(PG8_SA(1, 0), cA + kstep, voffA); PG8_STAGE(PG8_SB(1, 1), cB + hstep + kstep, voffB);
        PG8_WAIT_V(6); PG8_BAR;
    } else {
        PG8_STAGE(PG8_SB(0, 0), cB, voffB); PG8_STAGE(PG8_SA(0, 0), cA, voffA); PG8_STAGE(PG8_SB(0, 1), cB + hstep, voffB); PG8_STAGE(PG8_SA(0, 1), cA + hstep, voffA);
        if (wr == 1) PG8_BAR;
        PG8_WAIT_V(4); PG8_BAR;
        PG8_STAGE(PG8_SB(1, 0), cB + kstep, voffB); PG8_STAGE(PG8_SA(1, 0), cA + kstep, voffA); PG8_STAGE(PG8_SB(1, 1), cB + hstep + kstep, voffB);
        PG8_WAIT_V(6); PG8_BAR;
    }
    for (;;) {
        const bool has_next = S.next(ui + 1, nxt); const bool narrow = (NARROW_PN >= 0) && (cur.pn == NARROW_PN);
        const char* nA = has_next ? (const char*)g.A + (size_t)nxt.pm * tstep : cA; const char* nB = has_next ? (const char*)g.Bt + (size_t)nxt.pn * tstep : cB;
        for (int t = 0; t < nt; t += 2) {
            const bool last = (t == nt - 2);
            const char* a1 = cA + (size_t)(t + 1) * kstep;
            const char* a2 = last ? nA : cA + (size_t)(t + 2) * kstep; const char* b2 = last ? nB : cB + (size_t)(t + 2) * kstep;
            const char* a3 = a2 + kstep; const char* b3 = b2 + kstep;
            if (last && has_next) S.a_ready(nxt);
            if constexpr (SP2) {
            PG8_LDB(B0, 0, 0); PG8_LDB(B1, 0, 1); PG8_SCHED; PG8_LDA(At, 0, 0); PG8_STAGE(PG8_SA(1, 1), a1 + hstep, voffA);
            PG8_WAIT_V(8); PG8_WAIT_L(0); PG8_BAR; PG8_MMA(0, 0, At, B0); if (NARROW_PN < 0 || !narrow) PG8_MMA(0, 1, At, B1); PG8_BAR; PG8_SCHED;
            PG8_LDA(At, 0, 1); PG8_STAGE(PG8_SB(0, 0), b2, voffB); PG8_STAGE(PG8_SB(0, 1), b2 + hstep, voffB); PG8_STAGE(PG8_SA(0, 0), a2, voffA);
            PG8_WAIT_V(8); PG8_WAIT_L(0); PG8_BAR; PG8_MMA(1, 0, At, B0); if (NARROW_PN < 0 || !narrow) PG8_MMA(1, 1, At, B1); PG8_BAR; PG8_SCHED;
            PG8_LDB(B0, 1, 0); PG8_LDB(B1, 1, 1); PG8_SCHED; PG8_LDA(At, 1, 0); PG8_STAGE(PG8_SA(0, 1), a2 + hstep, voffA);
            PG8_WAIT_V(8); PG8_WAIT_L(0); PG8_BAR; PG8_MMA(0, 0, At, B0); if (NARROW_PN < 0 || !narrow) PG8_MMA(0, 1, At, B1); PG8_BAR; PG8_SCHED;
            PG8_LDA(At, 1, 1); PG8_STAGE(PG8_SB(1, 0), b3, voffB); PG8_STAGE(PG8_SB(1, 1), b3 + hstep, voffB); PG8_STAGE(PG8_SA(1, 0), a3, voffA);
            PG8_WAIT_V(8); PG8_WAIT_L(0); PG8_BAR; PG8_MMA(1, 0, At, B0); if (NARROW_PN < 0 || !narrow) PG8_MMA(1, 1, At, B1); PG8_BAR; PG8_SCHED;
            } else {
            PG8_LDB(B0, 0, 0); PG8_SCHED; PG8_LDA(At, 0, 0); PG8_STAGE(PG8_SA(1, 1), a1 + hstep, voffA);
            PG8_WAIT_L(8); PG8_BAR; PG8_WAIT_L(0); PG8_MMA(0, 0, At, B0); PG8_BAR; PG8_SCHED;
            PG8_LDB(B1, 0, 1); PG8_STAGE(PG8_SB(0, 0), b2, voffB);
            PG8_BAR; PG8_WAIT_L(0); PG8_MMA(0, 1, At, B1); PG8_BAR;
            PG8_LDA(At, 0, 1); PG8_STAGE(PG8_SA(0, 0), a2, voffA);
            PG8_BAR; PG8_WAIT_L(0); PG8_MMA(1, 0, At, B0); PG8_BAR; PG8_SCHED;
            PG8_STAGE(PG8_SB(0, 1), b2 + hstep, voffB);
            PG8_WAIT_V(6); PG8_BAR; PG8_MMA(1, 1, At, B1); PG8_BAR;
            PG8_LDB(B0, 1, 0); PG8_SCHED; PG8_LDA(At, 1, 0); PG8_STAGE(PG8_SA(0, 1), a2 + hstep, voffA);
            PG8_WAIT_L(8); PG8_BAR; PG8_WAIT_L(0); PG8_MMA(0, 0, At, B0); PG8_BAR; PG8_SCHED;
            PG8_LDB(B1, 1, 1); PG8_STAGE(PG8_SB(1, 0), b3, voffB);
            PG8_BAR; PG8_WAIT_L(0); PG8_MMA(0, 1, At, B1); PG8_BAR;
            PG8_LDA(At, 1, 1); PG8_STAGE(PG8_SA(1, 0), a3, voffA);
            PG8_BAR; PG8_WAIT_L(0); PG8_MMA(1, 0, At, B0); PG8_BAR; PG8_SCHED;
            PG8_STAGE(PG8_SB(1, 1), b3 + hstep, voffB);
            PG8_WAIT_V(6); PG8_BAR; PG8_MMA(1, 1, At, B1); PG8_BAR;
            }
        }
        if constexpr (ALIGN_EPI) { if (wr == 0) PG8_BAR; }
        if constexpr (!Epi::AFTER_DRAIN) { E(acc, cur, wr, wc, fr, fq); S.done(cur); }
        if (!has_next) break;
#pragma unroll
        for (int a = 0; a < 2; ++a)
#pragma unroll
            for (int b = 0; b < 2; ++b)
#pragma unroll
                for (int m = 0; m < 4; ++m)
#pragma unroll
                    for (int n = 0; n < 2; ++n) acc[a][b][m][n] = (f32x4){0.f, 0.f, 0.f, 0.f};
        cur = nxt; cA = nA; cB = nB; ++ui;
        if constexpr (ALIGN_EPI) { if (wr == 1) PG8_BAR; }
    }
    PG8_WAIT_V(0);
    if constexpr (!ALIGN_EPI) { if (wr == 0) PG8_BAR; }
    PG8_BAR;
    if constexpr (Epi::AFTER_DRAIN) { E.fused(acc, cur, wr, wc, fr, fq, lds, wid, lane); S.done(cur); }
#undef PG8_SA
#undef PG8_SB
#undef PG8_STAGE
#undef PG8_LDA
#undef PG8_LDB
#undef PG8_MMA
#undef PG8_WAIT_V
#undef PG8_WAIT_L
#undef PG8_BAR
#undef PG8_SCHED
}
}

namespace cg = cooperative_groups;
#define LAS __attribute__((address_space(3)))
#define DI __device__ __forceinline__
typedef unsigned short bf16;
typedef short bf16x8 __attribute__((ext_vector_type(8)));
typedef float f32x4 __attribute__((ext_vector_type(4)));
typedef unsigned u32x4 __attribute__((ext_vector_type(4)));
typedef unsigned u32x2 __attribute__((ext_vector_type(2)));

#ifndef MK_N_LAUNCHES
#define MK_N_LAUNCHES 1
#endif
#define PROBE_DUP 0
#define DUP(bit) for (int rep_ = 0; rep_ < (((PROBE_DUP) >> (bit)) & 1) + 1; ++rep_)
constexpr int NPH = 10;
constexpr int NTOK = 32768, DM = 1024, PWSRC = 2592, N1 = 2816, PHS = 384, PUS = 1024, DFF = 2816, N3 = 5632;
constexpr float EPS = 1e-6f;
constexpr size_t MiB = 1u << 20;
constexpr size_t WS_SSQ1 = 0, WS_SSQ2 = 128 * 1024, WS_XSC = 256 * 1024, WS_WSB = 1 * MiB, WS_RSW = 1 * MiB + 256 * 1024, WS_BT1 = 2 * MiB, WS_BT2 = 8 * MiB, WS_BT3 = 10 * MiB, WS_BT4 = 21 * MiB,
                 WS_DEC = 27 * MiB, WS_LR = 28 * MiB, WS_H = 32 * MiB  , WS_ST = 96 * MiB  ,
                 WS_P = 160 * MiB  , WS_Y = 336 * MiB  , WS_END = 400 * MiB;
constexpr size_t WS_BAR = 512 * 1024, WS_CNT = WS_BAR + 16384, WS_BAR_BYTES = 16384 + 32768;
constexpr size_t WS_PU = WS_P + (size_t)4 * NTOK * PHS * 2;
constexpr int LDS_BYTES = 151552;

typedef float f32x2_t __attribute__((ext_vector_type(2))); typedef __bf16 bf16x2_t __attribute__((ext_vector_type(2)));
DI unsigned pk2(float lo, float hi) { f32x2_t v = {lo, hi}; bf16x2_t b = __builtin_convertvector(v, bf16x2_t); return __builtin_bit_cast(unsigned, b); }
DI float bflo(unsigned u) { return __uint_as_float(u << 16); }
DI float bfhi(unsigned u) { return __uint_as_float(u & 0xffff0000u); }
DI float silu_f(float g) { return g * __builtin_amdgcn_rcpf(1.0f + __expf(-g)); }
DI float logsig(float z) { return fminf(z, 0.f) - __logf(1.0f + __expf(-fabsf(z))); }
DI void lds_barrier() { asm volatile("s_waitcnt lgkmcnt(0)" ::: "memory"); __builtin_amdgcn_s_barrier(); asm volatile("" ::: "memory"); }
DI bf16x8 lds_frag(LAS const unsigned char* p) { return *(LAS const bf16x8*)p; }
DI f32x4 mfma16(bf16x8 a, bf16x8 b, f32x4 c) { return __builtin_amdgcn_mfma_f32_16x16x32_bf16(a, b, c, 0, 0, 0); }

#define XB_TMO      128
#define XB_XCNT(j)  (256  + 64 * (j))
#define XB_XSUB(j)  (1280 + 64 * (j))
#define XB_XGEN(j)  (2304 + 64 * (j))
#define XB_TOP      3328
#define XB_TOPGEN   3392
#define XCD_BAR_WORDS 3456
#define XB_SPIN_CAP (1u << 18)

__device__ __forceinline__ unsigned xb_ld(unsigned* p)              { return __hip_atomic_load(p, __ATOMIC_RELAXED, __HIP_MEMORY_SCOPE_AGENT); }
__device__ __forceinline__ unsigned xb_add(unsigned* p, unsigned v) { return __hip_atomic_fetch_add(p, v, __ATOMIC_RELAXED, __HIP_MEMORY_SCOPE_AGENT); }
__device__ __forceinline__ unsigned xb_xcc_id() { return (unsigned)__builtin_amdgcn_s_getreg((3 << 11) | 20) & 0xFu; }
#define XB_SPIN(cond, bar) do { unsigned _sp = 0; while (cond) { __builtin_amdgcn_s_sleep(1); \
    if ((++_sp & 255u) == 0u) { if (xb_ld(&(bar)[XB_TMO])) break; if (_sp > XB_SPIN_CAP) { atomicAdd(&(bar)[XB_TMO], 1u); break; } } } } while (0)

struct XcdBarrier {
    unsigned* bar; unsigned x;
    volatile LAS unsigned* st;
};

__device__ __forceinline__ XcdBarrier xcd_barrier_post(unsigned* bar, volatile LAS unsigned* st) {
    XcdBarrier b; b.bar = bar; b.x = xb_xcc_id(); b.st = st;
    if (threadIdx.x == 0) (void)xb_add(&bar[XB_XCNT(b.x)], 1u);
    return b;
}
__device__ __forceinline__ void xcd_barrier_complete(unsigned* bar, unsigned x, unsigned& nloc, unsigned& nx) {
    const unsigned G = gridDim.x * gridDim.y * gridDim.z;
    unsigned sum, cnt, mine, sp = 0u;
    for (;;) {
        sum = 0u; cnt = 0u; mine = 0u;
#pragma unroll
        for (unsigned j = 0; j < 16; ++j) { const unsigned c = xb_ld(&bar[XB_XCNT(j)]); sum += c; cnt += (c > 0u) ? 1u : 0u; mine = (j == x) ? c : mine; }
        if (sum == G) break;
        __builtin_amdgcn_s_sleep(1);
        if ((++sp & 255u) == 0u) { if (xb_ld(&bar[XB_TMO])) break; if (sp > XB_SPIN_CAP) { atomicAdd(&bar[XB_TMO], 1u); break; } }
    }
    nloc = mine > 0u ? mine : 1u; nx = cnt > 0u ? cnt : 1u;
}

__device__ __forceinline__ void xcd_barrier(const XcdBarrier& b) {
    asm volatile("s_waitcnt vmcnt(0)" ::: "memory");
    __syncthreads();
    if (threadIdx.x == 0) {
        unsigned* bar = b.bar;
        __builtin_amdgcn_s_waitcnt(0);
        unsigned nloc = b.st[0], nx = b.st[1];
        if (nloc == 0u) { xcd_barrier_complete(bar, b.x, nloc, nx); b.st[0] = nloc; b.st[1] = nx; }
        const unsigned old = xb_add(&bar[XB_XSUB(b.x)], 1u);
        const unsigned gen = old / nloc;
        if (old + 1u == (gen + 1u) * nloc) {
            __builtin_amdgcn_fence(__ATOMIC_RELEASE, "agent");
            asm volatile("s_waitcnt vmcnt(0)" ::: "memory");
            const unsigned og = xb_add(&bar[XB_TOP], 1u);
            const unsigned tg = og / nx;
            if (og + 1u == (tg + 1u) * nx) xb_add(&bar[XB_TOPGEN], 1u);
            else XB_SPIN(xb_ld(&bar[XB_TOPGEN]) == tg, bar);
            __builtin_amdgcn_fence(__ATOMIC_ACQUIRE, "agent");
            xb_add(&bar[XB_XGEN(b.x)], 1u);
            asm volatile("s_waitcnt vmcnt(0)" ::: "memory");
        } else {
            XB_SPIN(xb_ld(&bar[XB_XGEN(b.x)]) == gen, bar);
            __builtin_amdgcn_fence(__ATOMIC_ACQUIRE, "agent");
            asm volatile("s_waitcnt vmcnt(0)" ::: "memory");
        }
    }
    __syncthreads();
}

struct OrderG1 { pg8::StaticOrder full, all; bool special; int c;
    __device__ void init(int G, int c_) { special = (G == 256); c = c_; full.init(NTOK, 2560, G, c_); all.init(NTOK, N1, G, c_); }
    __device__ bool next(int i, pg8::Unit& u) const { if (!special) return all.next(i, u); if (i < 5) return full.next(i, u); if (i == 5 && c < 128) { u.pm = c; u.pn = 10; return true; } return false; }
    __device__ __forceinline__ void a_ready(const pg8::Unit&) const {}
    __device__ __forceinline__ void done(const pg8::Unit&) const {}
};
struct Args { const float* in[18]; float* out; unsigned char* ws; int ph_lo, ph_hi; };

struct Epi1 {
    static constexpr bool PERM = true, AFTER_DRAIN = false;
    bf16* P; bf16* PU; bf16* LR;
    DI void operator()(const f32x4 (&acc)[2][2][4][2], const pg8::Unit& u, int wr, int wc, int fr, int fq) const {
        const int row0 = u.pm * 256 + wr * 64 + fr;
        if (u.pn == 10) {
            if (wc == 0) {
#pragma unroll
                for (int ai = 0; ai < 2; ++ai)
#pragma unroll
                    for (int m = 0; m < 4; ++m) { bf16* p = LR + (size_t)(row0 + ai * 128 + m * 16) * 64 + (fq >> 1) * 32 + (fq & 1) * 8; u32x4 hv, lv;
#pragma unroll
                        for (int e = 0; e < 4; ++e) { const float x0 = acc[ai][0][m][e >> 1][(e & 1) * 2], x1 = acc[ai][0][m][e >> 1][(e & 1) * 2 + 1]; const unsigned hp = pk2(x0, x1);
                            hv[e] = hp; lv[e] = pk2(x0 - bflo(hp), x1 - bfhi(hp)); }
                        *(u32x4*)p = hv; *(u32x4*)(p + 16) = lv; }
            }
            return;
        }
        const bool act = u.pn >= 6;
        const int col0 = u.pn * 256 + wc * 32 + 8 * fq;
#pragma unroll
        for (int ai = 0; ai < 2; ++ai)
#pragma unroll
            for (int m = 0; m < 4; ++m) { const int row = row0 + ai * 128 + m * 16;
#pragma unroll
                for (int bj = 0; bj < 2; ++bj) { const int col = col0 + bj * 128;
                    bf16* dst = act ? PU + (size_t)row * PUS + (col - 1536) : P + ((size_t)(col / 384) * NTOK + row) * PHS + col % 384;
                    f32x4 v0 = acc[ai][bj][m][0], v1 = acc[ai][bj][m][1];
                    if (act) { pg8::f32x2 a = pg8::gelu_pk((pg8::f32x2){v0[0], v0[1]}), b = pg8::gelu_pk((pg8::f32x2){v0[2], v0[3]}), c = pg8::gelu_pk((pg8::f32x2){v1[0], v1[1]}), d = pg8::gelu_pk((pg8::f32x2){v1[2], v1[3]});
                        v0 = (f32x4){a.x, a.y, b.x, b.y}; v1 = (f32x4){c.x, c.y, d.x, d.y}; }
                    u32x4 w; w.x = pk2(v0[0], v0[1]); w.y = pk2(v0[2], v0[3]); w.z = pk2(v1[0], v1[1]); w.w = pk2(v1[2], v1[3]);
                    *(u32x4*)dst = w; } }
    }
};
template <int MODE> struct EpiRes {
    static constexpr bool PERM = true, AFTER_DRAIN = false;
    const float* xsc; const bf16* baseb; const float* aux  ; bf16* ob; float* ssq;
    DI void operator()(const f32x4 (&acc)[2][2][4][2], const pg8::Unit& u, int wr, int wc, int fr, int fq) const {
        const int row0 = u.pm * 256 + wr * 64 + fr, col0 = u.pn * 256 + wc * 32 + 8 * fq;
        f32x4 gi[2][2];
        if (MODE == 0) {
#pragma unroll
            for (int bj = 0; bj < 2; ++bj)
#pragma unroll
                for (int n = 0; n < 2; ++n) { const f32x4 gq = *(const f32x4*)(aux + col0 + bj * 128 + n * 4); gi[bj][n] = (f32x4){1.0f / gq[0], 1.0f / gq[1], 1.0f / gq[2], 1.0f / gq[3]}; } }
#pragma unroll
        for (int ai = 0; ai < 2; ++ai) {
            u32x4 bw[4][2]; float sc[4];
#pragma unroll
            for (int m = 0; m < 4; ++m) { if (MODE == 0) sc[m] = xsc[row0 + ai * 128 + m * 16];
#pragma unroll
                for (int bj = 0; bj < 2; ++bj) bw[m][bj] = *(const u32x4*)(baseb + (size_t)(row0 + ai * 128 + m * 16) * DM + col0 + bj * 128); }
#pragma unroll
            for (int m = 0; m < 4; ++m) { const int row = row0 + ai * 128 + m * 16; float s = 0.f;
#pragma unroll
                for (int bj = 0; bj < 2; ++bj) { const size_t o = (size_t)row * DM + col0 + bj * 128; const u32x4 w = bw[m][bj];
                    f32x4 v0 = (f32x4){bflo(w.x), bfhi(w.x), bflo(w.y), bfhi(w.y)}, v1 = (f32x4){bflo(w.z), bfhi(w.z), bflo(w.w), bfhi(w.w)};
                    if (MODE == 0) { v0 = v0 * sc[m] * gi[bj][0]; v1 = v1 * sc[m] * gi[bj][1]; }
                    v0 = v0 + acc[ai][bj][m][0]; v1 = v1 + acc[ai][bj][m][1];
                    s += ((v0[0] * v0[0] + v0[1] * v0[1]) + (v0[2] * v0[2] + v0[3] * v0[3])) + ((v1[0] * v1[0] + v1[1] * v1[1]) + (v1[2] * v1[2] + v1[3] * v1[3]));
                    if (MODE == 0) { u32x4 wo; wo.x = pk2(v0[0], v0[1]); wo.y = pk2(v0[2], v0[3]); wo.z = pk2(v1[0], v1[1]); wo.w = pk2(v1[2], v1[3]); *(u32x4*)(ob + o) = wo; }
                    else { *(f32x4*)((float*)aux + o) = v0; *(f32x4*)((float*)aux + o + 4) = v1; } }
                s += __shfl_xor(s, 16); s += __shfl_xor(s, 32);
                if (fq == 0) atomicAdd(ssq + row, s); }
        }
    }
};
struct EpiFinal {
    static constexpr bool PERM = true, AFTER_DRAIN = false;
    const bf16* base; float* out; float* ssq; unsigned* cnt; const float* gf;
    DI void operator()(f32x4 (&acc)[2][2][4][2], const pg8::Unit& u, int wr, int wc, int fr, int fq) const {
        const int row0 = u.pm * 256 + wr * 64 + fr, col0 = u.pn * 256 + wc * 32 + 8 * fq;
        u32x4 bw[2][4][2];
#pragma unroll
        for (int ai = 0; ai < 2; ++ai)
#pragma unroll
            for (int m = 0; m < 4; ++m)
#pragma unroll
                for (int bj = 0; bj < 2; ++bj) bw[ai][m][bj] = *(const u32x4*)(base + (size_t)(row0 + ai * 128 + m * 16) * DM + col0 + bj * 128);
        f32x4 gv[2][2];
#pragma unroll
        for (int bj = 0; bj < 2; ++bj)
#pragma unroll
            for (int n = 0; n < 2; ++n) gv[bj][n] = *(const f32x4*)(gf + col0 + bj * 128 + n * 4);
#pragma unroll
        for (int ai = 0; ai < 2; ++ai)
#pragma unroll
            for (int m = 0; m < 4; ++m) { const int row = row0 + ai * 128 + m * 16; float s = 0.f;
#pragma unroll
                for (int bj = 0; bj < 2; ++bj) { const u32x4 w = bw[ai][m][bj];
                    const f32x4 v0 = (f32x4){bflo(w.x), bfhi(w.x), bflo(w.y), bfhi(w.y)} + acc[ai][bj][m][0], v1 = (f32x4){bflo(w.z), bfhi(w.z), bflo(w.w), bfhi(w.w)} + acc[ai][bj][m][1];
                    acc[ai][bj][m][0] = v0; acc[ai][bj][m][1] = v1;
                    s += ((v0[0] * v0[0] + v0[1] * v0[1]) + (v0[2] * v0[2] + v0[3] * v0[3])) + ((v1[0] * v1[0] + v1[1] * v1[1]) + (v1[2] * v1[2] + v1[3] * v1[3])); }
                s += __shfl_xor(s, 16); s += __shfl_xor(s, 32);
                if (fq == 0) atomicAdd(ssq + row, s); }
        asm volatile("s_waitcnt vmcnt(0)" ::: "memory");
        unsigned* c = cnt + 64 * u.pm;
        if (fr == 0 && fq == 0) __hip_atomic_fetch_add(c, 1u, __ATOMIC_RELAXED, __HIP_MEMORY_SCOPE_AGENT);
        { unsigned sp = 0; while ((unsigned)__builtin_amdgcn_readfirstlane(__hip_atomic_load(c, __ATOMIC_RELAXED, __HIP_MEMORY_SCOPE_AGENT)) < 32u) { __builtin_amdgcn_s_sleep(2); if (++sp > (1u << 22)) break; } }
        float sv[8];
#pragma unroll
        for (int i = 0; i < 8; ++i) sv[i] = __hip_atomic_load(ssq + row0 + (i >> 2) * 128 + (i & 3) * 16, __ATOMIC_RELAXED, __HIP_MEMORY_SCOPE_AGENT);
#pragma unroll
        for (int ai = 0; ai < 2; ++ai)
#pragma unroll
            for (int m = 0; m < 4; ++m) { const int row = row0 + ai * 128 + m * 16; const float rs = rsqrtf(sv[ai * 4 + m] * (1.0f / 1024.0f) + EPS);
#pragma unroll
                for (int bj = 0; bj < 2; ++bj)
#pragma unroll
                    for (int n = 0; n < 2; ++n) *(f32x4*)(out + (size_t)row * DM + col0 + bj * 128 + n * 4) = acc[ai][bj][m][n] * rs * gv[bj][n]; }
    }
};
struct Epi3 {
    static constexpr bool PERM = true, AFTER_DRAIN = false;
    bf16* ACT; const float* ssq;
    DI void operator()(const f32x4 (&acc)[2][2][4][2], const pg8::Unit& u, int wr, int wc, int fr, int fq) const {
        const int row0 = u.pm * 256 + wr * 64 + fr, col0 = u.pn * 128 + wc * 32 + 8 * fq;
        float sv[8];
#pragma unroll
        for (int i = 0; i < 8; ++i) sv[i] = ssq[row0 + (i >> 2) * 128 + (i & 3) * 16];
#pragma unroll
        for (int ai = 0; ai < 2; ++ai)
#pragma unroll
            for (int m = 0; m < 4; ++m) { const int row = row0 + ai * 128 + m * 16; const float rs = rsqrtf(sv[ai * 4 + m] * (1.0f / 1024.0f) + EPS);
                float o[8];
#pragma unroll
                for (int n = 0; n < 2; ++n)
#pragma unroll
                    for (int e = 0; e < 4; ++e) o[n * 4 + e] = silu_f(acc[ai][0][m][n][e] * rs) * (acc[ai][1][m][n][e] * rs);
                u32x4 w; w.x = pk2(o[0], o[1]); w.y = pk2(o[2], o[3]); w.z = pk2(o[4], o[5]); w.w = pk2(o[6], o[7]);
                *(u32x4*)(ACT + (size_t)row * DFF + col0) = w; }
    }
};

DI void p0_item(const Args& A, int it, LAS float* scr, int tid) {
    int mat, ntile, kt;
    if (it < 704) { mat = 1; ntile = it >> 4; kt = it & 15; }
    else if (it < 960) { it -= 704; mat = 2; ntile = it >> 4; kt = it & 15; }
    else if (it < 2368) { it -= 960; mat = 3; ntile = it >> 4; kt = it & 15; }
    else { it -= 2368; mat = 4; ntile = it / 44; kt = it % 44; }
    const int kl = tid >> 3, n8 = tid & 7, nd = ntile * 64 + n8 * 8, k = kt * 64 + kl;
    const float* src = nullptr; int ldw = 0, sc = 0; float scale = 1.f; bf16* dst; int K = 1024;
    if (mat == 1) { ldw = PWSRC; dst = (bf16*)(A.ws + WS_BT1);
        if (nd < 1536) { const int hh = nd / 384, c = nd % 384; sc = c < 64 ? hh * 64 + c : (c < 128 ? 256 + hh * 64 + (c - 64) : (c < 256 ? 512 + hh * 128 + (c - 128) : 1024 + hh * 128 + (c - 256))); if (c < 64) scale = 0.125f; }
        else if (nd < 2560) sc = nd + 32; else if (nd < 2592) sc = nd - 2560 + 1536; else sc = -1;
        if (sc >= 0) src = A.in[2]; }
    else if (mat == 2) { ldw = 1024; dst = (bf16*)(A.ws + WS_BT2); sc = nd; src = A.in[12]; }
    else if (mat == 3) { ldw = DFF; dst = (bf16*)(A.ws + WS_BT3); const int tl = nd >> 8, r = nd & 255; if (r < 128) { src = A.in[14]; sc = tl * 128 + r; } else { src = A.in[15]; sc = tl * 128 + r - 128; } scale = A.in[13][k]; }
    else { ldw = 1024; dst = (bf16*)(A.ws + WS_BT4); sc = nd; src = A.in[16]; K = DFF; }
    f32x4 a = (f32x4){0.f, 0.f, 0.f, 0.f}, b = a;
    if (src) { const float* p = src + (size_t)k * ldw + sc; a = *(const f32x4*)p * scale; b = *(const f32x4*)(p + 4) * scale; }
    LAS float* w = scr + kl * 65 + n8 * 8;
    w[0] = a[0]; w[1] = a[1]; w[2] = a[2]; w[3] = a[3]; w[4] = b[0]; w[5] = b[1]; w[6] = b[2]; w[7] = b[3];
    __syncthreads();
    const int nl = tid >> 3, k8 = tid & 7; float v[8];
#pragma unroll
    for (int j = 0; j < 8; ++j) v[j] = scr[(k8 * 8 + j) * 65 + nl];
    u32x4 o; o.x = pk2(v[0], v[1]); o.y = pk2(v[2], v[3]); o.z = pk2(v[4], v[5]); o.w = pk2(v[6], v[7]);
    *(u32x4*)(dst + (size_t)(ntile * 64 + nl) * K + kt * 64 + k8 * 8) = o;
    __syncthreads();
}
DI void p0_prologue(const Args& A, LAS unsigned char* lds, int tid) {
    const int G = gridDim.x, bx = blockIdx.x, lane = tid & 63, wid = tid >> 6;
    for (int i = bx * 512 + tid; i < 65536; i += G * 512) ((float*)(A.ws + WS_SSQ1))[i] = 0.f;
    for (int i = bx * 512 + tid; i < 65536; i += G * 512) { ((bf16*)(A.ws + WS_WSB))[i] = (bf16)(pk2(A.in[10][i], 0.f) & 0xffffu); }
    for (int i = bx * 512 + tid; i < 512; i += G * 512) { const float* w = A.in[10] + (size_t)i * 128; float r = 0.f;
        for (int j = 0; j < 128; j += 4) { const f32x4 v = *(const f32x4*)(w + j); r += (v[0] + v[1]) + (v[2] + v[3]); }
        ((float*)(A.ws + WS_RSW))[i] = r; }
    for (int it = bx; it < 3072; it += G) p0_item(A, it, (LAS float*)lds, tid);
    const float* x = A.in[0]; const float* g1 = A.in[1]; bf16* H = (bf16*)(A.ws + WS_H);
    f32x4 gv[4];
#pragma unroll
    for (int j = 0; j < 4; ++j) gv[j] = *(const f32x4*)(g1 + lane * 4 + 256 * j);
    for (int row = bx * 8 + wid; row < NTOK; row += G * 8) {
        const float* xr = x + (size_t)row * DM; f32x4 v[4]; float s = 0.f;
#pragma unroll
        for (int j = 0; j < 4; ++j) { v[j] = *(const f32x4*)(xr + lane * 4 + 256 * j); s += (v[j][0] * v[j][0] + v[j][1] * v[j][1]) + (v[j][2] * v[j][2] + v[j][3] * v[j][3]); }
#pragma unroll
        for (int o = 1; o < 64; o <<= 1) s += __shfl_xor(s, o);
        const float rs = rsqrtf(s * (1.0f / 1024.0f) + EPS);
        if (lane == 0) ((float*)(A.ws + WS_XSC))[row] = sqrtf(s * (1.0f / 1024.0f) + EPS);
#pragma unroll
        for (int j = 0; j < 4; ++j) { const f32x4 y = v[j] * rs * gv[j]; u32x2 w; w.x = pk2(y[0], y[1]); w.y = pk2(y[2], y[3]); *(u32x2*)(H + (size_t)row * DM + lane * 4 + 256 * j) = w; }
    }
}

constexpr int GM_VTS = 136, GM_PART = (128 * GM_VTS + 16) * 2  , GM_LN = 4 * GM_PART;
static_assert(GM_LN + 4096 <= 151552 - 16, "gMLP LDS map");
DI void gmlp_phase(const Args& A, LAS unsigned char* lds, int tid) {
    const int lane = tid & 63, wid = tid >> 6, fr = lane & 15, fq = lane >> 4;
    const bf16* PU = (const bf16*)(A.ws + WS_PU); bf16* Y = (bf16*)(A.ws + WS_Y); const bf16* WS = (const bf16*)(A.ws + WS_WSB); const float* RSW = (const float*)(A.ws + WS_RSW);
    const float* bsp = A.in[11];
    LAS float* LN = (LAS float*)(lds + GM_LN);
    for (int unit = blockIdx.x; unit < 256; unit += gridDim.x) {
        const int tok0 = unit * 128, j = tid >> 2, part = tid & 3, irow = wid * 16 + fr;
        u32x4 w[16];
        { const bf16* p = PU + (size_t)(tok0 + j) * PUS + 512 + part * 128;
#pragma unroll
          for (int i = 0; i < 16; ++i) w[i] = *(const u32x4*)(p + i * 8); }
        bf16x8 wfn[4]; u32x2 uvn[8];
#define GM_LOADG(g_) do { _Pragma("unroll") for (int ks_ = 0; ks_ < 4; ++ks_) wfn[ks_] = *(const bf16x8*)(WS + (size_t)(g_) * 16384 + irow * 128 + ks_ * 32 + fq * 8); \
        _Pragma("unroll") for (int ct_ = 0; ct_ < 8; ++ct_) uvn[ct_] = *(const u32x2*)(PU + (size_t)(tok0 + irow) * PUS + (g_) * 128 + ct_ * 16 + 4 * fq); } while (0)
        lds_barrier();
        LN[tid] = A.in[8][tid]; LN[512 + tid] = A.in[9][tid];
        float sm = 0.f, sq = 0.f;
#pragma unroll
        for (int i = 0; i < 16; ++i)
#pragma unroll
            for (int e = 0; e < 4; ++e) { const float a = bflo(w[i][e]), b = bfhi(w[i][e]); sm += a + b; sq += a * a + b * b; }
        sm += __shfl_xor(sm, 1); sm += __shfl_xor(sm, 2); sq += __shfl_xor(sq, 1); sq += __shfl_xor(sq, 2);
        const float mean = sm * (1.0f / 512.0f), rstd = rsqrtf(fmaxf(sq * (1.0f / 512.0f) - mean * mean, 0.f) + EPS);
        LAS unsigned short* vt = (LAS unsigned short*)(lds + part * GM_PART) + j;
#pragma unroll
        for (int i = 0; i < 16; ++i)
#pragma unroll
            for (int e = 0; e < 4; ++e) { const unsigned pv = pk2((bflo(w[i][e]) - mean) * rstd, (bfhi(w[i][e]) - mean) * rstd); const int c = i * 8 + e * 2;
                vt[c * GM_VTS] = (unsigned short)(pv & 0xffffu); vt[(c + 1) * GM_VTS] = (unsigned short)(pv >> 16); }
        GM_LOADG(0);
        lds_barrier();
        for (int g = 0; g < 4; ++g) {
            bf16x8 wf[4]; u32x2 uv[8];
#pragma unroll
            for (int ks = 0; ks < 4; ++ks) wf[ks] = wfn[ks];
#pragma unroll
            for (int ct = 0; ct < 8; ++ct) uv[ct] = uvn[ct];
            if (g < 3) GM_LOADG(g + 1);
            const float bias = bsp[g * 128 + irow], rsw = RSW[g * 128 + irow];
#pragma unroll
            for (int ct = 0; ct < 8; ++ct) { f32x4 acc = (f32x4){0.f, 0.f, 0.f, 0.f};
#pragma unroll
                for (int ks = 0; ks < 4; ++ks) acc = mfma16(lds_frag(lds + g * GM_PART + ((ct * 16 + fr) * GM_VTS + ks * 32 + fq * 8) * 2), wf[ks], acc);
                const int c = ct * 16 + 4 * fq; const f32x4 lg = *(LAS const f32x4*)(LN + g * 128 + c), lb = *(LAS const f32x4*)(LN + 512 + g * 128 + c); const u32x2 uu = uv[ct];
                u32x2 o; o.x = pk2(bflo(uu.x) * (lg[0] * acc[0] + lb[0] * rsw + bias), bfhi(uu.x) * (lg[1] * acc[1] + lb[1] * rsw + bias));
                o.y = pk2(bflo(uu.y) * (lg[2] * acc[2] + lb[2] * rsw + bias), bfhi(uu.y) * (lg[3] * acc[3] + lb[3] * rsw + bias));
                *(u32x2*)(Y + (size_t)(tok0 + irow) * DM + 512 + g * 128 + c) = o; }
        }
#undef GM_LOADG
    }
}

constexpr int G_LR = 0, G_WD = 8192, G_BD = 16384, G_SEG = 16896, G_LA = 18944, G_A0 = 52224, RS72 = 72;
constexpr int GA_KTF = G_A0, GA_KTB = G_A0 + 9216, GA_VT = G_A0 + 18432;
constexpr int GC_QDF = G_A0, GC_QDB = G_A0 + 9216, GC_KDF = G_A0 + 18432, GC_KDB = G_A0 + 27648, GC_VT = G_A0 + 36864, GC_SS = GC_VT + 18432, GC_RS = GC_SS + 9216;
constexpr int GC_STF = 0, GC_STB = 132096;
static_assert(GC_RS + 512 <= 131072 && GC_STF + 18432 <= G_LA && GC_STB + 18432 <= 151552 - 16, "GLA LDS map");
struct DecayW { bf16x8 bh, bl; float bias; };
DI unsigned hi16(float x) { return pk2(x, 0.f) & 0xffffu; }
DI DecayW gla_decay_w(const Args& A, int h, int wid, int fr, int fq) {
    const int dir = wid >> 2, d = h * 64 + 16 * (wid & 3) + fr; const float* w = (dir ? A.in[5] : A.in[3]) + ((fq & 1) * 8) * 256 + d;
    DecayW o; unsigned hh[8], ll[8];
#pragma unroll
    for (int j = 0; j < 8; ++j) { const float x = w[j * 256]; hh[j] = hi16(x); ll[j] = (fq < 2) ? hi16(x - __uint_as_float(hh[j] << 16)) : 0u; }
    u32x4 a, b;
#pragma unroll
    for (int e = 0; e < 4; ++e) { a[e] = hh[2 * e] | (hh[2 * e + 1] << 16); b[e] = ll[2 * e] | (ll[2 * e + 1] << 16); }
    o.bh = __builtin_bit_cast(bf16x8, a); o.bl = __builtin_bit_cast(bf16x8, b); o.bias = (dir ? A.in[6] : A.in[4])[d];
    return o;
}
struct LrRows { bf16x8 v[4]; };
DI LrRows gla_load_lr(const bf16* LRg, int tok0, int wid, int fr, int fq) {
    LrRows o; const bf16* p = LRg + (size_t)(tok0 + fr) * 64 + (wid >> 2) * 32 + fq * 8;
#pragma unroll
    for (int tt = 0; tt < 4; ++tt) o.v[tt] = *(const bf16x8*)(p + tt * 1024);
    return o;
}
DI void gla_decay(LAS unsigned char* lds, const LrRows& L, const DecayW& W, int wid, int fr, int fq) {
    LAS float* LA = (LAS float*)(lds + G_LA); const int dir = wid >> 2, d = 16 * (wid & 3) + fr;
    float la[4][4], p[4][4], S[4], ex[4], tot[4];
#pragma unroll
    for (int tt = 0; tt < 4; ++tt) {
        const bf16x8 a1 = L.v[tt]; const bf16x8 a2 = (fq < 2) ? a1 : (bf16x8){0, 0, 0, 0, 0, 0, 0, 0};
        f32x4 z = (f32x4){0.f, 0.f, 0.f, 0.f};
        z = mfma16(a1, W.bh, z); z = mfma16(a2, W.bl, z);
#pragma unroll
        for (int r = 0; r < 4; ++r) la[tt][r] = logsig(z[r] + W.bias) * (1.0f / 16.0f);
        p[tt][0] = la[tt][0]; p[tt][1] = p[tt][0] + la[tt][1]; p[tt][2] = p[tt][1] + la[tt][2]; p[tt][3] = p[tt][2] + la[tt][3]; S[tt] = p[tt][3];
    }
#pragma unroll
    for (int tt = 0; tt < 4; ++tt) { const float s1 = __shfl_xor(S[tt], 16), s2 = __shfl_xor(S[tt], 32), s3 = __shfl_xor(s1, 32);
        tot[tt] = (S[tt] + s1) + (s2 + s3); ex[tt] = fq == 0 ? 0.f : (fq == 1 ? s1 : (fq == 2 ? s2 + s3 : s1 + s2 + s3)); }
    const float T = (tot[0] + tot[1]) + (tot[2] + tot[3]); float base = 0.f;
#pragma unroll
    for (int tt = 0; tt < 4; ++tt) {
#pragma unroll
        for (int r = 0; r < 4; ++r) { const float pre = base + ex[tt] + p[tt][r]; LA[(dir * 64 + 16 * tt + 4 * fq + r) * 65 + d] = dir ? (T - pre + la[tt][r]) : pre; }
        base += tot[tt]; }
    lds_barrier();
}
DI void gla_build_vt(const u32x4 a, const u32x4 b, LAS unsigned char* vtb, int tid) {
    const int sp = tid & 31, dvb = tid >> 5; LAS unsigned* vt = (LAS unsigned*)vtb;
#pragma unroll
    for (int e = 0; e < 4; ++e) { const int dv = dvb * 8 + 2 * e;
        vt[dv * (RS72 / 2) + sp] = (a[e] & 0xffffu) | (b[e] << 16);
        vt[(dv + 1) * (RS72 / 2) + sp] = (a[e] >> 16) | (b[e] & 0xffff0000u); }
}
DI size_t st_off(int dir, int b, int h, int n) { return ((size_t)((dir * 4 + b) * 4 + h) * 128 + n) * 8192; }
DI void gla_pass_a(const Args& A, LAS unsigned char* lds, int tid) {
    const int lane = tid & 63, wid = tid >> 6, fr = lane & 15, fq = lane >> 4;
    const bf16* P = (const bf16*)(A.ws + WS_P); bf16* ST = (bf16*)(A.ws + WS_ST); float* DEC = (float*)(A.ws + WS_DEC);
    LAS float* LA = (LAS float*)(lds + G_LA);
    const bf16* LRg = (const bf16*)(A.ws + WS_LR); int h_loaded = -1; DecayW dw; dw.bh = (bf16x8){0,0,0,0,0,0,0,0}; dw.bl = dw.bh; dw.bias = 0.f;
    const int sp = tid & 31, db = tid >> 5;
    LrRows lrn; u32x2 k0n, k1n; u32x4 van, vbn;
#define GA_LOAD(un) do { const int h_ = (un) & 3, tok_ = ((un) >> 2) * 64; lrn = gla_load_lr(LRg, tok_, wid, fr, fq); \
        const bf16* kp_ = P + ((size_t)h_ * NTOK + tok_ + 2 * sp) * PHS + 64 + db * 4; k0n = *(const u32x2*)kp_; k1n = *(const u32x2*)(kp_ + PHS); \
        const bf16* vp_ = P + ((size_t)h_ * NTOK + tok_ + 2 * sp) * PHS + 128 + db * 8; van = *(const u32x4*)vp_; vbn = *(const u32x4*)(vp_ + PHS); } while (0)
    if (blockIdx.x < 2048) GA_LOAD(blockIdx.x);
    for (int unit = blockIdx.x; unit < 2048; unit += gridDim.x) {
        const int h = unit & 3, cn = unit >> 2, b = cn >> 7, n = cn & 127;
        if (h != h_loaded) { dw = gla_decay_w(A, h, wid, fr, fq); h_loaded = h; }
        const LrRows lrc = lrn; const u32x2 k0 = k0n, k1 = k1n; const u32x4 va = van, vb = vbn;
        if (unit + (int)gridDim.x < 2048) GA_LOAD(unit + gridDim.x);
        gla_decay(lds, lrc, dw, wid, fr, fq);
        {
            const float kk0[4] = {bflo(k0.x), bfhi(k0.x), bflo(k0.y), bfhi(k0.y)}, kk1[4] = {bflo(k1.x), bfhi(k1.x), bflo(k1.y), bfhi(k1.y)};
#pragma unroll
            for (int dir = 0; dir < 2; ++dir) { LAS unsigned* kt = (LAS unsigned*)(lds + (dir ? GA_KTB : GA_KTF));
#pragma unroll
                for (int j = 0; j < 4; ++j) { const int d = db * 4 + j; const float be = LA[(dir * 64 + (dir ? 0 : 63)) * 65 + d];
                    const float e0 = __expf(be - LA[(dir * 64 + 2 * sp) * 65 + d]), e1 = __expf(be - LA[(dir * 64 + 2 * sp + 1) * 65 + d]);
                    kt[d * (RS72 / 2) + sp] = pk2(kk0[j] * e0, kk1[j] * e1); } }
            if (tid < 128) { const int dir = tid >> 6, d = tid & 63; DEC[((size_t)((dir * 4 + b) * 4 + h) * 128 + n) * 64 + d] = __expf(LA[(dir * 64 + (dir ? 0 : 63)) * 65 + d]); }
        }
        gla_build_vt(va, vb, lds + GA_VT, tid);
        lds_barrier();
        {
            const int dir = wid >> 2, dvt0 = (wid & 3) * 2; LAS const unsigned char* kt = lds + (dir ? GA_KTB : GA_KTF);
            bf16x8 yv[2][2];
#pragma unroll
            for (int dvi = 0; dvi < 2; ++dvi)
#pragma unroll
                for (int ks = 0; ks < 2; ++ks) yv[dvi][ks] = lds_frag(lds + GA_VT + (((dvt0 + dvi) * 16 + fr) * RS72 + ks * 32 + fq * 8) * 2);
            bf16* stp = ST + st_off(dir, b, h, n);
#pragma unroll
            for (int dkt = 0; dkt < 4; ++dkt) { const bf16x8 x0 = lds_frag(kt + ((dkt * 16 + fr) * RS72 + fq * 8) * 2), x1 = lds_frag(kt + ((dkt * 16 + fr) * RS72 + 32 + fq * 8) * 2);
#pragma unroll
                for (int dvi = 0; dvi < 2; ++dvi) { f32x4 acc = (f32x4){0.f, 0.f, 0.f, 0.f}; acc = mfma16(x0, yv[dvi][0], acc); acc = mfma16(x1, yv[dvi][1], acc);
                    u32x2 w; w.x = pk2(acc[0], acc[1]); w.y = pk2(acc[2], acc[3]);
                    *(u32x2*)(stp + ((dvt0 + dvi) * 16 + fr) * 64 + dkt * 16 + 4 * fq) = w; } }
        }
    }
    lds_barrier();
#undef GA_LOAD
}
DI void gla_scan(const Args& A, LAS unsigned char* lds, int tid) {
    unsigned* ST = (unsigned*)(A.ws + WS_ST); const float* DEC = (const float*)(A.ws + WS_DEC); LAS float* DL = (LAS float*)lds;
    for (int g0 = blockIdx.x * 512; g0 < 131072; g0 += gridDim.x * 512) {
        const int gt = g0 + tid, seq = g0 >> 12, e2 = gt & 4095, dir = seq >> 4, dk = (2 * e2) & 63;
        __syncthreads();
#pragma unroll
        for (int i = 0; i < 4; ++i) *(LAS f32x4*)(DL + (tid + 512 * i) * 4) = *(const f32x4*)(DEC + (size_t)seq * 8192 + (tid + 512 * i) * 4);
        __syncthreads();
        unsigned* sp = ST + (size_t)seq * 128 * 4096 + e2;
        float s0 = 0.f, s1 = 0.f;
        unsigned nx[32];
#pragma unroll
        for (int j = 0; j < 32; ++j) { const int n = dir ? 127 - j : j; nx[j] = __builtin_nontemporal_load(sp + (size_t)n * 4096); }
#pragma unroll 1
        for (int i0 = 0; i0 < 128; i0 += 32) {
            unsigned ds[32];
#pragma unroll
            for (int j = 0; j < 32; ++j) ds[j] = nx[j];
            if (i0 + 32 < 128) {
#pragma unroll
                for (int j = 0; j < 32; ++j) { const int n = dir ? 127 - (i0 + 32 + j) : i0 + 32 + j; nx[j] = __builtin_nontemporal_load(sp + (size_t)n * 4096); } }
#pragma unroll
            for (int j = 0; j < 32; ++j) { const int n = dir ? 127 - (i0 + j) : i0 + j; const float d0 = DL[n * 64 + dk], d1 = DL[n * 64 + dk + 1];
                sp[(size_t)n * 4096] = pk2(s0, s1); s0 = d0 * s0 + bflo(ds[j]); s1 = d1 * s1 + bfhi(ds[j]); }
        }
    }
}
DI void gla_pass_c(const Args& A, LAS unsigned char* lds, int tid) {
    const int lane = tid & 63, wid = tid >> 6, fr = lane & 15, fq = lane >> 4;
    const bf16* P = (const bf16*)(A.ws + WS_P); const bf16* ST = (const bf16*)(A.ws + WS_ST); bf16* Y = (bf16*)(A.ws + WS_Y);
    LAS float* LA = (LAS float*)(lds + G_LA); LAS float* RS = (LAS float*)(lds + GC_RS);
    const bf16* LRg = (const bf16*)(A.ws + WS_LR); int h_loaded = -1; DecayW dw; dw.bh = (bf16x8){0,0,0,0,0,0,0,0}; dw.bl = dw.bh; dw.bias = 0.f;
    const int t = tid >> 3, d8 = (tid & 7) * 8, vsp = tid & 31, vdb = tid >> 5, ott = wid & 3, odvh = wid >> 2, ot = ott * 16 + fr;
    LrRows lrn; u32x4 qn, kn, van, vbn, stn[4]; u32x2 ggn[4]; f32x4 ngv[4];
#pragma unroll
    for (int i = 0; i < 4; ++i) ngv[i] = (f32x4){0.f, 0.f, 0.f, 0.f};
#define GC_LOAD(un) do { const int h_ = (un) & 3, cn_ = (un) >> 2, tok_ = cn_ * 64; lrn = gla_load_lr(LRg, tok_, wid, fr, fq); \
        const bf16* qp_ = P + ((size_t)h_ * NTOK + tok_ + t) * PHS + d8; qn = *(const u32x4*)qp_; kn = *(const u32x4*)(qp_ + 64); \
        const bf16* vp_ = P + ((size_t)h_ * NTOK + tok_ + 2 * vsp) * PHS + 128 + vdb * 8; van = *(const u32x4*)vp_; vbn = *(const u32x4*)(vp_ + PHS); \
        _Pragma("unroll") for (int i_ = 0; i_ < 4; ++i_) { const int ci_ = tid + 512 * i_; stn[i_] = *(const u32x4*)(ST + st_off(ci_ >> 10, cn_ >> 7, h_, cn_ & 127) + (ci_ & 1023) * 8); } \
        _Pragma("unroll") for (int dvi_ = 0; dvi_ < 4; ++dvi_) ggn[dvi_] = *(const u32x2*)(P + ((size_t)h_ * NTOK + tok_ + ot) * PHS + 256 + (odvh * 4 + dvi_) * 16 + 4 * fq); } while (0)
    if (blockIdx.x < 2048) GC_LOAD(blockIdx.x);
    for (int unit = blockIdx.x; unit < 2048; unit += gridDim.x) {
        const int h = unit & 3, cn = unit >> 2, tok0 = cn * 64;
        if (h != h_loaded) { dw = gla_decay_w(A, h, wid, fr, fq); h_loaded = h;
#pragma unroll
            for (int dvi = 0; dvi < 4; ++dvi) ngv[dvi] = *(const f32x4*)(A.in[7] + h * 128 + (odvh * 4 + dvi) * 16 + 4 * fq); }
        const LrRows lrc = lrn; const u32x4 q = qn, k = kn, va = van, vb = vbn; u32x4 stc[4]; u32x2 gg[4];
#pragma unroll
        for (int i = 0; i < 4; ++i) { stc[i] = stn[i]; gg[i] = ggn[i]; }
        if (unit + (int)gridDim.x < 2048) GC_LOAD(unit + gridDim.x);
        DUP(13) gla_decay(lds, lrc, dw, wid, fr, fq);
        DUP(10) {
#pragma unroll
            for (int dir = 0; dir < 2; ++dir) { u32x4 qo, ko;
#pragma unroll
                for (int e = 0; e < 4; ++e) { const float b0 = LA[(dir * 64 + t) * 65 + d8 + 2 * e], b1 = LA[(dir * 64 + t) * 65 + d8 + 2 * e + 1];
                    qo[e] = pk2(bflo(q[e]) * __expf(b0), bfhi(q[e]) * __expf(b1)); ko[e] = pk2(bflo(k[e]) * __expf(-b0), bfhi(k[e]) * __expf(-b1)); }
                *(LAS u32x4*)(lds + (dir ? GC_QDB : GC_QDF) + (t * RS72 + d8) * 2) = qo; *(LAS u32x4*)(lds + (dir ? GC_KDB : GC_KDF) + (t * RS72 + d8) * 2) = ko; }
        }
        gla_build_vt(va, vb, lds + GC_VT, tid);
#pragma unroll
        for (int i = 0; i < 4; ++i) { const int ci = tid + 512 * i, cc = ci & 1023; *(LAS u32x4*)(lds + ((ci >> 10) ? GC_STB : GC_STF) + ((cc >> 3) * RS72 + (cc & 7) * 8) * 2) = stc[i]; }
        lds_barrier();
        DUP(11) {
#pragma unroll
            for (int ti = 0; ti < 2; ++ti) { const int tile = wid * 2 + ti, tt = tile >> 2, st = tile & 3;
                f32x4 af = (f32x4){0.f, 0.f, 0.f, 0.f}, ab = af;
                if (st <= tt) {
#pragma unroll
                    for (int ks = 0; ks < 2; ++ks) af = mfma16(lds_frag(lds + GC_KDF + ((st * 16 + fr) * RS72 + ks * 32 + fq * 8) * 2), lds_frag(lds + GC_QDF + ((tt * 16 + fr) * RS72 + ks * 32 + fq * 8) * 2), af); }
                if (st >= tt) {
#pragma unroll
                    for (int ks = 0; ks < 2; ++ks) ab = mfma16(lds_frag(lds + GC_KDB + ((st * 16 + fr) * RS72 + ks * 32 + fq * 8) * 2), lds_frag(lds + GC_QDB + ((tt * 16 + fr) * RS72 + ks * 32 + fq * 8) * 2), ab); }
                const int t = tt * 16 + fr, s0 = st * 16 + 4 * fq; float v[4];
#pragma unroll
                for (int r = 0; r < 4; ++r) v[r] = ((s0 + r) <= t ? af[r] : 0.f) + ((s0 + r) >= t ? ab[r] : 0.f);
                u32x2 w; w.x = pk2(v[0], v[1]); w.y = pk2(v[2], v[3]);
                *(LAS u32x2*)(lds + GC_SS + (t * RS72 + s0) * 2) = w; }
        }
        lds_barrier();
        DUP(12) {
            const int tt = wid & 3, dvh = wid >> 2, t = tt * 16 + fr;
            bf16x8 yv[6];
#pragma unroll
            for (int ks = 0; ks < 2; ++ks) { yv[ks] = lds_frag(lds + GC_SS + (t * RS72 + ks * 32 + fq * 8) * 2); yv[2 + ks] = lds_frag(lds + GC_QDF + (t * RS72 + ks * 32 + fq * 8) * 2); yv[4 + ks] = lds_frag(lds + GC_QDB + (t * RS72 + ks * 32 + fq * 8) * 2); }
            f32x4 acc[4]; float q = 0.f;
#pragma unroll
            for (int dvi = 0; dvi < 4; ++dvi) { const int dvr = (dvh * 4 + dvi) * 16 + fr; f32x4 a = (f32x4){0.f, 0.f, 0.f, 0.f};
#pragma unroll
                for (int ks = 0; ks < 2; ++ks) { a = mfma16(lds_frag(lds + GC_VT + (dvr * RS72 + ks * 32 + fq * 8) * 2), yv[ks], a);
                    a = mfma16(lds_frag(lds + GC_STF + (dvr * RS72 + ks * 32 + fq * 8) * 2), yv[2 + ks], a); a = mfma16(lds_frag(lds + GC_STB + (dvr * RS72 + ks * 32 + fq * 8) * 2), yv[4 + ks], a); }
                acc[dvi] = a; q += (a[0] * a[0] + a[1] * a[1]) + (a[2] * a[2] + a[3] * a[3]); }
            q += __shfl_xor(q, 16); q += __shfl_xor(q, 32);
            if (fq == 0) RS[dvh * 64 + t] = q;
            lds_barrier();
            const float rn = rsqrtf((RS[t] + RS[64 + t]) * (1.0f / 128.0f) + EPS);
#pragma unroll
            for (int dvi = 0; dvi < 4; ++dvi) { const int col = h * 128 + (dvh * 4 + dvi) * 16 + 4 * fq;
                const f32x4 ng = ngv[dvi]; const f32x4 a = acc[dvi];
                u32x2 w; w.x = pk2(a[0] * rn * ng[0] * silu_f(bflo(gg[dvi].x)), a[1] * rn * ng[1] * silu_f(bfhi(gg[dvi].x))); w.y = pk2(a[2] * rn * ng[2] * silu_f(bflo(gg[dvi].y)), a[3] * rn * ng[3] * silu_f(bfhi(gg[dvi].y)));
                *(u32x2*)(Y + (size_t)(tok0 + t) * DM + col) = w; }
        }
    }
    lds_barrier();
#undef GC_LOAD
}
DI void final_norm(const Args& A, int tid, float* dst) {
    const int lane = tid & 63, wid = tid >> 6; const float* ssq = (const float*)(A.ws + WS_SSQ2); const float* gf = A.in[17];
    f32x4 gv[4];
#pragma unroll
    for (int j = 0; j < 4; ++j) gv[j] = *(const f32x4*)(gf + lane * 4 + 256 * j);
    for (int row = blockIdx.x * 8 + wid; row < NTOK; row += gridDim.x * 8) { float* xr = A.out + (size_t)row * DM; float* dr = dst + (size_t)row * DM; const float rs = rsqrtf(ssq[row] * (1.0f / 1024.0f) + EPS);
#pragma unroll
        for (int j = 0; j < 4; ++j) { const int o = lane * 4 + 256 * j; *(f32x4*)(dr + o) = *(const f32x4*)(xr + o) * rs * gv[j]; } }
}

__global__ void __launch_bounds__(512, 2) fwd_kernel(Args args) {
    extern __shared__ __attribute__((aligned(16))) unsigned char lds_raw[];
    LAS unsigned char* lds = (LAS unsigned char*)lds_raw;
    const int tid = threadIdx.x, lo = args.ph_lo, hi = args.ph_hi;
#define IN(k) (lo <= (k) && (k) < hi)
    volatile LAS unsigned* xst = (volatile LAS unsigned*)(lds + LDS_BYTES - 16);
    if (tid < 2) xst[tid] = 0u;
    __syncthreads();
    const XcdBarrier xbar = xcd_barrier_post((unsigned*)(args.ws + WS_BAR), xst);
    if (hi > NPH) cg::this_grid().sync();
#define SEAM(k) do { if (IN(k) && IN((k) + 1)) xcd_barrier(xbar); } while (0)
    if (IN(0)) { DUP(0) p0_prologue(args, lds, tid); } SEAM(0);
    if (IN(1)) { pg8::Gemm g{(const bf16*)(args.ws + WS_H), (const bf16*)(args.ws + WS_BT1), NTOK, N1, DM}; OrderG1 S; S.init(gridDim.x, blockIdx.x);
        Epi1 E{(bf16*)(args.ws + WS_P), (bf16*)(args.ws + WS_PU), (bf16*)(args.ws + WS_LR)};
        pg8::gemm_phase<Epi1, OrderG1, true, true, 10>(lds, g, S, E); } SEAM(1);
    if (IN(2)) { DUP(2) { gmlp_phase(args, lds, tid); __syncthreads(); } DUP(3) { gla_pass_a(args, lds, tid); } } SEAM(2);
    if (IN(3)) { gla_scan(args, lds, tid); if ((PROBE_DUP >> 9) & 1) { xcd_barrier(xbar); gla_pass_a(args, lds, tid); xcd_barrier(xbar); gla_scan(args, lds, tid); } } SEAM(3);
    if (IN(4)) { DUP(4) gla_pass_c(args, lds, tid); } SEAM(4);
    if (IN(5)) { pg8::Gemm g{(const bf16*)(args.ws + WS_Y), (const bf16*)(args.ws + WS_BT2), NTOK, DM, DM}; pg8::StaticOrder S; S.init(NTOK, DM, gridDim.x, blockIdx.x);
        EpiRes<0> E{(const float*)(args.ws + WS_XSC), (const bf16*)(args.ws + WS_H), args.in[1], (bf16*)(args.ws + WS_ST), (float*)(args.ws + WS_SSQ1)}; pg8::gemm_phase<EpiRes<0>, pg8::StaticOrder, true, true>(lds, g, S, E); } SEAM(5);
    if (IN(6)) { pg8::Gemm g{(const bf16*)(args.ws + WS_ST), (const bf16*)(args.ws + WS_BT3), NTOK, N3, DM}; pg8::StaticOrder S; S.init(NTOK, N3, gridDim.x, blockIdx.x);
        Epi3 E{(bf16*)(args.ws + WS_P), (const float*)(args.ws + WS_SSQ1)}; DUP(6) pg8::gemm_phase<Epi3, pg8::StaticOrder, true, true>(lds, g, S, E); } SEAM(6);
    if (IN(7)) { pg8::Gemm g{(const bf16*)(args.ws + WS_P), (const bf16*)(args.ws + WS_BT4), NTOK, DM, DFF}; pg8::StaticOrder S; S.init(NTOK, DM, gridDim.x, blockIdx.x);
        if (gridDim.x == 256) {
            EpiFinal E{(const bf16*)(args.ws + WS_ST), args.out, (float*)(args.ws + WS_SSQ2), (unsigned*)(args.ws + WS_CNT), args.in[17]}; pg8::gemm_phase<EpiFinal, pg8::StaticOrder, true, true>(lds, g, S, E); }
        else { EpiRes<1> E{nullptr, (const bf16*)(args.ws + WS_ST), (const float*)args.out, nullptr, (float*)(args.ws + WS_SSQ2)}; pg8::gemm_phase<EpiRes<1>, pg8::StaticOrder, true, true>(lds, g, S, E); } }
    if (gridDim.x != 256) SEAM(7);
    if (IN(8) && gridDim.x != 256) { final_norm(args, tid, args.out); }
#undef IN
#undef SEAM
}

extern "C" void kernel_launch(void* const* d_in, const int* in_sizes, int n_in, void* d_out, int out_size, void* d_ws, size_t ws_size, hipStream_t stream) {
    static int grid = 0;
    if (grid == 0) {
        if (n_in != 18 || out_size != NTOK * DM || ws_size < WS_END) { fprintf(stderr, "kernel_launch: unexpected shapes (n_in %d out %d ws %zu)\n", n_in, out_size, ws_size); grid = -1; return; }
        int dev = 0, cus = 0, per_cu = 0;
        hipGetDevice(&dev); hipDeviceGetAttribute(&cus, hipDeviceAttributeMultiprocessorCount, dev);
        if (hipFuncSetAttribute((const void*)fwd_kernel, hipFuncAttributeMaxDynamicSharedMemorySize, LDS_BYTES) != hipSuccess) { fprintf(stderr, "kernel_launch: hipFuncSetAttribute failed\n"); grid = -1; return; }
        if (hipOccupancyMaxActiveBlocksPerMultiprocessor(&per_cu, (const void*)fwd_kernel, 512, LDS_BYTES) != hipSuccess || per_cu < 1) { fprintf(stderr, "kernel_launch: occupancy query says %d\n", per_cu); per_cu = 1; }
        (void)hipGetLastError();
        grid = cus * 1;
        fprintf(stderr, "kernel_launch: grid %d (cus %d, per_cu %d)\n", grid, cus, per_cu);
    }
    if (grid < 0) return;
    Args a{};
    for (int i = 0; i < 18; ++i) a.in[i] = (const float*)d_in[i];
    a.out = (float*)d_out; a.ws = (unsigned char*)d_ws;
    if (hipMemsetAsync((char*)d_ws + WS_BAR, 0, WS_BAR_BYTES, stream) != hipSuccess) { fprintf(stderr, "kernel_launch: memset failed\n"); return; }
#if MK_N_LAUNCHES == 1
    a.ph_lo = 0; a.ph_hi = NPH;
    void* kargs[] = {&a};
    hipError_t e = hipLaunchCooperativeKernel((const void*)fwd_kernel, dim3(grid), dim3(512), kargs, LDS_BYTES, stream);
    if (e != hipSuccess) fprintf(stderr, "kernel_launch: cooperative launch failed: %s (grid %d)\n", hipGetErrorString(e), grid);
#else
    for (int ph = 0; ph < 9; ++ph) { a.ph_lo = ph; a.ph_hi = ph + 1; hipLaunchKernelGGL(fwd_kernel, dim3(grid), dim3(512), LDS_BYTES, stream, a); }
#endif
}
```

```cpp
#include <hip/hip_runtime.h>
#include <hip/hip_cooperative_groups.h>
#include <cstdio>
#include <cstdint>
namespace pg8 {
#define PG8_LAS __attribute__((address_space(3)))
typedef unsigned short bf16_t;
typedef short bf16x8 __attribute__((ext_vector_type(8)));
typedef float f32x4 __attribute__((ext_vector_type(4)));
typedef unsigned u32x4 __attribute__((ext_vector_type(4)));
constexpr int BM = 256, BK = 64, HALF = 128, HTB = HALF * BK * 2  , STAGE_BYTES = 8 * HTB, NXCD = 8, WGM = 8;

__host__ __device__ __forceinline__ int lds_byte(int r, int c) { const int st = (r >> 4) * 2 + (c >> 5), rr = r & 15, cc = c & 31, ob = rr * 64 + cc * 2; return st * 1024 + (ob ^ (((ob >> 9) & 1) << 5)); }
__host__ __device__ __forceinline__ void stage_rc(int b, int& R, int& C) { const int st = b / 1024, sb = b % 1024, swz = sb ^ (((sb >> 9) & 1) << 5); R = (st >> 1) * 16 + swz / 64; C = (st & 1) * 32 + (swz % 64) / 2; }
__host__ __device__ __forceinline__ int perm32(int rho) { const int n = rho >> 4, i = rho & 15; return 8 * (i >> 2) + 4 * n + (i & 3); }

struct Unit { int pm, pn; };
struct Gemm { const bf16_t* A; const bf16_t* Bt; int M, N, K; };

struct StaticOrder {
    int nM, nN, nwg, G, c;
    __host__ __device__ void init(int M, int N, int G_, int c_) { nM = M / BM; nN = N / BM; nwg = nM * nN; G = G_; c = c_; }
    __host__ __device__ bool next(int i, Unit& u) const {
        const long L = (long)i * G + c; if (L >= nwg) return false;
        int wgid = (int)L; { const int q = nwg / NXCD, r = nwg % NXCD, xcd = wgid % NXCD, off = wgid / NXCD; wgid = (xcd < r ? xcd * (q + 1) : r * (q + 1) + (xcd - r) * q) + off; }
        const int nig = WGM * nN, gid = wgid / nig, fm = gid * WGM, gsz = (nM - fm) < WGM ? (nM - fm) : WGM;
        u.pm = fm + ((wgid % nig) % gsz); u.pn = (wgid % nig) / gsz; return true;
    }
    __device__ __forceinline__ void a_ready(const Unit&) const {}
    __device__ __forceinline__ void done(const Unit&) const {}
};
__device__ __forceinline__ unsigned cvt_pk_bf16(float lo, float hi) { unsigned r; asm volatile("v_cvt_pk_bf16_f32 %0, %1, %2" : "=v"(r) : "v"(lo), "v"(hi)); return r; }
typedef float f32x2 __attribute__((ext_vector_type(2)));
__device__ __forceinline__ f32x2 gelu_pk(f32x2 v) {
    const f32x2 av = __builtin_elementwise_abs(v), d = av * 0.2316418882f + 1.0f;
    f32x2 t; t.x = __builtin_amdgcn_rcpf(d.x); t.y = __builtin_amdgcn_rcpf(d.y);
    f32x2 q = t * 0.5307027145f + (-0.7265760135f); q = q * t + 0.7107068705f; q = q * t + (-0.142248368f); q = q * t + 0.127414796f; q = q * t;
    const f32x2 s = (v * v) * (-0.72134752044f);
    f32x2 e; e.x = __builtin_amdgcn_exp2f(s.x); e.y = __builtin_amdgcn_exp2f(s.y);
    const f32x2 m = v * (q * e), r = v - m;
    f32x2 o; o.x = v.x < 0.f ? m.x : r.x; o.y = v.y < 0.f ? m.y : r.y; return o;
}
template <class Epi, class Sched, bool ALIGN_EPI = false, bool SP2 = false, int NARROW_PN = -1  >
__device__ __forceinline__ void gemm_phase(PG8_LAS unsigned char* lds, const Gemm g, const Sched& S, const Epi& E) {
    const int tid = threadIdx.x, wid = __builtin_amdgcn_readfirstlane(tid >> 6), lane = tid & 63, wr = wid >> 2, wc = wid & 3, fr = lane & 15, fq = lane >> 4;
    const int K = g.K, nt = K / BK;
    unsigned voffA[2], voffB[2];
#pragma unroll
    for (int i = 0; i < 2; ++i) { int R, C; stage_rc(tid * 16 + i * 8192, R, C); const int Rb = Epi::PERM ? ((R & ~31) + perm32(R & 31)) : R;
        voffA[i] = (unsigned)(R * K + C) * 2u; voffB[i] = (unsigned)(Rb * K + C) * 2u; }
    const size_t kstep = (size_t)(BK * 2);
    const size_t hstep = (size_t)HALF * K * 2;
    const size_t tstep = 2 * hstep;
    const unsigned ldsw = (unsigned)wid * 1024u;
    const int aoff = lds_byte(wr * 64 + fr, fq * 8), boff = lds_byte(wc * 32 + fr, fq * 8);
#define PG8_SA(b, h) (((b) * 2 + (h)) * HTB)
#define PG8_SB(b, h) ((4 + (b) * 2 + (h)) * HTB)
#define PG8_STAGE(bufoff, gbase, voff) do { _Pragma("unroll") for (int _i = 0; _i < 2; ++_i) \
        __builtin_amdgcn_global_load_lds((const unsigned*)((const char*)(gbase) + (voff)[_i]), (PG8_LAS unsigned*)(lds + (bufoff) + ldsw + _i * 8192), 16, 0, 0); } while (0)
#define PG8_LDA(dst, b, h) do { _Pragma("unroll") for (int m = 0; m < 4; ++m) _Pragma("unroll") for (int k = 0; k < 2; ++k) dst[m][k] = *(const PG8_LAS bf16x8*)(lds + PG8_SA(b, h) + aoff + m * 2048 + k * 1024); } while (0)
#define PG8_LDB(dst, b, h) do { _Pragma("unroll") for (int n = 0; n < 2; ++n) _Pragma("unroll") for (int k = 0; k < 2; ++k) dst[n][k] = *(const PG8_LAS bf16x8*)(lds + PG8_SB(b, h) + boff + n * 2048 + k * 1024); } while (0)
#define PG8_MMA(ai, bj, At, Bt) do { __builtin_amdgcn_s_setprio(1); _Pragma("unroll") for (int m = 0; m < 4; ++m) _Pragma("unroll") for (int n = 0; n < 2; ++n) _Pragma("unroll") for (int k = 0; k < 2; ++k) \
        acc[ai][bj][m][n] = __builtin_amdgcn_mfma_f32_16x16x32_bf16(Bt[n][k], At[m][k], acc[ai][bj][m][n], 0, 0, 0); __builtin_amdgcn_s_setprio(0); } while (0)
#define PG8_WAIT_V(n) asm volatile("s_waitcnt vmcnt(" #n ")" ::: "memory")
#define PG8_WAIT_L(n) asm volatile("s_waitcnt lgkmcnt(" #n ")" ::: "memory")
#define PG8_BAR __builtin_amdgcn_s_barrier()
#define PG8_SCHED __builtin_amdgcn_sched_barrier(0)
    Unit cur, nxt; int ui = 0;
    if (!S.next(0, cur)) return;
    f32x4 acc[2][2][4][2];
#pragma unroll
    for (int a = 0; a < 2; ++a)
#pragma unroll
        for (int b = 0; b < 2; ++b)
#pragma unroll
            for (int m = 0; m < 4; ++m)
#pragma unroll
                for (int n = 0; n < 2; ++n) acc[a][b][m][n] = (f32x4){0.f, 0.f, 0.f, 0.f};
    bf16x8 At[4][2], B0[2][2], B1[2][2];
    const char* cA = (const char*)g.A + (size_t)cur.pm * tstep; const char* cB = (const char*)g.Bt + (size_t)cur.pn * tstep;
    S.a_ready(cur);
    if constexpr (SP2) {
        PG8_STAGE(PG8_SB(0, 0), cB, voffB); PG8_STAGE(PG8_SB(0, 1), cB + hstep, voffB); PG8_STAGE(PG8_SA(0, 0), cA, voffA); PG8_STAGE(PG8_SA(0, 1), cA + hstep, voffA);
        if (wr == 1) PG8_BAR;
        PG8_WAIT_V(2); PG8_BAR;
        PG8_STAGE(PG8_SB(1, 0), cB + kstep, voffB); PG8_STAGE(PG8_SA(1, 0), cA + kstep, voffA); PG8_STAGE(PG8_SB(1, 1), cB + hstep + kstep, voffB);
        PG8_WAIT_V(6); PG8_BAR;
    } else {
        PG8_STAGE(PG8_SB(0, 0), cB, voffB); PG8_STAGE(PG8_SA(0, 0), cA, voffA); PG8_STAGE(PG8_SB(0, 1), cB + hstep, voffB); PG8_STAGE(PG8_SA(0, 1), cA + hstep, voffA);
        if (wr == 1) PG8_BAR;
        PG8_WAIT_V(4); PG8_BAR;
        PG8_STAGE(PG8_SB(1, 0), cB + kstep, voffB); PG8_STAGE(PG8_SA(1, 0), cA + kstep, voffA); PG8_STAGE(PG8_SB(1, 1), cB + hstep + kstep, voffB);
        PG8_WAIT_V(6); PG8_BAR;
    }
    for (;;) {
        const bool has_next = S.next(ui + 1, nxt); const bool narrow = (NARROW_PN >= 0) && (cur.pn == NARROW_PN);
        const char* nA = has_next ? (const char*)g.A + (size_t)nxt.pm * tstep : cA; const char* nB = has_next ? (const char*)g.Bt + (size_t)nxt.pn * tstep : cB;
        for (int t = 0; t < nt; t += 2) {
            const bool last = (t == nt - 2);
            const char* a1 = cA + (size_t)(t + 1) * kstep;
            const char* a2 = last ? nA : cA + (size_t)(t + 2) * kstep; const char* b2 = last ? nB : cB + (size_t)(t + 2) * kstep;
            const char* a3 = a2 + kstep; const char* b3 = b2 + kstep;
            if (last && has_next) S.a_ready(nxt);
            if constexpr (SP2) {
            PG8_LDB(B0, 0, 0); PG8_LDB(B1, 0, 1); PG8_SCHED; PG8_LDA(At, 0, 0); PG8_STAGE(PG8_SA(1, 1), a1 + hstep, voffA);
            PG8_WAIT_V(8); PG8_WAIT_L(0); PG8_BAR; PG8_MMA(0, 0, At, B0); if (NARROW_PN < 0 || !narrow) PG8_MMA(0, 1, At, B1); PG8_BAR; PG8_SCHED;
            PG8_LDA(At, 0, 1); PG8_STAGE(PG8_SB(0, 0), b2, voffB); PG8_STAGE(PG8_SB(0, 1), b2 + hstep, voffB); PG8_STAGE(PG8_SA(0, 0), a2, voffA);
            PG8_WAIT_V(8); PG8_WAIT_L(0); PG8_BAR; PG8_MMA(1, 0, At, B0); if (NARROW_PN < 0 || !narrow) PG8_MMA(1, 1, At, B1); PG8_BAR; PG8_SCHED;
            PG8_LDB(B0, 1, 0); PG8_LDB(B1, 1, 1); PG8_SCHED; PG8_LDA(At, 1, 0); PG8_STAGE(PG8_SA(0, 1), a2 + hstep, voffA);
            PG8_WAIT_V(8); PG8_WAIT_L(0); PG8_BAR; PG8_MMA(0, 0, At, B0); if (NARROW_PN < 0 || !narrow) PG8_MMA(0, 1, At, B1); PG8_BAR; PG8_SCHED;
            PG8_LDA(At, 1, 1); PG8_STAGE(PG8_SB(1, 0), b3, voffB); PG8_STAGE(PG8_SB(1, 1), b3 + hstep, voffB); PG8_STAGE(PG8_SA(1, 0), a3, voffA);
            PG8_WAIT_V(8); PG8_WAIT_L(0); PG8_BAR; PG8_MMA(1, 0, At, B0); if (NARROW_PN < 0 || !narrow) PG8_MMA(1, 1, At, B1); PG8_BAR; PG8_SCHED;
            } else {
            PG8_LDB(B0, 0, 0); PG8_SCHED; PG8_LDA(At, 0, 0); PG8_STAGE(PG8_SA(1, 1), a1 + hstep, voffA);
            PG8_WAIT_L(8); PG8_BAR; PG8_WAIT_L(0); PG8_MMA(0, 0, At, B0); PG8_BAR; PG8_SCHED;
            PG8_LDB(B1, 0, 1); PG8_STAGE(PG8_SB(0, 0), b2, voffB);
            PG8_BAR; PG8_WAIT_L(0); PG8_MMA(0, 1, At, B1); PG8_BAR;
            PG8_LDA(At, 0, 1); PG8_STAGE(PG8_SA(0, 0), a2, voffA);
            PG8_BAR; PG8_WAIT_L(0); PG8_MMA(1, 0, At, B0); PG8_BAR; PG8_SCHED;
            PG8_STAGE(PG8_SB(0, 1), b2 + hstep, voffB);
            PG8_WAIT_V(6); PG8_BAR; PG8_MMA(1, 1, At, B1); PG8_BAR;
            PG8_LDB(B0, 1, 0); PG8_SCHED; PG8_LDA(At, 1, 0); PG8_STAGE(PG8_SA(0, 1), a2 + hstep, voffA);
            PG8_WAIT_L(8); PG8_BAR; PG8_WAIT_L(0); PG8_MMA(0, 0, At, B0); PG8_BAR; PG8_SCHED;
            PG8_LDB(B1, 1, 1); PG8_STAGE(PG8_SB(1, 0), b3, voffB);
            PG8_BAR; PG8_WAIT_L(0); PG8_MMA(0, 1, At, B1); PG8_BAR;
            PG8_LDA(At, 1, 1); PG8_STAGE(PG8_SA(1, 0), a3, voffA);
            PG8_BAR; PG8_WAIT_L(0); PG8_MMA(1, 0, At, B0); PG8_BAR; PG8_SCHED;
            PG8_STAGE(PG8_SB(1, 1), b3 + hstep, voffB);
            PG8_WAIT_V(6); PG8_BAR; PG8_MMA(1, 1, At, B1); PG8_BAR;
            }
        }
        if constexpr (ALIGN_EPI) { if (wr == 0) PG8_BAR; }
        if constexpr (!Epi::AFTER_DRAIN) { E(acc, cur, wr, wc, fr, fq); S.done(cur); }
        if (!has_next) break;
#pragma unroll
        for (int a = 0; a < 2; ++a)
#pragma unroll
            for (int b = 0; b < 2; ++b)
#pragma unroll
                for (int m = 0; m < 4; ++m)
#pragma unroll
                    for (int n = 0; n < 2; ++n) acc[a][b][m][n] = (f32x4){0.f, 0.f, 0.f, 0.f};
        cur = nxt; cA = nA; cB = nB; ++ui;
        if constexpr (ALIGN_EPI) { if (wr == 1) PG8_BAR; }
    }
    PG8_WAIT_V(0);
    if constexpr (!ALIGN_EPI) { if (wr == 0) PG8_BAR; }
    PG8_BAR;
    if constexpr (Epi::AFTER_DRAIN) { E.fused(acc, cur, wr, wc, fr, fq, lds, wid, lane); S.done(cur); }
#undef PG8_SA
#undef PG8_SB
#undef PG8_STAGE
#undef PG8_LDA
#undef PG8_LDB
#undef PG8_MMA
#undef PG8_WAIT_V
#undef PG8_WAIT_L
#undef PG8_BAR
#undef PG8_SCHED
}
}

namespace cg = cooperative_groups;
#define LAS __attribute__((address_space(3)))
#define DI __device__ __forceinline__
typedef unsigned short bf16;
typedef short bf16x8 __attribute__((ext_vector_type(8)));
typedef float f32x4 __attribute__((ext_vector_type(4)));
typedef unsigned u32x4 __attribute__((ext_vector_type(4)));
typedef unsigned u32x2 __attribute__((ext_vector_type(2)));

#ifndef MK_N_LAUNCHES
#define MK_N_LAUNCHES 1
#endif
#define PROBE_DUP 0
#define DUP(bit) for (int rep_ = 0; rep_ < (((PROBE_DUP) >> (bit)) & 1) + 1; ++rep_)
constexpr int NPH = 10;
constexpr int NTOK = 32768, DM = 1024, PWSRC = 2592, N1 = 2816, PHS = 384, PUS = 1024, DFF = 2816, N3 = 5632;
constexpr float EPS = 1e-6f;
constexpr size_t MiB = 1u << 20;
constexpr size_t WS_SSQ1 = 0, WS_SSQ2 = 128 * 1024, WS_XSC = 256 * 1024, WS_WSB = 1 * MiB, WS_RSW = 1 * MiB + 256 * 1024, WS_BT1 = 2 * MiB, WS_BT2 = 8 * MiB, WS_BT3 = 10 * MiB, WS_BT4 = 21 * MiB,
                 WS_DEC = 27 * MiB, WS_LR = 28 * MiB, WS_H = 32 * MiB  , WS_ST = 96 * MiB  ,
                 WS_P = 160 * MiB  , WS_Y = 336 * MiB  , WS_END = 400 * MiB;
constexpr size_t WS_BAR = 512 * 1024, WS_CNT = WS_BAR + 16384, WS_BAR_BYTES = 16384 + 32768;
constexpr size_t WS_PU = WS_P + (size_t)4 * NTOK * PHS * 2;
constexpr int LDS_BYTES = 151552;

typedef float f32x2_t __attribute__((ext_vector_type(2))); typedef __bf16 bf16x2_t __attribute__((ext_vector_type(2)));
DI unsigned pk2(float lo, float hi) { f32x2_t v = {lo, hi}; bf16x2_t b = __builtin_convertvector(v, bf16x2_t); return __builtin_bit_cast(unsigned, b); }
DI float bflo(unsigned u) { return __uint_as_float(u << 16); }
DI float bfhi(unsigned u) { return __uint_as_float(u & 0xffff0000u); }
DI float silu_f(float g) { return g * __builtin_amdgcn_rcpf(1.0f + __expf(-g)); }
DI float logsig(float z) { return fminf(z, 0.f) - __logf(1.0f + __expf(-fabsf(z))); }
DI void lds_barrier() { asm volatile("s_waitcnt lgkmcnt(0)" ::: "memory"); __builtin_amdgcn_s_barrier(); asm volatile("" ::: "memory"); }
DI bf16x8 lds_frag(LAS const unsigned char* p) { return *(LAS const bf16x8*)p; }
DI f32x4 mfma16(bf16x8 a, bf16x8 b, f32x4 c) { return __builtin_amdgcn_mfma_f32_16x16x32_bf16(a, b, c, 0, 0, 0); }

#define XB_TMO      128
#define XB_XCNT(j)  (256  + 64 * (j))
#define XB_XSUB(j)  (1280 + 64 * (j))
#define XB_XGEN(j)  (2304 + 64 * (j))
#define XB_TOP      3328
#define XB_TOPGEN   3392
#define XCD_BAR_WORDS 3456
#define XB_SPIN_CAP (1u << 18)

__device__ __forceinline__ unsigned xb_ld(unsigned* p)              { return __hip_atomic_load(p, __ATOMIC_RELAXED, __HIP_MEMORY_SCOPE_AGENT); }
__device__ __forceinline__ unsigned xb_add(unsigned* p, unsigned v) { return __hip_atomic_fetch_add(p, v, __ATOMIC_RELAXED, __HIP_MEMORY_SCOPE_AGENT); }
__device__ __forceinline__ unsigned xb_xcc_id() { return (unsigned)__builtin_amdgcn_s_getreg((3 << 11) | 20) & 0xFu; }
#define XB_SPIN(cond, bar) do { unsigned _sp = 0; while (cond) { __builtin_amdgcn_s_sleep(1); \
    if ((++_sp & 255u) == 0u) { if (xb_ld(&(bar)[XB_TMO])) break; if (_sp > XB_SPIN_CAP) { atomicAdd(&(bar)[XB_TMO], 1u); break; } } } } while (0)

struct XcdBarrier {
    unsigned* bar; unsigned x;
    volatile LAS unsigned* st;
};

__device__ __forceinline__ XcdBarrier xcd_barrier_post(unsigned* bar, volatile LAS unsigned* st) {
    XcdBarrier b; b.bar = bar; b.x = xb_xcc_id(); b.st = st;
    if (threadIdx.x == 0) (void)xb_add(&bar[XB_XCNT(b.x)], 1u);
    return b;
}
__device__ __forceinline__ void xcd_barrier_complete(unsigned* bar, unsigned x, unsigned& nloc, unsigned& nx) {
    const unsigned G = gridDim.x * gridDim.y * gridDim.z;
    unsigned sum, cnt, mine, sp = 0u;
    for (;;) {
        sum = 0u; cnt = 0u; mine = 0u;
#pragma unroll
        for (unsigned j = 0; j < 16; ++j) { const unsigned c = xb_ld(&bar[XB_XCNT(j)]); sum += c; cnt += (c > 0u) ? 1u : 0u; mine = (j == x) ? c : mine; }
        if (sum == G) break;
        __builtin_amdgcn_s_sleep(1);
        if ((++sp & 255u) == 0u) { if (xb_ld(&bar[XB_TMO])) break; if (sp > XB_SPIN_CAP) { atomicAdd(&bar[XB_TMO], 1u); break; } }
    }
    nloc = mine > 0u ? mine : 1u; nx = cnt > 0u ? cnt : 1u;
}

__device__ __forceinline__ void xcd_barrier(const XcdBarrier& b) {
    asm volatile("s_waitcnt vmcnt(0)" ::: "memory");
    __syncthreads();
    if (threadIdx.x == 0) {
        unsigned* bar = b.bar;
        __builtin_amdgcn_s_waitcnt(0);
        unsigned nloc = b.st[0], nx = b.st[1];
        if (nloc == 0u) { xcd_barrier_complete(bar, b.x, nloc, nx); b.st[0] = nloc; b.st[1] = nx; }
        const unsigned old = xb_add(&bar[XB_XSUB(b.x)], 1u);
        const unsigned gen = old / nloc;
        if (old + 1u == (gen + 1u) * nloc) {
            __builtin_amdgcn_fence(__ATOMIC_RELEASE, "agent");
            asm volatile("s_waitcnt vmcnt(0)" ::: "memory");
            const unsigned og = xb_add(&bar[XB_TOP], 1u);
            const unsigned tg = og / nx;
            if (og + 1u == (tg + 1u) * nx) xb_add(&bar[XB_TOPGEN], 1u);
            else XB_SPIN(xb_ld(&bar[XB_TOPGEN]) == tg, bar);
            __builtin_amdgcn_fence(__ATOMIC_ACQUIRE, "agent");
            xb_add(&bar[XB_XGEN(b.x)], 1u);
            asm volatile("s_waitcnt vmcnt(0)" ::: "memory");
        } else {
            XB_SPIN(xb_ld(&bar[XB_XGEN(b.x)]) == gen, bar);
            __builtin_amdgcn_fence(__ATOMIC_ACQUIRE, "agent");
            asm volatile("s_waitcnt vmcnt(0)" ::: "memory");
        }
    }
    __syncthreads();
}

struct OrderG1 { pg8::StaticOrder full, all; bool special; int c;
    __device__ void init(int G, int c_) { special = (G == 256); c = c_; full.init(NTOK, 2560, G, c_); all.init(NTOK, N1, G, c_); }
    __device__ bool next(int i, pg8::Unit& u) const { if (!special) return all.next(i, u); if (i < 5) return full.next(i, u); if (i == 5 && c < 128) { u.pm = c; u.pn = 10; return true; } return false; }
    __device__ __forceinline__ void a_ready(const pg8::Unit&) const {}
    __device__ __forceinline__ void done(const pg8::Unit&) const {}
};
struct Args { const float* in[18]; float* out; unsigned char* ws; int ph_lo, ph_hi; };

struct Epi1 {
    static constexpr bool PERM = true, AFTER_DRAIN = false;
    bf16* P; bf16* PU; bf16* LR;
    DI void operator()(const f32x4 (&acc)[2][2][4][2], const pg8::Unit& u, int wr, int wc, int fr, int fq) const {
        const int row0 = u.pm * 256 + wr * 64 + fr;
        if (u.pn == 10) {
            if (wc == 0) {
#pragma unroll
                for (int ai = 0; ai < 2; ++ai)
#pragma unroll
                    for (int m = 0; m < 4; ++m) { bf16* p = LR + (size_t)(row0 + ai * 128 + m * 16) * 64 + (fq >> 1) * 32 + (fq & 1) * 8; u32x4 hv, lv;
#pragma unroll
                        for (int e = 0; e < 4; ++e) { const float x0 = acc[ai][0][m][e >> 1][(e & 1) * 2], x1 = acc[ai][0][m][e >> 1][(e & 1) * 2 + 1]; const unsigned hp = pk2(x0, x1);
                            hv[e] = hp; lv[e] = pk2(x0 - bflo(hp), x1 - bfhi(hp)); }
                        *(u32x4*)p = hv; *(u32x4*)(p + 16) = lv; }
            }
            return;
        }
        const bool act = u.pn >= 6;
        const int col0 = u.pn * 256 + wc * 32 + 8 * fq;
#pragma unroll
        for (int ai = 0; ai < 2; ++ai)
#pragma unroll
            for (int m = 0; m < 4; ++m) { const int row = row0 + ai * 128 + m * 16;
#pragma unroll
                for (int bj = 0; bj < 2; ++bj) { const int col = col0 + bj * 128;
                    bf16* dst = act ? PU + (size_t)row * PUS + (col - 1536) : P + ((size_t)(col / 384) * NTOK + row) * PHS + col % 384;
                    f32x4 v0 = acc[ai][bj][m][0], v1 = acc[ai][bj][m][1];
                    if (act) { pg8::f32x2 a = pg8::gelu_pk((pg8::f32x2){v0[0], v0[1]}), b = pg8::gelu_pk((pg8::f32x2){v0[2], v0[3]}), c = pg8::gelu_pk((pg8::f32x2){v1[0], v1[1]}), d = pg8::gelu_pk((pg8::f32x2){v1[2], v1[3]});
                        v0 = (f32x4){a.x, a.y, b.x, b.y}; v1 = (f32x4){c.x, c.y, d.x, d.y}; }
                    u32x4 w; w.x = pk2(v0[0], v0[1]); w.y = pk2(v0[2], v0[3]); w.z = pk2(v1[0], v1[1]); w.w = pk2(v1[2], v1[3]);
                    *(u32x4*)dst = w; } }
    }
};
template <int MODE> struct EpiRes {
    static constexpr bool PERM = true, AFTER_DRAIN = false;
    const float* xsc; const bf16* baseb; const float* aux  ; bf16* ob; float* ssq;
    DI void operator()(const f32x4 (&acc)[2][2][4][2], const pg8::Unit& u, int wr, int wc, int fr, int fq) const {
        const int row0 = u.pm * 256 + wr * 64 + fr, col0 = u.pn * 256 + wc * 32 + 8 * fq;
        f32x4 gi[2][2];
        if (MODE == 0) {
#pragma unroll
            for (int bj = 0; bj < 2; ++bj)
#pragma unroll
                for (int n = 0; n < 2; ++n) { const f32x4 gq = *(const f32x4*)(aux + col0 + bj * 128 + n * 4); gi[bj][n] = (f32x4){1.0f / gq[0], 1.0f / gq[1], 1.0f / gq[2], 1.0f / gq[3]}; } }
#pragma unroll
        for (int ai = 0; ai < 2; ++ai) {
            u32x4 bw[4][2]; float sc[4];
#pragma unroll
            for (int m = 0; m < 4; ++m) { if (MODE == 0) sc[m] = xsc[row0 + ai * 128 + m * 16];
#pragma unroll
                for (int bj = 0; bj < 2; ++bj) bw[m][bj] = *(const u32x4*)(baseb + (size_t)(row0 + ai * 128 + m * 16) * DM + col0 + bj * 128); }
#pragma unroll
            for (int m = 0; m < 4; ++m) { const int row = row0 + ai * 128 + m * 16; float s = 0.f;
#pragma unroll
                for (int bj = 0; bj < 2; ++bj) { const size_t o = (size_t)row * DM + col0 + bj * 128; const u32x4 w = bw[m][bj];
                    f32x4 v0 = (f32x4){bflo(w.x), bfhi(w.x), bflo(w.y), bfhi(w.y)}, v1 = (f32x4){bflo(w.z), bfhi(w.z), bflo(w.w), bfhi(w.w)};
                    if (MODE == 0) { v0 = v0 * sc[m] * gi[bj][0]; v1 = v1 * sc[m] * gi[bj][1]; }
                    v0 = v0 + acc[ai][bj][m][0]; v1 = v1 + acc[ai][bj][m][1];
                    s += ((v0[0] * v0[0] + v0[1] * v0[1]) + (v0[2] * v0[2] + v0[3] * v0[3])) + ((v1[0] * v1[0] + v1[1] * v1[1]) + (v1[2] * v1[2] + v1[3] * v1[3]));
                    if (MODE == 0) { u32x4 wo; wo.x = pk2(v0[0], v0[1]); wo.y = pk2(v0[2], v0[3]); wo.z = pk2(v1[0], v1[1]); wo.w = pk2(v1[2], v1[3]); *(u32x4*)(ob + o) = wo; }
                    else { *(f32x4*)((float*)aux + o) = v0; *(f32x4*)((float*)aux + o + 4) = v1; } }
                s += __shfl_xor(s, 16); s += __shfl_xor(s, 32);
                if (fq == 0) atomicAdd(ssq + row, s); }
        }
    }
};
struct EpiFinal {
    static constexpr bool PERM = true, AFTER_DRAIN = false;
    const bf16* base; float* out; float* ssq; unsigned* cnt; const float* gf;
    DI void operator()(f32x4 (&acc)[2][2][4][2], const pg8::Unit& u, int wr, int wc, int fr, int fq) const {
        const int row0 = u.pm * 256 + wr * 64 + fr, col0 = u.pn * 256 + wc * 32 + 8 * fq;
        u32x4 bw[2][4][2];
#pragma unroll
        for (int ai = 0; ai < 2; ++ai)
#pragma unroll
            for (int m = 0; m < 4; ++m)
#pragma unroll
                for (int bj = 0; bj < 2; ++bj) bw[ai][m][bj] = *(const u32x4*)(base + (size_t)(row0 + ai * 128 + m * 16) * DM + col0 + bj * 128);
        f32x4 gv[2][2];
#pragma unroll
        for (int bj = 0; bj < 2; ++bj)
#pragma unroll
            for (int n = 0; n < 2; ++n) gv[bj][n] = *(const f32x4*)(gf + col0 + bj * 128 + n * 4);
#pragma unroll
        for (int ai = 0; ai < 2; ++ai)
#pragma unroll
            for (int m = 0; m < 4; ++m) { const int row = row0 + ai * 128 + m * 16; float s = 0.f;
#pragma unroll
                for (int bj = 0; bj < 2; ++bj) { const u32x4 w = bw[ai][m][bj];
                    const f32x4 v0 = (f32x4){bflo(w.x), bfhi(w.x), bflo(w.y), bfhi(w.y)} + acc[ai][bj][m][0], v1 = (f32x4){bflo(w.z), bfhi(w.z), bflo(w.w), bfhi(w.w)} + acc[ai][bj][m][1];
                    acc[ai][bj][m][0] = v0; acc[ai][bj][m][1] = v1;
                    s += ((v0[0] * v0[0] + v0[1] * v0[1]) + (v0[2] * v0[2] + v0[3] * v0[3])) + ((v1[0] * v1[0] + v1[1] * v1[1]) + (v1[2] * v1[2] + v1[3] * v1[3])); }
                s += __shfl_xor(s, 16); s += __shfl_xor(s, 32);
                if (fq == 0) atomicAdd(ssq + row, s); }
        asm volatile("s_waitcnt vmcnt(0)" ::: "memory");
        unsigned* c = cnt + 64 * u.pm;
        if (fr == 0 && fq == 0) __hip_atomic_fetch_add(c, 1u, __ATOMIC_RELAXED, __HIP_MEMORY_SCOPE_AGENT);
        { unsigned sp = 0; while ((unsigned)__builtin_amdgcn_readfirstlane(__hip_atomic_load(c, __ATOMIC_RELAXED, __HIP_MEMORY_SCOPE_AGENT)) < 32u) { __builtin_amdgcn_s_sleep(2); if (++sp > (1u << 22)) break; } }
        float sv[8];
#pragma unroll
        for (int i = 0; i < 8; ++i) sv[i] = __hip_atomic_load(ssq + row0 + (i >> 2) * 128 + (i & 3) * 16, __ATOMIC_RELAXED, __HIP_MEMORY_SCOPE_AGENT);
#pragma unroll
        for (int ai = 0; ai < 2; ++ai)
#pragma unroll
            for (int m = 0; m < 4; ++m) { const int row = row0 + ai * 128 + m * 16; const float rs = rsqrtf(sv[ai * 4 + m] * (1.0f / 1024.0f) + EPS);
#pragma unroll
                for (int bj = 0; bj < 2; ++bj)
#pragma unroll
                    for (int n = 0; n < 2; ++n) *(f32x4*)(out + (size_t)row * DM + col0 + bj * 128 + n * 4) = acc[ai][bj][m][n] * rs * gv[bj][n]; }
    }
};
struct Epi3 {
    static constexpr bool PERM = true, AFTER_DRAIN = false;
    bf16* ACT; const float* ssq;
    DI void operator()(const f32x4 (&acc)[2][2][4][2], const pg8::Unit& u, int wr, int wc, int fr, int fq) const {
        const int row0 = u.pm * 256 + wr * 64 + fr, col0 = u.pn * 128 + wc * 32 + 8 * fq;
        float sv[8];
#pragma unroll
        for (int i = 0; i < 8; ++i) sv[i] = ssq[row0 + (i >> 2) * 128 + (i & 3) * 16];
#pragma unroll
        for (int ai = 0; ai < 2; ++ai)
#pragma unroll
            for (int m = 0; m < 4; ++m) { const int row = row0 + ai * 128 + m * 16; const float rs = rsqrtf(sv[ai * 4 + m] * (1.0f / 1024.0f) + EPS);
                float o[8];
#pragma unroll
                for (int n = 0; n < 2; ++n)
#pragma unroll
                    for (int e = 0; e < 4; ++e) o[n * 4 + e] = silu_f(acc[ai][0][m][n][e] * rs) * (acc[ai][1][m][n][e] * rs);
                u32x4 w; w.x = pk2(o[0], o[1]); w.y = pk2(o[2], o[3]); w.z = pk2(o[4], o[5]); w.w = pk2(o[6], o[7]);
                *(u32x4*)(ACT + (size_t)row * DFF + col0) = w; }
    }
};

DI void p0_item(const Args& A, int it, LAS float* scr, int tid) {
    int mat, ntile, kt;
    if (it < 704) { mat = 1; ntile = it >> 4; kt = it & 15; }
    else if (it < 960) { it -= 704; mat = 2; ntile = it >> 4; kt = it & 15; }
    else if (it < 2368) { it -= 960; mat = 3; ntile = it >> 4; kt = it & 15; }
    else { it -= 2368; mat = 4; ntile = it / 44; kt = it % 44; }
    const int kl = tid >> 3, n8 = tid & 7, nd = ntile * 64 + n8 * 8, k = kt * 64 + kl;
    const float* src = nullptr; int ldw = 0, sc = 0; float scale = 1.f; bf16* dst; int K = 1024;
    if (mat == 1) { ldw = PWSRC; dst = (bf16*)(A.ws + WS_BT1);
        if (nd < 1536) { const int hh = nd / 384, c = nd % 384; sc = c < 64 ? hh * 64 + c : (c < 128 ? 256 + hh * 64 + (c - 64) : (c < 256 ? 512 + hh * 128 + (c - 128) : 1024 + hh * 128 + (c - 256))); if (c < 64) scale = 0.125f; }
        else if (nd < 2560) sc = nd + 32; else if (nd < 2592) sc = nd - 2560 + 1536; else sc = -1;
        if (sc >= 0) src = A.in[2]; }
    else if (mat == 2) { ldw = 1024; dst = (bf16*)(A.ws + WS_BT2); sc = nd; src = A.in[12]; }
    else if (mat == 3) { ldw = DFF; dst = (bf16*)(A.ws + WS_BT3); const int tl = nd >> 8, r = nd & 255; if (r < 128) { src = A.in[14]; sc = tl * 128 + r; } else { src = A.in[15]; sc = tl * 128 + r - 128; } scale = A.in[13][k]; }
    else { ldw = 1024; dst = (bf16*)(A.ws + WS_BT4); sc = nd; src = A.in[16]; K = DFF; }
    f32x4 a = (f32x4){0.f, 0.f, 0.f, 0.f}, b = a;
    if (src) { const float* p = src + (size_t)k * ldw + sc; a = *(const f32x4*)p * scale; b = *(const f32x4*)(p + 4) * scale; }
    LAS float* w = scr + kl * 65 + n8 * 8;
    w[0] = a[0]; w[1] = a[1]; w[2] = a[2]; w[3] = a[3]; w[4] = b[0]; w[5] = b[1]; w[6] = b[2]; w[7] = b[3];
    __syncthreads();
    const int nl = tid >> 3, k8 = tid & 7; float v[8];
#pragma unroll
    for (int j = 0; j < 8; ++j) v[j] = scr[(k8 * 8 + j) * 65 + nl];
    u32x4 o; o.x = pk2(v[0], v[1]); o.y = pk2(v[2], v[3]); o.z = pk2(v[4], v[5]); o.w = pk2(v[6], v[7]);
    *(u32x4*)(dst + (size_t)(ntile * 64 + nl) * K + kt * 64 + k8 * 8) = o;
    __syncthreads();
}
DI void p0_prologue(const Args& A, LAS unsigned char* lds, int tid) {
    const int G = gridDim.x, bx = blockIdx.x, lane = tid & 63, wid = tid >> 6;
    for (int i = bx * 512 + tid; i < 65536; i += G * 512) ((float*)(A.ws + WS_SSQ1))[i] = 0.f;
    for (int i = bx * 512 + tid; i < 65536; i += G * 512) { ((bf16*)(A.ws + WS_WSB))[i] = (bf16)(pk2(A.in[10][i], 0.f) & 0xffffu); }
    for (int i = bx * 512 + tid; i < 512; i += G * 512) { const float* w = A.in[10] + (size_t)i * 128; float r = 0.f;
        for (int j = 0; j < 128; j += 4) { const f32x4 v = *(const f32x4*)(w + j); r += (v[0] + v[1]) + (v[2] + v[3]); }
        ((float*)(A.ws + WS_RSW))[i] = r; }
    for (int it = bx; it < 3072; it += G) p0_item(A, it, (LAS float*)lds, tid);
    const float* x = A.in[0]; const float* g1 = A.in[1]; bf16* H = (bf16*)(A.ws + WS_H);
    f32x4 gv[4];
#pragma unroll
    for (int j = 0; j < 4; ++j) gv[j] = *(const f32x4*)(g1 + lane * 4 + 256 * j);
    for (int row = bx * 8 + wid; row < NTOK; row += G * 8) {
        const float* xr = x + (size_t)row * DM; f32x4 v[4]; float s = 0.f;
#pragma unroll
        for (int j = 0; j < 4; ++j) { v[j] = *(const f32x4*)(xr + lane * 4 + 256 * j); s += (v[j][0] * v[j][0] + v[j][1] * v[j][1]) + (v[j][2] * v[j][2] + v[j][3] * v[j][3]); }
#pragma unroll
        for (int o = 1; o < 64; o <<= 1) s += __shfl_xor(s, o);
        const float rs = rsqrtf(s * (1.0f / 1024.0f) + EPS);
        if (lane == 0) ((float*)(A.ws + WS_XSC))[row] = sqrtf(s * (1.0f / 1024.0f) + EPS);
#pragma unroll
        for (int j = 0; j < 4; ++j) { const f32x4 y = v[j] * rs * gv[j]; u32x2 w; w.x = pk2(y[0], y[1]); w.y = pk2(y[2], y[3]); *(u32x2*)(H + (size_t)row * DM + lane * 4 + 256 * j) = w; }
    }
}

constexpr int GM_VTS = 136, GM_PART = (128 * GM_VTS + 16) * 2  , GM_LN = 4 * GM_PART;
static_assert(GM_LN + 4096 <= 151552 - 16, "gMLP LDS map");
DI void gmlp_phase(const Args& A, LAS unsigned char* lds, int tid) {
    const int lane = tid & 63, wid = tid >> 6, fr = lane & 15, fq = lane >> 4;
    const bf16* PU = (const bf16*)(A.ws + WS_PU); bf16* Y = (bf16*)(A.ws + WS_Y); const bf16* WS = (const bf16*)(A.ws + WS_WSB); const float* RSW = (const float*)(A.ws + WS_RSW);
    const float* bsp = A.in[11];
    LAS float* LN = (LAS float*)(lds + GM_LN);
    for (int unit = blockIdx.x; unit < 256; unit += gridDim.x) {
        const int tok0 = unit * 128, j = tid >> 2, part = tid & 3, irow = wid * 16 + fr;
        u32x4 w[16];
        { const bf16* p = PU + (size_t)(tok0 + j) * PUS + 512 + part * 128;
#pragma unroll
          for (int i = 0; i < 16; ++i) w[i] = *(const u32x4*)(p + i * 8); }
        bf16x8 wfn[4]; u32x4 uvn[4];
#define GM_LOADG(g_) do { _Pragma("unroll") for (int ks_ = 0; ks_ < 4; ++ks_) wfn[ks_] = *(const bf16x8*)(WS + (size_t)(g_) * 16384 + irow * 128 + ks_ * 32 + fq * 8); \
        _Pragma("unroll") for (int pp_ = 0; pp_ < 4; ++pp_) uvn[pp_] = *(const u32x4*)(PU + (size_t)(tok0 + irow) * PUS + (g_) * 128 + pp_ * 32 + 8 * fq); } while (0)
        lds_barrier();
        LN[tid] = A.in[8][tid]; LN[512 + tid] = A.in[9][tid];
        float sm = 0.f, sq = 0.f;
#pragma unroll
        for (int i = 0; i < 16; ++i)
#pragma unroll
            for (int e = 0; e < 4; ++e) { const float a = bflo(w[i][e]), b = bfhi(w[i][e]); sm += a + b; sq += a * a + b * b; }
        sm += __shfl_xor(sm, 1); sm += __shfl_xor(sm, 2); sq += __shfl_xor(sq, 1); sq += __shfl_xor(sq, 2);
        const float mean = sm * (1.0f / 512.0f), rstd = rsqrtf(fmaxf(sq * (1.0f / 512.0f) - mean * mean, 0.f) + EPS);
        LAS unsigned short* vt = (LAS unsigned short*)(lds + part * GM_PART) + j;
#pragma unroll
        for (int i = 0; i < 16; ++i)
#pragma unroll
            for (int e = 0; e < 4; ++e) { const unsigned pv = pk2((bflo(w[i][e]) - mean) * rstd, (bfhi(w[i][e]) - mean) * rstd); const int c = i * 8 + e * 2;
                vt[c * GM_VTS] = (unsigned short)(pv & 0xffffu); vt[(c + 1) * GM_VTS] = (unsigned short)(pv >> 16); }
        GM_LOADG(0);
        lds_barrier();
        for (int g = 0; g < 4; ++g) {
            bf16x8 wf[4]; u32x4 uv[4];
#pragma unroll
            for (int ks = 0; ks < 4; ++ks) wf[ks] = wfn[ks];
#pragma unroll
            for (int pp = 0; pp < 4; ++pp) uv[pp] = uvn[pp];
            if (g < 3) GM_LOADG(g + 1);
            const float bias = bsp[g * 128 + irow], rsw = RSW[g * 128 + irow];
#pragma unroll
            for (int pp = 0; pp < 4; ++pp) {
                f32x4 a0 = (f32x4){0.f, 0.f, 0.f, 0.f}, a1 = a0;
#pragma unroll
                for (int ks = 0; ks < 4; ++ks) { a0 = mfma16(lds_frag(lds + g * GM_PART + ((32 * pp + 8 * (fr >> 2) + (fr & 3)) * GM_VTS + ks * 32 + fq * 8) * 2), wf[ks], a0);
                    a1 = mfma16(lds_frag(lds + g * GM_PART + ((32 * pp + 8 * (fr >> 2) + 4 + (fr & 3)) * GM_VTS + ks * 32 + fq * 8) * 2), wf[ks], a1); }
                const int c = 32 * pp + 8 * fq; const u32x4 uu = uv[pp];
                const f32x4 lg0 = *(LAS const f32x4*)(LN + g * 128 + c), lg1 = *(LAS const f32x4*)(LN + g * 128 + c + 4), lb0 = *(LAS const f32x4*)(LN + 512 + g * 128 + c), lb1 = *(LAS const f32x4*)(LN + 512 + g * 128 + c + 4);
                u32x4 o; o.x = pk2(bflo(uu.x) * (lg0[0] * a0[0] + lb0[0] * rsw + bias), bfhi(uu.x) * (lg0[1] * a0[1] + lb0[1] * rsw + bias));
                o.y = pk2(bflo(uu.y) * (lg0[2] * a0[2] + lb0[2] * rsw + bias), bfhi(uu.y) * (lg0[3] * a0[3] + lb0[3] * rsw + bias));
                o.z = pk2(bflo(uu.z) * (lg1[0] * a1[0] + lb1[0] * rsw + bias), bfhi(uu.z) * (lg1[1] * a1[1] + lb1[1] * rsw + bias));
                o.w = pk2(bflo(uu.w) * (lg1[2] * a1[2] + lb1[2] * rsw + bias), bfhi(uu.w) * (lg1[3] * a1[3] + lb1[3] * rsw + bias));
                *(u32x4*)(Y + (size_t)(tok0 + irow) * DM + 512 + g * 128 + c) = o; }
        }
#undef GM_LOADG
    }
}

constexpr int G_LR = 0, G_WD = 8192, G_BD = 16384, G_SEG = 16896, G_LA = 18944, G_A0 = 52224, RS72 = 72;
constexpr int GA_KTF = G_A0, GA_KTB = G_A0 + 9216, GA_VT = G_A0 + 18432;
constexpr int GC_QDF = G_A0, GC_QDB = G_A0 + 9216, GC_KDF = G_A0 + 18432, GC_KDB = G_A0 + 27648, GC_VT = G_A0 + 36864, GC_SS = GC_VT + 18432, GC_RS = GC_SS + 9216;
constexpr int GC_STF = 0, GC_STB = 132096;
static_assert(GC_RS + 512 <= 131072 && GC_STF + 18432 <= G_LA && GC_STB + 18432 <= 151552 - 16, "GLA LDS map");
struct DecayW { bf16x8 bh, bl; float bias; };
DI unsigned hi16(float x) { return pk2(x, 0.f) & 0xffffu; }
DI DecayW gla_decay_w(const Args& A, int h, int wid, int fr, int fq) {
    const int dir = wid >> 2, d = h * 64 + 16 * (wid & 3) + fr; const float* w = (dir ? A.in[5] : A.in[3]) + ((fq & 1) * 8) * 256 + d;
    DecayW o; unsigned hh[8], ll[8];
#pragma unroll
    for (int j = 0; j < 8; ++j) { const float x = w[j * 256]; hh[j] = hi16(x); ll[j] = (fq < 2) ? hi16(x - __uint_as_float(hh[j] << 16)) : 0u; }
    u32x4 a, b;
#pragma unroll
    for (int e = 0; e < 4; ++e) { a[e] = hh[2 * e] | (hh[2 * e + 1] << 16); b[e] = ll[2 * e] | (ll[2 * e + 1] << 16); }
    o.bh = __builtin_bit_cast(bf16x8, a); o.bl = __builtin_bit_cast(bf16x8, b); o.bias = (dir ? A.in[6] : A.in[4])[d];
    return o;
}
struct LrRows { bf16x8 v[4]; };
DI LrRows gla_load_lr(const bf16* LRg, int tok0, int wid, int fr, int fq) {
    LrRows o; const bf16* p = LRg + (size_t)(tok0 + fr) * 64 + (wid >> 2) * 32 + fq * 8;
#pragma unroll
    for (int tt = 0; tt < 4; ++tt) o.v[tt] = *(const bf16x8*)(p + tt * 1024);
    return o;
}
DI void gla_decay(LAS unsigned char* lds, const LrRows& L, const DecayW& W, int wid, int fr, int fq) {
    LAS float* LA = (LAS float*)(lds + G_LA); const int dir = wid >> 2, d = 16 * (wid & 3) + fr;
    float la[4][4], p[4][4], S[4], ex[4], tot[4];
#pragma unroll
    for (int tt = 0; tt < 4; ++tt) {
        const bf16x8 a1 = L.v[tt]; const bf16x8 a2 = (fq < 2) ? a1 : (bf16x8){0, 0, 0, 0, 0, 0, 0, 0};
        f32x4 z = (f32x4){0.f, 0.f, 0.f, 0.f};
        z = mfma16(a1, W.bh, z); z = mfma16(a2, W.bl, z);
#pragma unroll
        for (int r = 0; r < 4; ++r) la[tt][r] = logsig(z[r] + W.bias) * (1.0f / 16.0f);
        p[tt][0] = la[tt][0]; p[tt][1] = p[tt][0] + la[tt][1]; p[tt][2] = p[tt][1] + la[tt][2]; p[tt][3] = p[tt][2] + la[tt][3]; S[tt] = p[tt][3];
    }
#pragma unroll
    for (int tt = 0; tt < 4; ++tt) { const float s1 = __shfl_xor(S[tt], 16), s2 = __shfl_xor(S[tt], 32), s3 = __shfl_xor(s1, 32);
        tot[tt] = (S[tt] + s1) + (s2 + s3); ex[tt] = fq == 0 ? 0.f : (fq == 1 ? s1 : (fq == 2 ? s2 + s3 : s1 + s2 + s3)); }
    const float T = (tot[0] + tot[1]) + (tot[2] + tot[3]); float base = 0.f;
#pragma unroll
    for (int tt = 0; tt < 4; ++tt) {
#pragma unroll
        for (int r = 0; r < 4; ++r) { const float pre = base + ex[tt] + p[tt][r]; LA[(dir * 64 + 16 * tt + 4 * fq + r) * 65 + d] = dir ? (T - pre + la[tt][r]) : pre; }
        base += tot[tt]; }
    lds_barrier();
}
DI void gla_build_vt(const u32x4 a, const u32x4 b, LAS unsigned char* vtb, int tid) {
    const int sp = tid & 31, dvb = tid >> 5; LAS unsigned* vt = (LAS unsigned*)vtb;
#pragma unroll
    for (int e = 0; e < 4; ++e) { const int dv = dvb * 8 + 2 * e;
        vt[dv * (RS72 / 2) + sp] = (a[e] & 0xffffu) | (b[e] << 16);
        vt[(dv + 1) * (RS72 / 2) + sp] = (a[e] >> 16) | (b[e] & 0xffff0000u); }
}
DI size_t st_off(int dir, int b, int h, int n) { return ((size_t)((dir * 4 + b) * 4 + h) * 128 + n) * 8192; }
DI void gla_pass_a(const Args& A, LAS unsigned char* lds, int tid) {
    const int lane = tid & 63, wid = tid >> 6, fr = lane & 15, fq = lane >> 4;
    const bf16* P = (const bf16*)(A.ws + WS_P); bf16* ST = (bf16*)(A.ws + WS_ST); float* DEC = (float*)(A.ws + WS_DEC);
    LAS float* LA = (LAS float*)(lds + G_LA);
    const bf16* LRg = (const bf16*)(A.ws + WS_LR); int h_loaded = -1; DecayW dw; dw.bh = (bf16x8){0,0,0,0,0,0,0,0}; dw.bl = dw.bh; dw.bias = 0.f;
    const int sp = tid & 31, db = tid >> 5;
    LrRows lrn; u32x2 k0n, k1n; u32x4 van, vbn;
#define GA_LOAD(un) do { const int h_ = (un) & 3, tok_ = ((un) >> 2) * 64; lrn = gla_load_lr(LRg, tok_, wid, fr, fq); \
        const bf16* kp_ = P + ((size_t)h_ * NTOK + tok_ + 2 * sp) * PHS + 64 + db * 4; k0n = *(const u32x2*)kp_; k1n = *(const u32x2*)(kp_ + PHS); \
        const bf16* vp_ = P + ((size_t)h_ * NTOK + tok_ + 2 * sp) * PHS + 128 + db * 8; van = *(const u32x4*)vp_; vbn = *(const u32x4*)(vp_ + PHS); } while (0)
    if (blockIdx.x < 2048) GA_LOAD(blockIdx.x);
    for (int unit = blockIdx.x; unit < 2048; unit += gridDim.x) {
        const int h = unit & 3, cn = unit >> 2, b = cn >> 7, n = cn & 127;
        if (h != h_loaded) { dw = gla_decay_w(A, h, wid, fr, fq); h_loaded = h; }
        const LrRows lrc = lrn; const u32x2 k0 = k0n, k1 = k1n; const u32x4 va = van, vb = vbn;
        if (unit + (int)gridDim.x < 2048) GA_LOAD(unit + gridDim.x);
        gla_decay(lds, lrc, dw, wid, fr, fq);
        {
            const float kk0[4] = {bflo(k0.x), bfhi(k0.x), bflo(k0.y), bfhi(k0.y)}, kk1[4] = {bflo(k1.x), bfhi(k1.x), bflo(k1.y), bfhi(k1.y)};
#pragma unroll
            for (int dir = 0; dir < 2; ++dir) { LAS unsigned* kt = (LAS unsigned*)(lds + (dir ? GA_KTB : GA_KTF));
#pragma unroll
                for (int j = 0; j < 4; ++j) { const int d = db * 4 + j; const float be = LA[(dir * 64 + (dir ? 0 : 63)) * 65 + d];
                    const float e0 = __expf(be - LA[(dir * 64 + 2 * sp) * 65 + d]), e1 = __expf(be - LA[(dir * 64 + 2 * sp + 1) * 65 + d]);
                    kt[d * (RS72 / 2) + sp] = pk2(kk0[j] * e0, kk1[j] * e1); } }
            if (tid < 128) { const int dir = tid >> 6, d = tid & 63; DEC[((size_t)((dir * 4 + b) * 4 + h) * 128 + n) * 64 + d] = __expf(LA[(dir * 64 + (dir ? 0 : 63)) * 65 + d]); }
        }
        gla_build_vt(va, vb, lds + GA_VT, tid);
        lds_barrier();
        {
            const int dir = wid >> 2, dvt0 = (wid & 3) * 2; LAS const unsigned char* kt = lds + (dir ? GA_KTB : GA_KTF);
            bf16x8 yv[2][2];
#pragma unroll
            for (int dvi = 0; dvi < 2; ++dvi)
#pragma unroll
                for (int ks = 0; ks < 2; ++ks) yv[dvi][ks] = lds_frag(lds + GA_VT + (((dvt0 + dvi) * 16 + fr) * RS72 + ks * 32 + fq * 8) * 2);
            bf16* stp = ST + st_off(dir, b, h, n);
#pragma unroll
            for (int pp = 0; pp < 2; ++pp) {
                bf16x8 x[2][2];
#pragma unroll
                for (int nn = 0; nn < 2; ++nn)
#pragma unroll
                    for (int ks = 0; ks < 2; ++ks) x[nn][ks] = lds_frag(kt + ((32 * pp + 8 * (fr >> 2) + 4 * nn + (fr & 3)) * RS72 + ks * 32 + fq * 8) * 2);
#pragma unroll
                for (int dvi = 0; dvi < 2; ++dvi) { f32x4 a0 = (f32x4){0.f, 0.f, 0.f, 0.f}, a1 = a0;
                    a0 = mfma16(x[0][0], yv[dvi][0], a0); a0 = mfma16(x[0][1], yv[dvi][1], a0); a1 = mfma16(x[1][0], yv[dvi][0], a1); a1 = mfma16(x[1][1], yv[dvi][1], a1);
                    u32x4 w; w.x = pk2(a0[0], a0[1]); w.y = pk2(a0[2], a0[3]); w.z = pk2(a1[0], a1[1]); w.w = pk2(a1[2], a1[3]);
                    *(u32x4*)(stp + ((dvt0 + dvi) * 16 + fr) * 64 + 32 * pp + 8 * fq) = w; } }
        }
    }
    lds_barrier();
#undef GA_LOAD
}
DI void gla_scan(const Args& A, LAS unsigned char* lds, int tid) {
    unsigned* ST = (unsigned*)(A.ws + WS_ST); const float* DEC = (const float*)(A.ws + WS_DEC); LAS float* DL = (LAS float*)lds;
    for (int g0 = blockIdx.x * 512; g0 < 131072; g0 += gridDim.x * 512) {
        const int gt = g0 + tid, seq = g0 >> 12, e2 = gt & 4095, dir = seq >> 4, dk = (2 * e2) & 63;
        __syncthreads();
#pragma unroll
        for (int i = 0; i < 4; ++i) *(LAS f32x4*)(DL + (tid + 512 * i) * 4) = *(const f32x4*)(DEC + (size_t)seq * 8192 + (tid + 512 * i) * 4);
        __syncthreads();
        unsigned* sp = ST + (size_t)seq * 128 * 4096 + e2;
        float s0 = 0.f, s1 = 0.f;
        unsigned nx[32];
#pragma unroll
        for (int j = 0; j < 32; ++j) { const int n = dir ? 127 - j : j; nx[j] = __builtin_nontemporal_load(sp + (size_t)n * 4096); }
#pragma unroll 1
        for (int i0 = 0; i0 < 128; i0 += 32) {
            unsigned ds[32];
#pragma unroll
            for (int j = 0; j < 32; ++j) ds[j] = nx[j];
            if (i0 + 32 < 128) {
#pragma unroll
                for (int j = 0; j < 32; ++j) { const int n = dir ? 127 - (i0 + 32 + j) : i0 + 32 + j; nx[j] = __builtin_nontemporal_load(sp + (size_t)n * 4096); } }
#pragma unroll
            for (int j = 0; j < 32; ++j) { const int n = dir ? 127 - (i0 + j) : i0 + j; const float d0 = DL[n * 64 + dk], d1 = DL[n * 64 + dk + 1];
                sp[(size_t)n * 4096] = pk2(s0, s1); s0 = d0 * s0 + bflo(ds[j]); s1 = d1 * s1 + bfhi(ds[j]); }
        }
    }
}
DI void gla_pass_c(const Args& A, LAS unsigned char* lds, int tid) {
    const int lane = tid & 63, wid = tid >> 6, fr = lane & 15, fq = lane >> 4;
    const bf16* P = (const bf16*)(A.ws + WS_P); const bf16* ST = (const bf16*)(A.ws + WS_ST); bf16* Y = (bf16*)(A.ws + WS_Y);
    LAS float* LA = (LAS float*)(lds + G_LA); LAS float* RS = (LAS float*)(lds + GC_RS);
    const bf16* LRg = (const bf16*)(A.ws + WS_LR); int h_loaded = -1; DecayW dw; dw.bh = (bf16x8){0,0,0,0,0,0,0,0}; dw.bl = dw.bh; dw.bias = 0.f;
    const int t = tid >> 3, d8 = (tid & 7) * 8, vsp = tid & 31, vdb = tid >> 5, ott = wid & 3, odvh = wid >> 2, ot = ott * 16 + fr;
    LrRows lrn; u32x4 qn, kn, van, vbn, stn[4]; u32x2 ggn[4]; f32x4 ngv[4];
#pragma unroll
    for (int i = 0; i < 4; ++i) ngv[i] = (f32x4){0.f, 0.f, 0.f, 0.f};
#define GC_LOAD(un) do { const int h_ = (un) & 3, cn_ = (un) >> 2, tok_ = cn_ * 64; lrn = gla_load_lr(LRg, tok_, wid, fr, fq); \
        const bf16* qp_ = P + ((size_t)h_ * NTOK + tok_ + t) * PHS + d8; qn = *(const u32x4*)qp_; kn = *(const u32x4*)(qp_ + 64); \
        const bf16* vp_ = P + ((size_t)h_ * NTOK + tok_ + 2 * vsp) * PHS + 128 + vdb * 8; van = *(const u32x4*)vp_; vbn = *(const u32x4*)(vp_ + PHS); \
        _Pragma("unroll") for (int i_ = 0; i_ < 4; ++i_) { const int ci_ = tid + 512 * i_; stn[i_] = *(const u32x4*)(ST + st_off(ci_ >> 10, cn_ >> 7, h_, cn_ & 127) + (ci_ & 1023) * 8); } \
        _Pragma("unroll") for (int dvi_ = 0; dvi_ < 4; ++dvi_) ggn[dvi_] = *(const u32x2*)(P + ((size_t)h_ * NTOK + tok_ + ot) * PHS + 256 + (odvh * 4 + dvi_) * 16 + 4 * fq); } while (0)
    if (blockIdx.x < 2048) GC_LOAD(blockIdx.x);
    for (int unit = blockIdx.x; unit < 2048; unit += gridDim.x) {
        const int h = unit & 3, cn = unit >> 2, tok0 = cn * 64;
        if (h != h_loaded) { dw = gla_decay_w(A, h, wid, fr, fq); h_loaded = h;
#pragma unroll
            for (int dvi = 0; dvi < 4; ++dvi) ngv[dvi] = *(const f32x4*)(A.in[7] + h * 128 + (odvh * 4 + dvi) * 16 + 4 * fq); }
        const LrRows lrc = lrn; const u32x4 q = qn, k = kn, va = van, vb = vbn; u32x4 stc[4]; u32x2 gg[4];
#pragma unroll
        for (int i = 0; i < 4; ++i) { stc[i] = stn[i]; gg[i] = ggn[i]; }
        if (unit + (int)gridDim.x < 2048) GC_LOAD(unit + gridDim.x);
        DUP(13) gla_decay(lds, lrc, dw, wid, fr, fq);
        DUP(10) {
#pragma unroll
            for (int dir = 0; dir < 2; ++dir) { u32x4 qo, ko;
#pragma unroll
                for (int e = 0; e < 4; ++e) { const float b0 = LA[(dir * 64 + t) * 65 + d8 + 2 * e], b1 = LA[(dir * 64 + t) * 65 + d8 + 2 * e + 1];
                    qo[e] = pk2(bflo(q[e]) * __expf(b0), bfhi(q[e]) * __expf(b1)); ko[e] = pk2(bflo(k[e]) * __expf(-b0), bfhi(k[e]) * __expf(-b1)); }
                *(LAS u32x4*)(lds + (dir ? GC_QDB : GC_QDF) + (t * RS72 + d8) * 2) = qo; *(LAS u32x4*)(lds + (dir ? GC_KDB : GC_KDF) + (t * RS72 + d8) * 2) = ko; }
        }
        gla_build_vt(va, vb, lds + GC_VT, tid);
#pragma unroll
        for (int i = 0; i < 4; ++i) { const int ci = tid + 512 * i, cc = ci & 1023; *(LAS u32x4*)(lds + ((ci >> 10) ? GC_STB : GC_STF) + ((cc >> 3) * RS72 + (cc & 7) * 8) * 2) = stc[i]; }
        lds_barrier();
        DUP(11) {
#pragma unroll
            for (int ti = 0; ti < 2; ++ti) { const int tile = wid * 2 + ti, tt = tile >> 2, st = tile & 3;
                f32x4 af = (f32x4){0.f, 0.f, 0.f, 0.f}, ab = af;
                if (st <= tt) {
#pragma unroll
                    for (int ks = 0; ks < 2; ++ks) af = mfma16(lds_frag(lds + GC_KDF + ((st * 16 + fr) * RS72 + ks * 32 + fq * 8) * 2), lds_frag(lds + GC_QDF + ((tt * 16 + fr) * RS72 + ks * 32 + fq * 8) * 2), af); }
                if (st >= tt) {
#pragma unroll
                    for (int ks = 0; ks < 2; ++ks) ab = mfma16(lds_frag(lds + GC_KDB + ((st * 16 + fr) * RS72 + ks * 32 + fq * 8) * 2), lds_frag(lds + GC_QDB + ((tt * 16 + fr) * RS72 + ks * 32 + fq * 8) * 2), ab); }
                const int t = tt * 16 + fr, s0 = st * 16 + 4 * fq; float v[4];
#pragma unroll
                for (int r = 0; r < 4; ++r) v[r] = ((s0 + r) <= t ? af[r] : 0.f) + ((s0 + r) >= t ? ab[r] : 0.f);
                u32x2 w; w.x = pk2(v[0], v[1]); w.y = pk2(v[2], v[3]);
                *(LAS u32x2*)(lds + GC_SS + (t * RS72 + s0) * 2) = w; }
        }
        lds_barrier();
        DUP(12) {
            const int tt = wid & 3, dvh = wid >> 2, t = tt * 16 + fr;
            bf16x8 yv[6];
#pragma unroll
            for (int ks = 0; ks < 2; ++ks) { yv[ks] = lds_frag(lds + GC_SS + (t * RS72 + ks * 32 + fq * 8) * 2); yv[2 + ks] = lds_frag(lds + GC_QDF + (t * RS72 + ks * 32 + fq * 8) * 2); yv[4 + ks] = lds_frag(lds + GC_QDB + (t * RS72 + ks * 32 + fq * 8) * 2); }
            f32x4 acc[4]; float q = 0.f;
#pragma unroll
            for (int dvi = 0; dvi < 4; ++dvi) { const int dvr = (dvh * 4 + dvi) * 16 + fr; f32x4 a = (f32x4){0.f, 0.f, 0.f, 0.f};
#pragma unroll
                for (int ks = 0; ks < 2; ++ks) { a = mfma16(lds_frag(lds + GC_VT + (dvr * RS72 + ks * 32 + fq * 8) * 2), yv[ks], a);
                    a = mfma16(lds_frag(lds + GC_STF + (dvr * RS72 + ks * 32 + fq * 8) * 2), yv[2 + ks], a); a = mfma16(lds_frag(lds + GC_STB + (dvr * RS72 + ks * 32 + fq * 8) * 2), yv[4 + ks], a); }
                acc[dvi] = a; q += (a[0] * a[0] + a[1] * a[1]) + (a[2] * a[2] + a[3] * a[3]); }
            q += __shfl_xor(q, 16); q += __shfl_xor(q, 32);
            if (fq == 0) RS[dvh * 64 + t] = q;
            lds_barrier();
            const float rn = rsqrtf((RS[t] + RS[64 + t]) * (1.0f / 128.0f) + EPS);
#pragma unroll
            for (int dvi = 0; dvi < 4; ++dvi) { const int col = h * 128 + (dvh * 4 + dvi) * 16 + 4 * fq;
                const f32x4 ng = ngv[dvi]; const f32x4 a = acc[dvi];
                u32x2 w; w.x = pk2(a[0] * rn * ng[0] * silu_f(bflo(gg[dvi].x)), a[1] * rn * ng[1] * silu_f(bfhi(gg[dvi].x))); w.y = pk2(a[2] * rn * ng[2] * silu_f(bflo(gg[dvi].y)), a[3] * rn * ng[3] * silu_f(bfhi(gg[dvi].y)));
                *(u32x2*)(Y + (size_t)(tok0 + t) * DM + col) = w; }
        }
    }
    lds_barrier();
#undef GC_LOAD
}
DI void final_norm(const Args& A, int tid, float* dst) {
    const int lane = tid & 63, wid = tid >> 6; const float* ssq = (const float*)(A.ws + WS_SSQ2); const float* gf = A.in[17];
    f32x4 gv[4];
#pragma unroll
    for (int j = 0; j < 4; ++j) gv[j] = *(const f32x4*)(gf + lane * 4 + 256 * j);
    for (int row = blockIdx.x * 8 + wid; row < NTOK; row += gridDim.x * 8) { float* xr = A.out + (size_t)row * DM; float* dr = dst + (size_t)row * DM; const float rs = rsqrtf(ssq[row] * (1.0f / 1024.0f) + EPS);
#pragma unroll
        for (int j = 0; j < 4; ++j) { const int o = lane * 4 + 256 * j; *(f32x4*)(dr + o) = *(const f32x4*)(xr + o) * rs * gv[j]; } }
}

__global__ void __launch_bounds__(512, 2) fwd_kernel(Args args) {
    extern __shared__ __attribute__((aligned(16))) unsigned char lds_raw[];
    LAS unsigned char* lds = (LAS unsigned char*)lds_raw;
    const int tid = threadIdx.x, lo = args.ph_lo, hi = args.ph_hi;
#define IN(k) (lo <= (k) && (k) < hi)
    volatile LAS unsigned* xst = (volatile LAS unsigned*)(lds + LDS_BYTES - 16);
    if (tid < 2) xst[tid] = 0u;
    __syncthreads();
    const XcdBarrier xbar = xcd_barrier_post((unsigned*)(args.ws + WS_BAR), xst);
    if (hi > NPH) cg::this_grid().sync();
#define SEAM(k) do { if (IN(k) && IN((k) + 1)) xcd_barrier(xbar); } while (0)
    if (IN(0)) { DUP(0) p0_prologue(args, lds, tid); } SEAM(0);
    if (IN(1)) { pg8::Gemm g{(const bf16*)(args.ws + WS_H), (const bf16*)(args.ws + WS_BT1), NTOK, N1, DM}; OrderG1 S; S.init(gridDim.x, blockIdx.x);
        Epi1 E{(bf16*)(args.ws + WS_P), (bf16*)(args.ws + WS_PU), (bf16*)(args.ws + WS_LR)};
        pg8::gemm_phase<Epi1, OrderG1, true, true, 10>(lds, g, S, E); } SEAM(1);
    if (IN(2)) { DUP(2) { gmlp_phase(args, lds, tid); __syncthreads(); } DUP(3) { gla_pass_a(args, lds, tid); } } SEAM(2);
    if (IN(3)) { gla_scan(args, lds, tid); if ((PROBE_DUP >> 9) & 1) { xcd_barrier(xbar); gla_pass_a(args, lds, tid); xcd_barrier(xbar); gla_scan(args, lds, tid); } } SEAM(3);
    if (IN(4)) { DUP(4) gla_pass_c(args, lds, tid); } SEAM(4);
    if (IN(5)) { pg8::Gemm g{(const bf16*)(args.ws + WS_Y), (const bf16*)(args.ws + WS_BT2), NTOK, DM, DM}; pg8::StaticOrder S; S.init(NTOK, DM, gridDim.x, blockIdx.x);
        EpiRes<0> E{(const float*)(args.ws + WS_XSC), (const bf16*)(args.ws + WS_H), args.in[1], (bf16*)(args.ws + WS_ST), (float*)(args.ws + WS_SSQ1)}; pg8::gemm_phase<EpiRes<0>, pg8::StaticOrder, true, true>(lds, g, S, E); } SEAM(5);
    if (IN(6)) { pg8::Gemm g{(const bf16*)(args.ws + WS_ST), (const bf16*)(args.ws + WS_BT3), NTOK, N3, DM}; pg8::StaticOrder S; S.init(NTOK, N3, gridDim.x, blockIdx.x);
        Epi3 E{(bf16*)(args.ws + WS_P), (const float*)(args.ws + WS_SSQ1)}; DUP(6) pg8::gemm_phase<Epi3, pg8::StaticOrder, true, true>(lds, g, S, E); } SEAM(6);
    if (IN(7)) { pg8::Gemm g{(const bf16*)(args.ws + WS_P), (const bf16*)(args.ws + WS_BT4), NTOK, DM, DFF}; pg8::StaticOrder S; S.init(NTOK, DM, gridDim.x, blockIdx.x);
        if (gridDim.x == 256) {
            EpiFinal E{(const bf16*)(args.ws + WS_ST), args.out, (float*)(args.ws + WS_SSQ2), (unsigned*)(args.ws + WS_CNT), args.in[17]}; pg8::gemm_phase<EpiFinal, pg8::StaticOrder, true, true>(lds, g, S, E); }
        else { EpiRes<1> E{nullptr, (const bf16*)(args.ws + WS_ST), (const float*)args.out, nullptr, (float*)(args.ws + WS_SSQ2)}; pg8::gemm_phase<EpiRes<1>, pg8::StaticOrder, true, true>(lds, g, S, E); } }
    if (gridDim.x != 256) SEAM(7);
    if (IN(8) && gridDim.x != 256) { final_norm(args, tid, args.out); }
#undef IN
#undef SEAM
}

extern "C" void kernel_launch(void* const* d_in, const int* in_sizes, int n_in, void* d_out, int out_size, void* d_ws, size_t ws_size, hipStream_t stream) {
    static int grid = 0;
    if (grid == 0) {
        if (n_in != 18 || out_size != NTOK * DM || ws_size < WS_END) { fprintf(stderr, "kernel_launch: unexpected shapes (n_in %d out %d ws %zu)\n", n_in, out_size, ws_size); grid = -1; return; }
        int dev = 0, cus = 0, per_cu = 0;
        hipGetDevice(&dev); hipDeviceGetAttribute(&cus, hipDeviceAttributeMultiprocessorCount, dev);
        if (hipFuncSetAttribute((const void*)fwd_kernel, hipFuncAttributeMaxDynamicSharedMemorySize, LDS_BYTES) != hipSuccess) { fprintf(stderr, "kernel_launch: hipFuncSetAttribute failed\n"); grid = -1; return; }
        if (hipOccupancyMaxActiveBlocksPerMultiprocessor(&per_cu, (const void*)fwd_kernel, 512, LDS_BYTES) != hipSuccess || per_cu < 1) { fprintf(stderr, "kernel_launch: occupancy query says %d\n", per_cu); per_cu = 1; }
        (void)hipGetLastError();
        grid = cus * 1;
        fprintf(stderr, "kernel_launch: grid %d (cus %d, per_cu %d)\n", grid, cus, per_cu);
    }
    if (grid < 0) return;
    Args a{};
    for (int i = 0; i < 18; ++i) a.in[i] = (const float*)d_in[i];
    a.out = (float*)d_out; a.ws = (unsigned char*)d_ws;
    if (hipMemsetAsync((char*)d_ws + WS_BAR, 0, WS_BAR_BYTES, stream) != hipSuccess) { fprintf(stderr, "kernel_launch: memset failed\n"); return; }
#if MK_N_LAUNCHES == 1
    a.ph_lo = 0; a.ph_hi = NPH;
    void* kargs[] = {&a};
    hipError_t e = hipLaunchCooperativeKernel((const void*)fwd_kernel, dim3(grid), dim3(512), kargs, LDS_BYTES, stream);
    if (e != hipSuccess) fprintf(stderr, "kernel_launch: cooperative launch failed: %s (grid %d)\n", hipGetErrorString(e), grid);
#else
    for (int ph = 0; ph < 9; ++ph) { a.ph_lo = ph; a.ph_hi = ph + 1; hipLaunchKernelGGL(fwd_kernel, dim3(grid), dim3(512), LDS_BYTES, stream, a); }
#endif
}
```

```cpp
#include <hip/hip_runtime.h>
#include <hip/hip_cooperative_groups.h>
#include <cstdio>
#include <cstdint>
namespace pg8 {
#define PG8_LAS __attribute__((address_space(3)))
typedef unsigned short bf16_t;
typedef short bf16x8 __attribute__((ext_vector_type(8)));
typedef float f32x4 __attribute__((ext_vector_type(4)));
typedef unsigned u32x4 __attribute__((ext_vector_type(4)));
constexpr int BM = 256, BK = 64, HALF = 128, HTB = HALF * BK * 2  , STAGE_BYTES = 8 * HTB, NXCD = 8, WGM = 8;

__host__ __device__ __forceinline__ int lds_byte(int r, int c) { const int st = (r >> 4) * 2 + (c >> 5), rr = r & 15, cc = c & 31, ob = rr * 64 + cc * 2; return st * 1024 + (ob ^ (((ob >> 9) & 1) << 5)); }
__host__ __device__ __forceinline__ void stage_rc(int b, int& R, int& C) { const int st = b / 1024, sb = b % 1024, swz = sb ^ (((sb >> 9) & 1) << 5); R = (st >> 1) * 16 + swz / 64; C = (st & 1) * 32 + (swz % 64) / 2; }
__host__ __device__ __forceinline__ int perm32(int rho) { const int n = rho >> 4, i = rho & 15; return 8 * (i >> 2) + 4 * n + (i & 3); }

struct Unit { int pm, pn; };
struct Gemm { const bf16_t* A; const bf16_t* Bt; int M, N, K; };

struct StaticOrder {
    int nM, nN, nwg, G, c;
    __host__ __device__ void init(int M, int N, int G_, int c_) { nM = M / BM; nN = N / BM; nwg = nM * nN; G = G_; c = c_; }
    __host__ __device__ bool next(int i, Unit& u) const {
        const long L = (long)i * G + c; if (L >= nwg) return false;
        int wgid = (int)L; { const int q = nwg / NXCD, r = nwg % NXCD, xcd = wgid % NXCD, off = wgid / NXCD; wgid = (xcd < r ? xcd * (q + 1) : r * (q + 1) + (xcd - r) * q) + off; }
        const int nig = WGM * nN, gid = wgid / nig, fm = gid * WGM, gsz = (nM - fm) < WGM ? (nM - fm) : WGM;
        u.pm = fm + ((wgid % nig) % gsz); u.pn = (wgid % nig) / gsz; return true;
    }
    __device__ __forceinline__ void a_ready(const Unit&) const {}
    __device__ __forceinline__ void done(const Unit&) const {}
};
__device__ __forceinline__ unsigned cvt_pk_bf16(float lo, float hi) { unsigned r; asm volatile("v_cvt_pk_bf16_f32 %0, %1, %2" : "=v"(r) : "v"(lo), "v"(hi)); return r; }
typedef float f32x2 __attribute__((ext_vector_type(2)));
__device__ __forceinline__ f32x2 gelu_pk(f32x2 v) {
    const f32x2 av = __builtin_elementwise_abs(v), d = av * 0.2316418882f + 1.0f;
    f32x2 t; t.x = __builtin_amdgcn_rcpf(d.x); t.y = __builtin_amdgcn_rcpf(d.y);
    f32x2 q = t * 0.5307027145f + (-0.7265760135f); q = q * t + 0.7107068705f; q = q * t + (-0.142248368f); q = q * t + 0.127414796f; q = q * t;
    const f32x2 s = (v * v) * (-0.72134752044f);
    f32x2 e; e.x = __builtin_amdgcn_exp2f(s.x); e.y = __builtin_amdgcn_exp2f(s.y);
    const f32x2 m = v * (q * e), r = v - m;
    f32x2 o; o.x = v.x < 0.f ? m.x : r.x; o.y = v.y < 0.f ? m.y : r.y; return o;
}
template <class Epi, class Sched, bool ALIGN_EPI = false, bool SP2 = false, int NARROW_PN = -1  >
__device__ __forceinline__ void gemm_phase(PG8_LAS unsigned char* lds, const Gemm g, const Sched& S, const Epi& E) {
    const int tid = threadIdx.x, wid = __builtin_amdgcn_readfirstlane(tid >> 6), lane = tid & 63, wr = wid >> 2, wc = wid & 3, fr = lane & 15, fq = lane >> 4;
    const int K = g.K, nt = K / BK;
    unsigned voffA[2], voffB[2];
#pragma unroll
    for (int i = 0; i < 2; ++i) { int R, C; stage_rc(tid * 16 + i * 8192, R, C); const int Rb = Epi::PERM ? ((R & ~31) + perm32(R & 31)) : R;
        voffA[i] = (unsigned)(R * K + C) * 2u; voffB[i] = (unsigned)(Rb * K + C) * 2u; }
    const size_t kstep = (size_t)(BK * 2);
    const size_t hstep = (size_t)HALF * K * 2;
    const size_t tstep = 2 * hstep;
    const unsigned ldsw = (unsigned)wid * 1024u;
    const int aoff = lds_byte(wr * 64 + fr, fq * 8), boff = lds_byte(wc * 32 + fr, fq * 8);
#define PG8_SA(b, h) (((b) * 2 + (h)) * HTB)
#define PG8_SB(b, h) ((4 + (b) * 2 + (h)) * HTB)
#define PG8_STAGE(bufoff, gbase, voff) do { _Pragma("unroll") for (int _i = 0; _i < 2; ++_i) \
        __builtin_amdgcn_global_load_lds((const unsigned*)((const char*)(gbase) + (voff)[_i]), (PG8_LAS unsigned*)(lds + (bufoff) + ldsw + _i * 8192), 16, 0, 0); } while (0)
#define PG8_LDA(dst, b, h) do { _Pragma("unroll") for (int m = 0; m < 4; ++m) _Pragma("unroll") for (int k = 0; k < 2; ++k) dst[m][k] = *(const PG8_LAS bf16x8*)(lds + PG8_SA(b, h) + aoff + m * 2048 + k * 1024); } while (0)
#define PG8_LDB(dst, b, h) do { _Pragma("unroll") for (int n = 0; n < 2; ++n) _Pragma("unroll") for (int k = 0; k < 2; ++k) dst[n][k] = *(const PG8_LAS bf16x8*)(lds + PG8_SB(b, h) + boff + n * 2048 + k * 1024); } while (0)
#define PG8_MMA(ai, bj, At, Bt) do { __builtin_amdgcn_s_setprio(1); _Pragma("unroll") for (int m = 0; m < 4; ++m) _Pragma("unroll") for (int n = 0; n < 2; ++n) _Pragma("unroll") for (int k = 0; k < 2; ++k) \
        acc[ai][bj][m][n] = __builtin_amdgcn_mfma_f32_16x16x32_bf16(Bt[n][k], At[m][k], acc[ai][bj][m][n], 0, 0, 0); __builtin_amdgcn_s_setprio(0); } while (0)
#define PG8_WAIT_V(n) asm volatile("s_waitcnt vmcnt(" #n ")" ::: "memory")
#define PG8_WAIT_L(n) asm volatile("s_waitcnt lgkmcnt(" #n ")" ::: "memory")
#define PG8_BAR __builtin_amdgcn_s_barrier()
#define PG8_SCHED __builtin_amdgcn_sched_barrier(0)
    Unit cur, nxt; int ui = 0;
    if (!S.next(0, cur)) return;
    f32x4 acc[2][2][4][2];
#pragma unroll
    for (int a = 0; a < 2; ++a)
#pragma unroll
        for (int b = 0; b < 2; ++b)
#pragma unroll
            for (int m = 0; m < 4; ++m)
#pragma unroll
                for (int n = 0; n < 2; ++n) acc[a][b][m][n] = (f32x4){0.f, 0.f, 0.f, 0.f};
    bf16x8 At[4][2], B0[2][2], B1[2][2];
    const char* cA = (const char*)g.A + (size_t)cur.pm * tstep; const char* cB = (const char*)g.Bt + (size_t)cur.pn * tstep;
    S.a_ready(cur);
    if constexpr (SP2) {
        PG8_STAGE(PG8_SB(0, 0), cB, voffB); PG8_STAGE(PG8_SB(0, 1), cB + hstep, voffB); PG8_STAGE(PG8_SA(0, 0), cA, voffA); PG8_STAGE(PG8_SA(0, 1), cA + hstep, voffA);
        if (wr == 1) PG8_BAR;
        PG8_WAIT_V(2); PG8_BAR;
        PG8_STAGE(PG8_SB(1, 0), cB + kstep, voffB); PG8_STAGE(PG8_SA(1, 0), cA + kstep, voffA); PG8_STAGE(PG8_SB(1, 1), cB + hstep + kstep, voffB);
        PG8_WAIT_V(6); PG8_BAR;
    } else {
        PG8_STAGE(PG8_SB(0, 0), cB, voffB); PG8_STAGE(PG8_SA(0, 0), cA, voffA); PG8_STAGE(PG8_SB(0, 1), cB + hstep, voffB); PG8_STAGE(PG8_SA(0, 1), cA + hstep, voffA);
        if (wr == 1) PG8_BAR;
        PG8_WAIT_V(4); PG8_BAR;
        PG8_STAGE(PG8_SB(1, 0), cB + kstep, voffB); PG8_STAGE(PG8_SA(1, 0), cA + kstep, voffA); PG8_STAGE(PG8_SB(1, 1), cB + hstep + kstep, voffB);
        PG8_WAIT_V(6); PG8_BAR;
    }
    for (;;) {
        const bool has_next = S.next(ui + 1, nxt); const bool narrow = (NARROW_PN >= 0) && (cur.pn == NARROW_PN);
        const char* nA = has_next ? (const char*)g.A + (size_t)nxt.pm * tstep : cA; const char* nB = has_next ? (const char*)g.Bt + (size_t)nxt.pn * tstep : cB;
        for (int t = 0; t < nt; t += 2) {
            const bool last = (t == nt - 2);
            const char* a1 = cA + (size_t)(t + 1) * kstep;
            const char* a2 = last ? nA : cA + (size_t)(t + 2) * kstep; const char* b2 = last ? nB : cB + (size_t)(t + 2) * kstep;
            const char* a3 = a2 + kstep; const char* b3 = b2 + kstep;
            if (last && has_next) S.a_ready(nxt);
            if constexpr (SP2) {
            PG8_LDB(B0, 0, 0); PG8_LDB(B1, 0, 1); PG8_SCHED; PG8_LDA(At, 0, 0); PG8_STAGE(PG8_SA(1, 1), a1 + hstep, voffA);
            PG8_WAIT_V(8); PG8_WAIT_L(0); PG8_BAR; PG8_MMA(0, 0, At, B0); if (NARROW_PN < 0 || !narrow) PG8_MMA(0, 1, At, B1); PG8_BAR; PG8_SCHED;
            PG8_LDA(At, 0, 1); PG8_STAGE(PG8_SB(0, 0), b2, voffB); PG8_STAGE(PG8_SB(0, 1), b2 + hstep, voffB); PG8_STAGE(PG8_SA(0, 0), a2, voffA);
            PG8_WAIT_V(8); PG8_WAIT_L(0); PG8_BAR; PG8_MMA(1, 0, At, B0); if (NARROW_PN < 0 || !narrow) PG8_MMA(1, 1, At, B1); PG8_BAR; PG8_SCHED;
            PG8_LDB(B0, 1, 0); PG8_LDB(B1, 1, 1); PG8_SCHED; PG8_LDA(At, 1, 0); PG8_STAGE(PG8_SA(0, 1), a2 + hstep, voffA);
            PG8_WAIT_V(8); PG8_WAIT_L(0); PG8_BAR; PG8_MMA(0, 0, At, B0); if (NARROW_PN < 0 || !narrow) PG8_MMA(0, 1, At, B1); PG8_BAR; PG8_SCHED;
            PG8_LDA(At, 1, 1); PG8_STAGE(PG8_SB(1, 0), b3, voffB); PG8_STAGE(PG8_SB(1, 1), b3 + hstep, voffB); PG8_STAGE(PG8_SA(1, 0), a3, voffA);
            PG8_WAIT_V(8); PG8_WAIT_L(0); PG8_BAR; PG8_MMA(1, 0, At, B0); if (NARROW_PN < 0 || !narrow) PG8_MMA(1, 1, At, B1); PG8_BAR; PG8_SCHED;
            } else {
            PG8_LDB(B0, 0, 0); PG8_SCHED; PG8_LDA(At, 0, 0); PG8_STAGE(PG8_SA(1, 1), a1 + hstep, voffA);
            PG8_WAIT_L(8); PG8_BAR; PG8_WAIT_L(0); PG8_MMA(0, 0, At, B0); PG8_BAR; PG8_SCHED;
            PG8_LDB(B1, 0, 1); PG8_STAGE(PG8_SB(0, 0), b2, voffB);
            PG8_BAR; PG8_WAIT_L(0); PG8_MMA(0, 1, At, B1); PG8_BAR;
            PG8_LDA(At, 0, 1); PG8_STAGE(PG8_SA(0, 0), a2, voffA);
            PG8_BAR; PG8_WAIT_L(0); PG8_MMA(1, 0, At, B0); PG8_BAR; PG8_SCHED;
            PG8_STAGE(PG8_SB(0, 1), b2 + hstep, voffB);
            PG8_WAIT_V(6); PG8_BAR; PG8_MMA(1, 1, At, B1); PG8_BAR;
            PG8_LDB(B0, 1, 0); PG8_SCHED; PG8_LDA(At, 1, 0); PG8_STAGE(PG8_SA(0, 1), a2 + hstep, voffA);
            PG8_WAIT_L(8); PG8_BAR; PG8_WAIT_L(0); PG8_MMA(0, 0, At, B0); PG8_BAR; PG8_SCHED;
            PG8_LDB(B1, 1, 1); PG8_STAGE(PG8_SB(1, 0), b3, voffB);
            PG8_BAR; PG8_WAIT_L(0); PG8_MMA(0, 1, At, B1); PG8_BAR;
            PG8_LDA(At, 1, 1); PG8_STAGE(PG8_SA(1, 0), a3, voffA);
            PG8_BAR; PG8_WAIT_L(0); PG8_MMA(1, 0, At, B0); PG8_BAR; PG8_SCHED;
            PG8_STAGE(PG8_SB(1, 1), b3 + hstep, voffB);
            PG8_WAIT_V(6); PG8_BAR; PG8_MMA(1, 1, At, B1); PG8_BAR;
            }
        }
        if constexpr (ALIGN_EPI) { if (wr == 0) PG8_BAR; }
        if constexpr (!Epi::AFTER_DRAIN) { E(acc, cur, wr, wc, fr, fq); S.done(cur); }
        if (!has_next) break;
#pragma unroll
        for (int a = 0; a < 2; ++a)
#pragma unroll
            for (int b = 0; b < 2; ++b)
#pragma unroll
                for (int m = 0; m < 4; ++m)
#pragma unroll
                    for (int n = 0; n < 2; ++n) acc[a][b][m][n] = (f32x4){0.f, 0.f, 0.f, 0.f};
        cur = nxt; cA = nA; cB = nB; ++ui;
        if constexpr (ALIGN_EPI) { if (wr == 1) PG8_BAR; }
    }
    PG8_WAIT_V(0);
    if constexpr (!ALIGN_EPI) { if (wr == 0) PG8_BAR; }
    PG8_BAR;
    if constexpr (Epi::AFTER_DRAIN) { E.fused(acc, cur, wr, wc, fr, fq, lds, wid, lane); S.done(cur); }
#undef PG8_SA
#undef PG8_SB
#undef PG8_STAGE
#undef PG8_LDA
#undef PG8_LDB
#undef PG8_MMA
#undef PG8_WAIT_V
#undef PG8_WAIT_L
#undef PG8_BAR
#undef PG8_SCHED
}
}

namespace cg = cooperative_groups;
#define LAS __attribute__((address_space(3)))
#define DI __device__ __forceinline__
typedef unsigned short bf16;
typedef short bf16x8 __attribute__((ext_vector_type(8)));
typedef float f32x4 __attribute__((ext_vector_type(4)));
typedef unsigned u32x4 __attribute__((ext_vector_type(4)));
typedef unsigned u32x2 __attribute__((ext_vector_type(2)));

#ifndef MK_N_LAUNCHES
#define MK_N_LAUNCHES 1
#endif
#define PROBE_DUP 0
#define DUP(bit) for (int rep_ = 0; rep_ < (((PROBE_DUP) >> (bit)) & 1) + 1; ++rep_)
constexpr int NPH = 10;
constexpr int NTOK = 32768, DM = 1024, PWSRC = 2592, N1 = 2816, PHS = 384, PUS = 1024, DFF = 2816, N3 = 5632;
constexpr float EPS = 1e-6f;
constexpr size_t MiB = 1u << 20;
constexpr size_t WS_SSQ1 = 0, WS_SSQ2 = 128 * 1024, WS_XSC = 256 * 1024, WS_WSB = 1 * MiB, WS_RSW = 1 * MiB + 256 * 1024, WS_BT1 = 2 * MiB, WS_BT2 = 8 * MiB, WS_BT3 = 10 * MiB, WS_BT4 = 21 * MiB,
                 WS_DEC = 27 * MiB, WS_LR = 28 * MiB, WS_H = 32 * MiB  , WS_ST = 96 * MiB  ,
                 WS_P = 160 * MiB  , WS_Y = 336 * MiB  , WS_END = 400 * MiB;
constexpr size_t WS_BAR = 512 * 1024, WS_CNT = WS_BAR + 16384, WS_BAR_BYTES = 16384 + 32768;
constexpr size_t WS_PU = WS_P + (size_t)4 * NTOK * PHS * 2;
constexpr int LDS_BYTES = 151552;

typedef float f32x2_t __attribute__((ext_vector_type(2))); typedef __bf16 bf16x2_t __attribute__((ext_vector_type(2)));
DI unsigned pk2(float lo, float hi) { f32x2_t v = {lo, hi}; bf16x2_t b = __builtin_convertvector(v, bf16x2_t); return __builtin_bit_cast(unsigned, b); }
DI float bflo(unsigned u) { return __uint_as_float(u << 16); }
DI float bfhi(unsigned u) { return __uint_as_float(u & 0xffff0000u); }
DI float silu_f(float g) { return g * __builtin_amdgcn_rcpf(1.0f + __expf(-g)); }
DI float logsig(float z) { return fminf(z, 0.f) - __logf(1.0f + __expf(-fabsf(z))); }
DI void lds_barrier() { asm volatile("s_waitcnt lgkmcnt(0)" ::: "memory"); __builtin_amdgcn_s_barrier(); asm volatile("" ::: "memory"); }
DI bf16x8 lds_frag(LAS const unsigned char* p) { return *(LAS const bf16x8*)p; }
DI f32x4 mfma16(bf16x8 a, bf16x8 b, f32x4 c) { return __builtin_amdgcn_mfma_f32_16x16x32_bf16(a, b, c, 0, 0, 0); }

#define XB_TMO      128
#define XB_XCNT(j)  (256  + 64 * (j))
#define XB_XSUB(j)  (1280 + 64 * (j))
#define XB_XGEN(j)  (2304 + 64 * (j))
#define XB_TOP      3328
#define XB_TOPGEN   3392
#define XCD_BAR_WORDS 3456
#define XB_SPIN_CAP (1u << 18)

__device__ __forceinline__ unsigned xb_ld(unsigned* p)              { return __hip_atomic_load(p, __ATOMIC_RELAXED, __HIP_MEMORY_SCOPE_AGENT); }
__device__ __forceinline__ unsigned xb_add(unsigned* p, unsigned v) { return __hip_atomic_fetch_add(p, v, __ATOMIC_RELAXED, __HIP_MEMORY_SCOPE_AGENT); }
__device__ __forceinline__ unsigned xb_xcc_id() { return (unsigned)__builtin_amdgcn_s_getreg((3 << 11) | 20) & 0xFu; }
#define XB_SPIN(cond, bar) do { unsigned _sp = 0; while (cond) { __builtin_amdgcn_s_sleep(1); \
    if ((++_sp & 255u) == 0u) { if (xb_ld(&(bar)[XB_TMO])) break; if (_sp > XB_SPIN_CAP) { atomicAdd(&(bar)[XB_TMO], 1u); break; } } } } while (0)

struct XcdBarrier {
    unsigned* bar; unsigned x;
    volatile LAS unsigned* st;
};

__device__ __forceinline__ XcdBarrier xcd_barrier_post(unsigned* bar, volatile LAS unsigned* st) {
    XcdBarrier b; b.bar = bar; b.x = xb_xcc_id(); b.st = st;
    if (threadIdx.x == 0) (void)xb_add(&bar[XB_XCNT(b.x)], 1u);
    return b;
}
__device__ __forceinline__ void xcd_barrier_complete(unsigned* bar, unsigned x, unsigned& nloc, unsigned& nx) {
    const unsigned G = gridDim.x * gridDim.y * gridDim.z;
    unsigned sum, cnt, mine, sp = 0u;
    for (;;) {
        sum = 0u; cnt = 0u; mine = 0u;
#pragma unroll
        for (unsigned j = 0; j < 16; ++j) { const unsigned c = xb_ld(&bar[XB_XCNT(j)]); sum += c; cnt += (c > 0u) ? 1u : 0u; mine = (j == x) ? c : mine; }
        if (sum == G) break;
        __builtin_amdgcn_s_sleep(1);
        if ((++sp & 255u) == 0u) { if (xb_ld(&bar[XB_TMO])) break; if (sp > XB_SPIN_CAP) { atomicAdd(&bar[XB_TMO], 1u); break; } }
    }
    nloc = mine > 0u ? mine : 1u; nx = cnt > 0u ? cnt : 1u;
}

__device__ __forceinline__ void xcd_barrier(const XcdBarrier& b) {
    asm volatile("s_waitcnt vmcnt(0)" ::: "memory");
    __syncthreads();
    if (threadIdx.x == 0) {
        unsigned* bar = b.bar;
        __builtin_amdgcn_s_waitcnt(0);
        unsigned nloc = b.st[0], nx = b.st[1];
        if (nloc == 0u) { xcd_barrier_complete(bar, b.x, nloc, nx); b.st[0] = nloc; b.st[1] = nx; }
        const unsigned old = xb_add(&bar[XB_XSUB(b.x)], 1u);
        const unsigned gen = old / nloc;
        if (old + 1u == (gen + 1u) * nloc) {
            __builtin_amdgcn_fence(__ATOMIC_RELEASE, "agent");
            asm volatile("s_waitcnt vmcnt(0)" ::: "memory");
            const unsigned og = xb_add(&bar[XB_TOP], 1u);
            const unsigned tg = og / nx;
            if (og + 1u == (tg + 1u) * nx) xb_add(&bar[XB_TOPGEN], 1u);
            else XB_SPIN(xb_ld(&bar[XB_TOPGEN]) == tg, bar);
            __builtin_amdgcn_fence(__ATOMIC_ACQUIRE, "agent");
            xb_add(&bar[XB_XGEN(b.x)], 1u);
            asm volatile("s_waitcnt vmcnt(0)" ::: "memory");
        } else {
            XB_SPIN(xb_ld(&bar[XB_XGEN(b.x)]) == gen, bar);
            __builtin_amdgcn_fence(__ATOMIC_ACQUIRE, "agent");
            asm volatile("s_waitcnt vmcnt(0)" ::: "memory");
        }
    }
    __syncthreads();
}

struct OrderG1 { pg8::StaticOrder full, all; bool special; int c;
    __device__ void init(int G, int c_) { special = (G == 256); c = c_; full.init(NTOK, 2560, G, c_); all.init(NTOK, N1, G, c_); }
    __device__ bool next(int i, pg8::Unit& u) const { if (!special) return all.next(i, u); if (i < 5) return full.next(i, u); if (i == 5 && c < 128) { u.pm = c; u.pn = 10; return true; } return false; }
    __device__ __forceinline__ void a_ready(const pg8::Unit&) const {}
    __device__ __forceinline__ void done(const pg8::Unit&) const {}
};
struct Args { const float* in[18]; float* out; unsigned char* ws; int ph_lo, ph_hi; };

struct Epi1 {
    static constexpr bool PERM = true, AFTER_DRAIN = false;
    bf16* P; bf16* PU; bf16* LR;
    DI void operator()(const f32x4 (&acc)[2][2][4][2], const pg8::Unit& u, int wr, int wc, int fr, int fq) const {
        const int row0 = u.pm * 256 + wr * 64 + fr;
        if (u.pn == 10) {
            if (wc == 0) {
#pragma unroll
                for (int ai = 0; ai < 2; ++ai)
#pragma unroll
                    for (int m = 0; m < 4; ++m) { bf16* p = LR + (size_t)(row0 + ai * 128 + m * 16) * 64 + (fq >> 1) * 32 + (fq & 1) * 8; u32x4 hv, lv;
#pragma unroll
                        for (int e = 0; e < 4; ++e) { const float x0 = acc[ai][0][m][e >> 1][(e & 1) * 2], x1 = acc[ai][0][m][e >> 1][(e & 1) * 2 + 1]; const unsigned hp = pk2(x0, x1);
                            hv[e] = hp; lv[e] = pk2(x0 - bflo(hp), x1 - bfhi(hp)); }
                        *(u32x4*)p = hv; *(u32x4*)(p + 16) = lv; }
            }
            return;
        }
        const bool act = u.pn >= 6;
        const int col0 = u.pn * 256 + wc * 32 + 8 * fq;
#pragma unroll
        for (int ai = 0; ai < 2; ++ai)
#pragma unroll
            for (int m = 0; m < 4; ++m) { const int row = row0 + ai * 128 + m * 16;
#pragma unroll
                for (int bj = 0; bj < 2; ++bj) { const int col = col0 + bj * 128;
                    bf16* dst = act ? PU + (size_t)row * PUS + (col - 1536) : P + ((size_t)(col / 384) * NTOK + row) * PHS + col % 384;
                    f32x4 v0 = acc[ai][bj][m][0], v1 = acc[ai][bj][m][1];
                    if (act) { pg8::f32x2 a = pg8::gelu_pk((pg8::f32x2){v0[0], v0[1]}), b = pg8::gelu_pk((pg8::f32x2){v0[2], v0[3]}), c = pg8::gelu_pk((pg8::f32x2){v1[0], v1[1]}), d = pg8::gelu_pk((pg8::f32x2){v1[2], v1[3]});
                        v0 = (f32x4){a.x, a.y, b.x, b.y}; v1 = (f32x4){c.x, c.y, d.x, d.y}; }
                    u32x4 w; w.x = pk2(v0[0], v0[1]); w.y = pk2(v0[2], v0[3]); w.z = pk2(v1[0], v1[1]); w.w = pk2(v1[2], v1[3]);
                    *(u32x4*)dst = w; } }
    }
};
template <int MODE> struct EpiRes {
    static constexpr bool PERM = true, AFTER_DRAIN = false;
    const float* xsc; const bf16* baseb; const float* aux  ; bf16* ob; float* ssq;
    DI void operator()(const f32x4 (&acc)[2][2][4][2], const pg8::Unit& u, int wr, int wc, int fr, int fq) const {
        const int row0 = u.pm * 256 + wr * 64 + fr, col0 = u.pn * 256 + wc * 32 + 8 * fq;
        f32x4 gi[2][2];
        if (MODE == 0) {
#pragma unroll
            for (int bj = 0; bj < 2; ++bj)
#pragma unroll
                for (int n = 0; n < 2; ++n) { const f32x4 gq = *(const f32x4*)(aux + col0 + bj * 128 + n * 4); gi[bj][n] = (f32x4){1.0f / gq[0], 1.0f / gq[1], 1.0f / gq[2], 1.0f / gq[3]}; } }
#pragma unroll
        for (int ai = 0; ai < 2; ++ai) {
            u32x4 bw[4][2]; float sc[4];
#pragma unroll
            for (int m = 0; m < 4; ++m) { if (MODE == 0) sc[m] = xsc[row0 + ai * 128 + m * 16];
#pragma unroll
                for (int bj = 0; bj < 2; ++bj) bw[m][bj] = *(const u32x4*)(baseb + (size_t)(row0 + ai * 128 + m * 16) * DM + col0 + bj * 128); }
#pragma unroll
            for (int m = 0; m < 4; ++m) { const int row = row0 + ai * 128 + m * 16; float s = 0.f;
#pragma unroll
                for (int bj = 0; bj < 2; ++bj) { const size_t o = (size_t)row * DM + col0 + bj * 128; const u32x4 w = bw[m][bj];
                    f32x4 v0 = (f32x4){bflo(w.x), bfhi(w.x), bflo(w.y), bfhi(w.y)}, v1 = (f32x4){bflo(w.z), bfhi(w.z), bflo(w.w), bfhi(w.w)};
                    if (MODE == 0) { v0 = v0 * sc[m] * gi[bj][0]; v1 = v1 * sc[m] * gi[bj][1]; }
                    v0 = v0 + acc[ai][bj][m][0]; v1 = v1 + acc[ai][bj][m][1];
                    s += ((v0[0] * v0[0] + v0[1] * v0[1]) + (v0[2] * v0[2] + v0[3] * v0[3])) + ((v1[0] * v1[0] + v1[1] * v1[1]) + (v1[2] * v1[2] + v1[3] * v1[3]));
                    if (MODE == 0) { u32x4 wo; wo.x = pk2(v0[0], v0[1]); wo.y = pk2(v0[2], v0[3]); wo.z = pk2(v1[0], v1[1]); wo.w = pk2(v1[2], v1[3]); *(u32x4*)(ob + o) = wo; }
                    else { *(f32x4*)((float*)aux + o) = v0; *(f32x4*)((float*)aux + o + 4) = v1; } }
                s += __shfl_xor(s, 16); s += __shfl_xor(s, 32);
                if (fq == 0) atomicAdd(ssq + row, s); }
        }
    }
};
struct EpiFinal {
    static constexpr bool PERM = true, AFTER_DRAIN = false;
    const bf16* base; float* out; float* ssq; unsigned* cnt; const float* gf;
    DI void operator()(f32x4 (&acc)[2][2][4][2], const pg8::Unit& u, int wr, int wc, int fr, int fq) const {
        const int row0 = u.pm * 256 + wr * 64 + fr, col0 = u.pn * 256 + wc * 32 + 8 * fq;
        u32x4 bw[2][4][2];
#pragma unroll
        for (int ai = 0; ai < 2; ++ai)
#pragma unroll
            for (int m = 0; m < 4; ++m)
#pragma unroll
                for (int bj = 0; bj < 2; ++bj) bw[ai][m][bj] = *(const u32x4*)(base + (size_t)(row0 + ai * 128 + m * 16) * DM + col0 + bj * 128);
        f32x4 gv[2][2];
#pragma unroll
        for (int bj = 0; bj < 2; ++bj)
#pragma unroll
            for (int n = 0; n < 2; ++n) gv[bj][n] = *(const f32x4*)(gf + col0 + bj * 128 + n * 4);
#pragma unroll
        for (int ai = 0; ai < 2; ++ai)
#pragma unroll
            for (int m = 0; m < 4; ++m) { const int row = row0 + ai * 128 + m * 16; float s = 0.f;
#pragma unroll
                for (int bj = 0; bj < 2; ++bj) { const u32x4 w = bw[ai][m][bj];
                    const f32x4 v0 = (f32x4){bflo(w.x), bfhi(w.x), bflo(w.y), bfhi(w.y)} + acc[ai][bj][m][0], v1 = (f32x4){bflo(w.z), bfhi(w.z), bflo(w.w), bfhi(w.w)} + acc[ai][bj][m][1];
                    acc[ai][bj][m][0] = v0; acc[ai][bj][m][1] = v1;
                    s += ((v0[0] * v0[0] + v0[1] * v0[1]) + (v0[2] * v0[2] + v0[3] * v0[3])) + ((v1[0] * v1[0] + v1[1] * v1[1]) + (v1[2] * v1[2] + v1[3] * v1[3])); }
                s += __shfl_xor(s, 16); s += __shfl_xor(s, 32);
                if (fq == 0) atomicAdd(ssq + row, s); }
        asm volatile("s_waitcnt vmcnt(0)" ::: "memory");
        unsigned* c = cnt + 64 * u.pm;
        if (fr == 0 && fq == 0) __hip_atomic_fetch_add(c, 1u, __ATOMIC_RELAXED, __HIP_MEMORY_SCOPE_AGENT);
        { unsigned sp = 0; while ((unsigned)__builtin_amdgcn_readfirstlane(__hip_atomic_load(c, __ATOMIC_RELAXED, __HIP_MEMORY_SCOPE_AGENT)) < 32u) { __builtin_amdgcn_s_sleep(2); if (++sp > (1u << 22)) break; } }
        float sv[8];
#pragma unroll
        for (int i = 0; i < 8; ++i) sv[i] = __hip_atomic_load(ssq + row0 + (i >> 2) * 128 + (i & 3) * 16, __ATOMIC_RELAXED, __HIP_MEMORY_SCOPE_AGENT);
#pragma unroll
        for (int ai = 0; ai < 2; ++ai)
#pragma unroll
            for (int m = 0; m < 4; ++m) { const int row = row0 + ai * 128 + m * 16; const float rs = rsqrtf(sv[ai * 4 + m] * (1.0f / 1024.0f) + EPS);
#pragma unroll
                for (int bj = 0; bj < 2; ++bj)
#pragma unroll
                    for (int n = 0; n < 2; ++n) *(f32x4*)(out + (size_t)row * DM + col0 + bj * 128 + n * 4) = acc[ai][bj][m][n] * rs * gv[bj][n]; }
    }
};
struct Epi3 {
    static constexpr bool PERM = true, AFTER_DRAIN = false;
    bf16* ACT; const float* ssq;
    DI void operator()(const f32x4 (&acc)[2][2][4][2], const pg8::Unit& u, int wr, int wc, int fr, int fq) const {
        const int row0 = u.pm * 256 + wr * 64 + fr, col0 = u.pn * 128 + wc * 32 + 8 * fq;
        float sv[8];
#pragma unroll
        for (int i = 0; i < 8; ++i) sv[i] = ssq[row0 + (i >> 2) * 128 + (i & 3) * 16];
#pragma unroll
        for (int ai = 0; ai < 2; ++ai)
#pragma unroll
            for (int m = 0; m < 4; ++m) { const int row = row0 + ai * 128 + m * 16; const float rs = rsqrtf(sv[ai * 4 + m] * (1.0f / 1024.0f) + EPS);
                float o[8];
#pragma unroll
                for (int n = 0; n < 2; ++n)
#pragma unroll
                    for (int e = 0; e < 4; ++e) o[n * 4 + e] = silu_f(acc[ai][0][m][n][e] * rs) * (acc[ai][1][m][n][e] * rs);
                u32x4 w; w.x = pk2(o[0], o[1]); w.y = pk2(o[2], o[3]); w.z = pk2(o[4], o[5]); w.w = pk2(o[6], o[7]);
                *(u32x4*)(ACT + (size_t)row * DFF + col0) = w; }
    }
};

DI void p0_item(const Args& A, int it, LAS float* scr, int tid) {
    int mat, ntile, kt;
    if (it < 704) { mat = 1; ntile = it >> 4; kt = it & 15; }
    else if (it < 960) { it -= 704; mat = 2; ntile = it >> 4; kt = it & 15; }
    else if (it < 2368) { it -= 960; mat = 3; ntile = it >> 4; kt = it & 15; }
    else { it -= 2368; mat = 4; ntile = it / 44; kt = it % 44; }
    const int kl = tid >> 3, n8 = tid & 7, nd = ntile * 64 + n8 * 8, k = kt * 64 + kl;
    const float* src = nullptr; int ldw = 0, sc = 0; float scale = 1.f; bf16* dst; int K = 1024;
    if (mat == 1) { ldw = PWSRC; dst = (bf16*)(A.ws + WS_BT1);
        if (nd < 1536) { const int hh = nd / 384, c = nd % 384; sc = c < 64 ? hh * 64 + c : (c < 128 ? 256 + hh * 64 + (c - 64) : (c < 256 ? 512 + hh * 128 + (c - 128) : 1024 + hh * 128 + (c - 256))); if (c < 64) scale = 0.125f; }
        else if (nd < 2560) sc = nd + 32; else if (nd < 2592) sc = nd - 2560 + 1536; else sc = -1;
        if (sc >= 0) src = A.in[2]; }
    else if (mat == 2) { ldw = 1024; dst = (bf16*)(A.ws + WS_BT2); sc = nd; src = A.in[12]; }
    else if (mat == 3) { ldw = DFF; dst = (bf16*)(A.ws + WS_BT3); const int tl = nd >> 8, r = nd & 255; if (r < 128) { src = A.in[14]; sc = tl * 128 + r; } else { src = A.in[15]; sc = tl * 128 + r - 128; } scale = A.in[13][k]; }
    else { ldw = 1024; dst = (bf16*)(A.ws + WS_BT4); sc = nd; src = A.in[16]; K = DFF; }
    f32x4 a = (f32x4){0.f, 0.f, 0.f, 0.f}, b = a;
    if (src) { const float* p = src + (size_t)k * ldw + sc; a = *(const f32x4*)p * scale; b = *(const f32x4*)(p + 4) * scale; }
    LAS float* w = scr + kl * 65 + n8 * 8;
    w[0] = a[0]; w[1] = a[1]; w[2] = a[2]; w[3] = a[3]; w[4] = b[0]; w[5] = b[1]; w[6] = b[2]; w[7] = b[3];
    __syncthreads();
    const int nl = tid >> 3, k8 = tid & 7; float v[8];
#pragma unroll
    for (int j = 0; j < 8; ++j) v[j] = scr[(k8 * 8 + j) * 65 + nl];
    u32x4 o; o.x = pk2(v[0], v[1]); o.y = pk2(v[2], v[3]); o.z = pk2(v[4], v[5]); o.w = pk2(v[6], v[7]);
    *(u32x4*)(dst + (size_t)(ntile * 64 + nl) * K + kt * 64 + k8 * 8) = o;
    __syncthreads();
}
DI void p0_prologue(const Args& A, LAS unsigned char* lds, int tid) {
    const int G = gridDim.x, bx = blockIdx.x, lane = tid & 63, wid = tid >> 6;
    for (int i = bx * 512 + tid; i < 65536; i += G * 512) ((float*)(A.ws + WS_SSQ1))[i] = 0.f;
    for (int i = bx * 512 + tid; i < 65536; i += G * 512) { ((bf16*)(A.ws + WS_WSB))[i] = (bf16)(pk2(A.in[10][i], 0.f) & 0xffffu); }
    for (int i = bx * 512 + tid; i < 512; i += G * 512) { const float* w = A.in[10] + (size_t)i * 128; float r = 0.f;
        for (int j = 0; j < 128; j += 4) { const f32x4 v = *(const f32x4*)(w + j); r += (v[0] + v[1]) + (v[2] + v[3]); }
        ((float*)(A.ws + WS_RSW))[i] = r; }
    for (int it = bx; it < 3072; it += G) p0_item(A, it, (LAS float*)lds, tid);
    const float* x = A.in[0]; const float* g1 = A.in[1]; bf16* H = (bf16*)(A.ws + WS_H);
    f32x4 gv[4];
#pragma unroll
    for (int j = 0; j < 4; ++j) gv[j] = *(const f32x4*)(g1 + lane * 4 + 256 * j);
    for (int row = bx * 8 + wid; row < NTOK; row += G * 8) {
        const float* xr = x + (size_t)row * DM; f32x4 v[4]; float s = 0.f;
#pragma unroll
        for (int j = 0; j < 4; ++j) { v[j] = *(const f32x4*)(xr + lane * 4 + 256 * j); s += (v[j][0] * v[j][0] + v[j][1] * v[j][1]) + (v[j][2] * v[j][2] + v[j][3] * v[j][3]); }
#pragma unroll
        for (int o = 1; o < 64; o <<= 1) s += __shfl_xor(s, o);
        const float rs = rsqrtf(s * (1.0f / 1024.0f) + EPS);
        if (lane == 0) ((float*)(A.ws + WS_XSC))[row] = sqrtf(s * (1.0f / 1024.0f) + EPS);
#pragma unroll
        for (int j = 0; j < 4; ++j) { const f32x4 y = v[j] * rs * gv[j]; u32x2 w; w.x = pk2(y[0], y[1]); w.y = pk2(y[2], y[3]); *(u32x2*)(H + (size_t)row * DM + lane * 4 + 256 * j) = w; }
    }
}

constexpr int GM_VTS = 136, GM_PART = (128 * GM_VTS + 16) * 2  , GM_LN = 4 * GM_PART;
static_assert(GM_LN + 4096 <= 151552 - 16, "gMLP LDS map");
DI void gmlp_phase(const Args& A, LAS unsigned char* lds, int tid) {
    const int lane = tid & 63, wid = tid >> 6, fr = lane & 15, fq = lane >> 4;
    const bf16* PU = (const bf16*)(A.ws + WS_PU); bf16* Y = (bf16*)(A.ws + WS_Y); const bf16* WS = (const bf16*)(A.ws + WS_WSB); const float* RSW = (const float*)(A.ws + WS_RSW);
    const float* bsp = A.in[11];
    LAS float* LN = (LAS float*)(lds + GM_LN);
    for (int unit = blockIdx.x; unit < 256; unit += gridDim.x) {
        const int tok0 = unit * 128, j = tid >> 2, part = tid & 3, irow = wid * 16 + fr;
        u32x4 w[16];
        { const bf16* p = PU + (size_t)(tok0 + j) * PUS + 512 + part * 128;
#pragma unroll
          for (int i = 0; i < 16; ++i) w[i] = *(const u32x4*)(p + i * 8); }
        bf16x8 wfn[4]; u32x4 uvn[4];
#define GM_LOADG(g_) do { _Pragma("unroll") for (int ks_ = 0; ks_ < 4; ++ks_) wfn[ks_] = *(const bf16x8*)(WS + (size_t)(g_) * 16384 + irow * 128 + ks_ * 32 + fq * 8); \
        _Pragma("unroll") for (int pp_ = 0; pp_ < 4; ++pp_) uvn[pp_] = *(const u32x4*)(PU + (size_t)(tok0 + irow) * PUS + (g_) * 128 + pp_ * 32 + 8 * fq); } while (0)
        lds_barrier();
        LN[tid] = A.in[8][tid]; LN[512 + tid] = A.in[9][tid];
        float sm = 0.f, sq = 0.f;
#pragma unroll
        for (int i = 0; i < 16; ++i)
#pragma unroll
            for (int e = 0; e < 4; ++e) { const float a = bflo(w[i][e]), b = bfhi(w[i][e]); sm += a + b; sq += a * a + b * b; }
        sm += __shfl_xor(sm, 1); sm += __shfl_xor(sm, 2); sq += __shfl_xor(sq, 1); sq += __shfl_xor(sq, 2);
        const float mean = sm * (1.0f / 512.0f), rstd = rsqrtf(fmaxf(sq * (1.0f / 512.0f) - mean * mean, 0.f) + EPS);
        LAS unsigned short* vt = (LAS unsigned short*)(lds + part * GM_PART) + j;
#pragma unroll
        for (int i = 0; i < 16; ++i)
#pragma unroll
            for (int e = 0; e < 4; ++e) { const unsigned pv = pk2((bflo(w[i][e]) - mean) * rstd, (bfhi(w[i][e]) - mean) * rstd); const int c = i * 8 + e * 2;
                vt[c * GM_VTS] = (unsigned short)(pv & 0xffffu); vt[(c + 1) * GM_VTS] = (unsigned short)(pv >> 16); }
        GM_LOADG(0);
        lds_barrier();
        for (int g = 0; g < 4; ++g) {
            bf16x8 wf[4]; u32x4 uv[4];
#pragma unroll
            for (int ks = 0; ks < 4; ++ks) wf[ks] = wfn[ks];
#pragma unroll
            for (int pp = 0; pp < 4; ++pp) uv[pp] = uvn[pp];
            if (g < 3) GM_LOADG(g + 1);
            const float bias = bsp[g * 128 + irow], rsw = RSW[g * 128 + irow];
#pragma unroll
            for (int pp = 0; pp < 4; ++pp) {
                f32x4 a0 = (f32x4){0.f, 0.f, 0.f, 0.f}, a1 = a0;
#pragma unroll
                for (int ks = 0; ks < 4; ++ks) { a0 = mfma16(lds_frag(lds + g * GM_PART + ((32 * pp + 8 * (fr >> 2) + (fr & 3)) * GM_VTS + ks * 32 + fq * 8) * 2), wf[ks], a0);
                    a1 = mfma16(lds_frag(lds + g * GM_PART + ((32 * pp + 8 * (fr >> 2) + 4 + (fr & 3)) * GM_VTS + ks * 32 + fq * 8) * 2), wf[ks], a1); }
                const int c = 32 * pp + 8 * fq; const u32x4 uu = uv[pp];
                const f32x4 lg0 = *(LAS const f32x4*)(LN + g * 128 + c), lg1 = *(LAS const f32x4*)(LN + g * 128 + c + 4), lb0 = *(LAS const f32x4*)(LN + 512 + g * 128 + c), lb1 = *(LAS const f32x4*)(LN + 512 + g * 128 + c + 4);
                u32x4 o; o.x = pk2(bflo(uu.x) * (lg0[0] * a0[0] + lb0[0] * rsw + bias), bfhi(uu.x) * (lg0[1] * a0[1] + lb0[1] * rsw + bias));
                o.y = pk2(bflo(uu.y) * (lg0[2] * a0[2] + lb0[2] * rsw + bias), bfhi(uu.y) * (lg0[3] * a0[3] + lb0[3] * rsw + bias));
                o.z = pk2(bflo(uu.z) * (lg1[0] * a1[0] + lb1[0] * rsw + bias), bfhi(uu.z) * (lg1[1] * a1[1] + lb1[1] * rsw + bias));
                o.w = pk2(bflo(uu.w) * (lg1[2] * a1[2] + lb1[2] * rsw + bias), bfhi(uu.w) * (lg1[3] * a1[3] + lb1[3] * rsw + bias));
                *(u32x4*)(Y + (size_t)(tok0 + irow) * DM + 512 + g * 128 + c) = o; }
        }
#undef GM_LOADG
    }
}

constexpr int G_LR = 0, G_WD = 8192, G_BD = 16384, G_SEG = 16896, G_LA = 18944, G_A0 = 52224, RS72 = 72;
constexpr int GA_KTF = G_A0, GA_KTB = G_A0 + 9216, GA_VT = G_A0 + 18432;
constexpr int GC_QDF = G_A0, GC_QDB = G_A0 + 9216, GC_KDF = G_A0 + 18432, GC_KDB = G_A0 + 27648, GC_VT = G_A0 + 36864, GC_SS = GC_VT + 18432, GC_RS = GC_SS + 9216;
constexpr int GC_STF = 0, GC_STB = 132096;
static_assert(GC_RS + 512 <= 131072 && GC_STF + 18432 <= G_LA && GC_STB + 18432 <= 151552 - 16, "GLA LDS map");
struct DecayW { bf16x8 bh, bl; float bias; };
DI unsigned hi16(float x) { return pk2(x, 0.f) & 0xffffu; }
DI DecayW gla_decay_w(const Args& A, int h, int wid, int fr, int fq) {
    const int dir = wid >> 2, d = h * 64 + 16 * (wid & 3) + fr; const float* w = (dir ? A.in[5] : A.in[3]) + ((fq & 1) * 8) * 256 + d;
    DecayW o; unsigned hh[8], ll[8];
#pragma unroll
    for (int j = 0; j < 8; ++j) { const float x = w[j * 256]; hh[j] = hi16(x); ll[j] = (fq < 2) ? hi16(x - __uint_as_float(hh[j] << 16)) : 0u; }
    u32x4 a, b;
#pragma unroll
    for (int e = 0; e < 4; ++e) { a[e] = hh[2 * e] | (hh[2 * e + 1] << 16); b[e] = ll[2 * e] | (ll[2 * e + 1] << 16); }
    o.bh = __builtin_bit_cast(bf16x8, a); o.bl = __builtin_bit_cast(bf16x8, b); o.bias = (dir ? A.in[6] : A.in[4])[d];
    return o;
}
struct LrRows { bf16x8 v[4]; };
DI LrRows gla_load_lr(const bf16* LRg, int tok0, int wid, int fr, int fq) {
    LrRows o; const bf16* p = LRg + (size_t)(tok0 + fr) * 64 + (wid >> 2) * 32 + fq * 8;
#pragma unroll
    for (int tt = 0; tt < 4; ++tt) o.v[tt] = *(const bf16x8*)(p + tt * 1024);
    return o;
}
DI void gla_decay(LAS unsigned char* lds, const LrRows& L, const DecayW& W, int wid, int fr, int fq) {
    LAS float* LA = (LAS float*)(lds + G_LA); const int dir = wid >> 2, d = 16 * (wid & 3) + fr;
    float la[4][4], p[4][4], S[4], ex[4], tot[4];
#pragma unroll
    for (int tt = 0; tt < 4; ++tt) {
        const bf16x8 a1 = L.v[tt]; const bf16x8 a2 = (fq < 2) ? a1 : (bf16x8){0, 0, 0, 0, 0, 0, 0, 0};
        f32x4 z = (f32x4){0.f, 0.f, 0.f, 0.f};
        z = mfma16(a1, W.bh, z); z = mfma16(a2, W.bl, z);
#pragma unroll
        for (int r = 0; r < 4; ++r) la[tt][r] = logsig(z[r] + W.bias) * (1.0f / 16.0f);
        p[tt][0] = la[tt][0]; p[tt][1] = p[tt][0] + la[tt][1]; p[tt][2] = p[tt][1] + la[tt][2]; p[tt][3] = p[tt][2] + la[tt][3]; S[tt] = p[tt][3];
    }
#pragma unroll
    for (int tt = 0; tt < 4; ++tt) { const float s1 = __shfl_xor(S[tt], 16), s2 = __shfl_xor(S[tt], 32), s3 = __shfl_xor(s1, 32);
        tot[tt] = (S[tt] + s1) + (s2 + s3); ex[tt] = fq == 0 ? 0.f : (fq == 1 ? s1 : (fq == 2 ? s2 + s3 : s1 + s2 + s3)); }
    const float T = (tot[0] + tot[1]) + (tot[2] + tot[3]); float base = 0.f;
#pragma unroll
    for (int tt = 0; tt < 4; ++tt) {
#pragma unroll
        for (int r = 0; r < 4; ++r) { const float pre = base + ex[tt] + p[tt][r]; LA[(dir * 64 + 16 * tt + 4 * fq + r) * 65 + d] = dir ? (T - pre + la[tt][r]) : pre; }
        base += tot[tt]; }
    lds_barrier();
}
DI void gla_build_vt(const u32x4 a, const u32x4 b, LAS unsigned char* vtb, int tid) {
    const int sp = tid & 31, dvb = tid >> 5; LAS unsigned* vt = (LAS unsigned*)vtb;
#pragma unroll
    for (int e = 0; e < 4; ++e) { const int dv = dvb * 8 + 2 * e;
        vt[dv * (RS72 / 2) + sp] = (a[e] & 0xffffu) | (b[e] << 16);
        vt[(dv + 1) * (RS72 / 2) + sp] = (a[e] >> 16) | (b[e] & 0xffff0000u); }
}
DI size_t st_off(int dir, int b, int h, int n) { return ((size_t)((dir * 4 + b) * 4 + h) * 128 + n) * 8192; }
DI void gla_pass_a(const Args& A, LAS unsigned char* lds, int tid) {
    const int lane = tid & 63, wid = tid >> 6, fr = lane & 15, fq = lane >> 4;
    const bf16* P = (const bf16*)(A.ws + WS_P); bf16* ST = (bf16*)(A.ws + WS_ST); float* DEC = (float*)(A.ws + WS_DEC);
    LAS float* LA = (LAS float*)(lds + G_LA);
    const bf16* LRg = (const bf16*)(A.ws + WS_LR); int h_loaded = -1; DecayW dw; dw.bh = (bf16x8){0,0,0,0,0,0,0,0}; dw.bl = dw.bh; dw.bias = 0.f;
    const int sp = tid & 31, db = tid >> 5;
    LrRows lrn; u32x2 k0n, k1n; u32x4 van, vbn;
#define GA_LOAD(un) do { const int h_ = (un) & 3, tok_ = ((un) >> 2) * 64; lrn = gla_load_lr(LRg, tok_, wid, fr, fq); \
        const bf16* kp_ = P + ((size_t)h_ * NTOK + tok_ + 2 * sp) * PHS + 64 + db * 4; k0n = *(const u32x2*)kp_; k1n = *(const u32x2*)(kp_ + PHS); \
        const bf16* vp_ = P + ((size_t)h_ * NTOK + tok_ + 2 * sp) * PHS + 128 + db * 8; van = *(const u32x4*)vp_; vbn = *(const u32x4*)(vp_ + PHS); } while (0)
    if (blockIdx.x < 2048) GA_LOAD(blockIdx.x);
    for (int unit = blockIdx.x; unit < 2048; unit += gridDim.x) {
        const int h = unit & 3, cn = unit >> 2, b = cn >> 7, n = cn & 127;
        if (h != h_loaded) { dw = gla_decay_w(A, h, wid, fr, fq); h_loaded = h; }
        const LrRows lrc = lrn; const u32x2 k0 = k0n, k1 = k1n; const u32x4 va = van, vb = vbn;
        if (unit + (int)gridDim.x < 2048) GA_LOAD(unit + gridDim.x);
        gla_decay(lds, lrc, dw, wid, fr, fq);
        {
            const float kk0[4] = {bflo(k0.x), bfhi(k0.x), bflo(k0.y), bfhi(k0.y)}, kk1[4] = {bflo(k1.x), bfhi(k1.x), bflo(k1.y), bfhi(k1.y)};
#pragma unroll
            for (int dir = 0; dir < 2; ++dir) { LAS unsigned* kt = (LAS unsigned*)(lds + (dir ? GA_KTB : GA_KTF));
#pragma unroll
                for (int j = 0; j < 4; ++j) { const int d = db * 4 + j; const float be = LA[(dir * 64 + (dir ? 0 : 63)) * 65 + d];
                    const float e0 = __expf(be - LA[(dir * 64 + 2 * sp) * 65 + d]), e1 = __expf(be - LA[(dir * 64 + 2 * sp + 1) * 65 + d]);
                    kt[d * (RS72 / 2) + sp] = pk2(kk0[j] * e0, kk1[j] * e1); } }
            if (tid < 128) { const int dir = tid >> 6, d = tid & 63; DEC[((size_t)((dir * 4 + b) * 4 + h) * 128 + n) * 64 + d] = __expf(LA[(dir * 64 + (dir ? 0 : 63)) * 65 + d]); }
        }
        gla_build_vt(va, vb, lds + GA_VT, tid);
        lds_barrier();
        {
            const int dir = wid >> 2, dvt0 = (wid & 3) * 2; LAS const unsigned char* kt = lds + (dir ? GA_KTB : GA_KTF);
            bf16x8 yv[2][2];
#pragma unroll
            for (int dvi = 0; dvi < 2; ++dvi)
#pragma unroll
                for (int ks = 0; ks < 2; ++ks) yv[dvi][ks] = lds_frag(lds + GA_VT + (((dvt0 + dvi) * 16 + fr) * RS72 + ks * 32 + fq * 8) * 2);
            bf16* stp = ST + st_off(dir, b, h, n);
#pragma unroll
            for (int pp = 0; pp < 2; ++pp) {
                bf16x8 x[2][2];
#pragma unroll
                for (int nn = 0; nn < 2; ++nn)
#pragma unroll
                    for (int ks = 0; ks < 2; ++ks) x[nn][ks] = lds_frag(kt + ((32 * pp + 8 * (fr >> 2) + 4 * nn + (fr & 3)) * RS72 + ks * 32 + fq * 8) * 2);
#pragma unroll
                for (int dvi = 0; dvi < 2; ++dvi) { f32x4 a0 = (f32x4){0.f, 0.f, 0.f, 0.f}, a1 = a0;
                    a0 = mfma16(x[0][0], yv[dvi][0], a0); a0 = mfma16(x[0][1], yv[dvi][1], a0); a1 = mfma16(x[1][0], yv[dvi][0], a1); a1 = mfma16(x[1][1], yv[dvi][1], a1);
                    u32x4 w; w.x = pk2(a0[0], a0[1]); w.y = pk2(a0[2], a0[3]); w.z = pk2(a1[0], a1[1]); w.w = pk2(a1[2], a1[3]);
                    *(u32x4*)(stp + ((dvt0 + dvi) * 16 + fr) * 64 + 32 * pp + 8 * fq) = w; } }
        }
    }
    lds_barrier();
#undef GA_LOAD
}
DI void gla_scan(const Args& A, LAS unsigned char* lds, int tid) {
    unsigned* ST = (unsigned*)(A.ws + WS_ST); const float* DEC = (const float*)(A.ws + WS_DEC); LAS float* DL = (LAS float*)lds;
    for (int g0 = blockIdx.x * 512; g0 < 131072; g0 += gridDim.x * 512) {
        const int gt = g0 + tid, seq = g0 >> 12, e2 = gt & 4095, dir = seq >> 4, dk = (2 * e2) & 63;
        __syncthreads();
#pragma unroll
        for (int i = 0; i < 4; ++i) *(LAS f32x4*)(DL + (tid + 512 * i) * 4) = *(const f32x4*)(DEC + (size_t)seq * 8192 + (tid + 512 * i) * 4);
        __syncthreads();
        unsigned* sp = ST + (size_t)seq * 128 * 4096 + e2;
        float s0 = 0.f, s1 = 0.f;
        unsigned nx[32];
#pragma unroll
        for (int j = 0; j < 32; ++j) { const int n = dir ? 127 - j : j; nx[j] = __builtin_nontemporal_load(sp + (size_t)n * 4096); }
#pragma unroll 1
        for (int i0 = 0; i0 < 128; i0 += 32) {
            unsigned ds[32];
#pragma unroll
            for (int j = 0; j < 32; ++j) ds[j] = nx[j];
            if (i0 + 32 < 128) {
#pragma unroll
                for (int j = 0; j < 32; ++j) { const int n = dir ? 127 - (i0 + 32 + j) : i0 + 32 + j; nx[j] = __builtin_nontemporal_load(sp + (size_t)n * 4096); } }
#pragma unroll
            for (int j = 0; j < 32; ++j) { const int n = dir ? 127 - (i0 + j) : i0 + j; const float d0 = DL[n * 64 + dk], d1 = DL[n * 64 + dk + 1];
                sp[(size_t)n * 4096] = pk2(s0, s1); s0 = d0 * s0 + bflo(ds[j]); s1 = d1 * s1 + bfhi(ds[j]); }
        }
    }
}
DI void gla_pass_c(const Args& A, LAS unsigned char* lds, int tid) {
    const int lane = tid & 63, wid = tid >> 6, fr = lane & 15, fq = lane >> 4;
    const bf16* P = (const bf16*)(A.ws + WS_P); const bf16* ST = (const bf16*)(A.ws + WS_ST); bf16* Y = (bf16*)(A.ws + WS_Y);
    LAS float* LA = (LAS float*)(lds + G_LA); LAS float* RS = (LAS float*)(lds + GC_RS);
    const bf16* LRg = (const bf16*)(A.ws + WS_LR); int h_loaded = -1; DecayW dw; dw.bh = (bf16x8){0,0,0,0,0,0,0,0}; dw.bl = dw.bh; dw.bias = 0.f;
    const int t = tid >> 3, d8 = (tid & 7) * 8, vsp = tid & 31, vdb = tid >> 5, ott = wid & 3, odvh = wid >> 2, ot = ott * 16 + fr;
    LrRows lrn; u32x4 qn, kn, van, vbn, stn[4], ggn[2]; f32x4 ngv[4];
#pragma unroll
    for (int i = 0; i < 4; ++i) ngv[i] = (f32x4){0.f, 0.f, 0.f, 0.f};
#define GC_LOAD(un) do { const int h_ = (un) & 3, cn_ = (un) >> 2, tok_ = cn_ * 64; lrn = gla_load_lr(LRg, tok_, wid, fr, fq); \
        const bf16* qp_ = P + ((size_t)h_ * NTOK + tok_ + t) * PHS + d8; qn = *(const u32x4*)qp_; kn = *(const u32x4*)(qp_ + 64); \
        const bf16* vp_ = P + ((size_t)h_ * NTOK + tok_ + 2 * vsp) * PHS + 128 + vdb * 8; van = *(const u32x4*)vp_; vbn = *(const u32x4*)(vp_ + PHS); \
        _Pragma("unroll") for (int i_ = 0; i_ < 4; ++i_) { const int ci_ = tid + 512 * i_; stn[i_] = *(const u32x4*)(ST + st_off(ci_ >> 10, cn_ >> 7, h_, cn_ & 127) + (ci_ & 1023) * 8); } \
        _Pragma("unroll") for (int pp_ = 0; pp_ < 2; ++pp_) ggn[pp_] = *(const u32x4*)(P + ((size_t)h_ * NTOK + tok_ + ot) * PHS + 256 + odvh * 64 + 32 * pp_ + 8 * fq); } while (0)
    if (blockIdx.x < 2048) GC_LOAD(blockIdx.x);
    for (int unit = blockIdx.x; unit < 2048; unit += gridDim.x) {
        const int h = unit & 3, cn = unit >> 2, tok0 = cn * 64;
        if (h != h_loaded) { dw = gla_decay_w(A, h, wid, fr, fq); h_loaded = h;
#pragma unroll
            for (int dvi = 0; dvi < 4; ++dvi) ngv[dvi] = *(const f32x4*)(A.in[7] + h * 128 + odvh * 64 + 32 * (dvi >> 1) + 8 * fq + 4 * (dvi & 1)); }
        const LrRows lrc = lrn; const u32x4 q = qn, k = kn, va = van, vb = vbn; u32x4 stc[4]; const u32x4 gg[2] = {ggn[0], ggn[1]};
#pragma unroll
        for (int i = 0; i < 4; ++i) stc[i] = stn[i];
        if (unit + (int)gridDim.x < 2048) GC_LOAD(unit + gridDim.x);
        DUP(13) gla_decay(lds, lrc, dw, wid, fr, fq);
        DUP(10) {
#pragma unroll
            for (int dir = 0; dir < 2; ++dir) { u32x4 qo, ko;
#pragma unroll
                for (int e = 0; e < 4; ++e) { const float b0 = LA[(dir * 64 + t) * 65 + d8 + 2 * e], b1 = LA[(dir * 64 + t) * 65 + d8 + 2 * e + 1];
                    qo[e] = pk2(bflo(q[e]) * __expf(b0), bfhi(q[e]) * __expf(b1)); ko[e] = pk2(bflo(k[e]) * __expf(-b0), bfhi(k[e]) * __expf(-b1)); }
                *(LAS u32x4*)(lds + (dir ? GC_QDB : GC_QDF) + (t * RS72 + d8) * 2) = qo; *(LAS u32x4*)(lds + (dir ? GC_KDB : GC_KDF) + (t * RS72 + d8) * 2) = ko; }
        }
        gla_build_vt(va, vb, lds + GC_VT, tid);
#pragma unroll
        for (int i = 0; i < 4; ++i) { const int ci = tid + 512 * i, cc = ci & 1023; *(LAS u32x4*)(lds + ((ci >> 10) ? GC_STB : GC_STF) + ((cc >> 3) * RS72 + (cc & 7) * 8) * 2) = stc[i]; }
        lds_barrier();
        DUP(11) {
#pragma unroll
            for (int ti = 0; ti < 2; ++ti) { const int tile = wid * 2 + ti, tt = tile >> 2, st = tile & 3;
                f32x4 af = (f32x4){0.f, 0.f, 0.f, 0.f}, ab = af;
                if (st <= tt) {
#pragma unroll
                    for (int ks = 0; ks < 2; ++ks) af = mfma16(lds_frag(lds + GC_KDF + ((st * 16 + fr) * RS72 + ks * 32 + fq * 8) * 2), lds_frag(lds + GC_QDF + ((tt * 16 + fr) * RS72 + ks * 32 + fq * 8) * 2), af); }
                if (st >= tt) {
#pragma unroll
                    for (int ks = 0; ks < 2; ++ks) ab = mfma16(lds_frag(lds + GC_KDB + ((st * 16 + fr) * RS72 + ks * 32 + fq * 8) * 2), lds_frag(lds + GC_QDB + ((tt * 16 + fr) * RS72 + ks * 32 + fq * 8) * 2), ab); }
                const int t = tt * 16 + fr, s0 = st * 16 + 4 * fq; float v[4];
#pragma unroll
                for (int r = 0; r < 4; ++r) v[r] = ((s0 + r) <= t ? af[r] : 0.f) + ((s0 + r) >= t ? ab[r] : 0.f);
                u32x2 w; w.x = pk2(v[0], v[1]); w.y = pk2(v[2], v[3]);
                *(LAS u32x2*)(lds + GC_SS + (t * RS72 + s0) * 2) = w; }
        }
        lds_barrier();
        DUP(12) {
            const int tt = wid & 3, dvh = wid >> 2, t = tt * 16 + fr;
            bf16x8 yv[6];
#pragma unroll
            for (int ks = 0; ks < 2; ++ks) { yv[ks] = lds_frag(lds + GC_SS + (t * RS72 + ks * 32 + fq * 8) * 2); yv[2 + ks] = lds_frag(lds + GC_QDF + (t * RS72 + ks * 32 + fq * 8) * 2); yv[4 + ks] = lds_frag(lds + GC_QDB + (t * RS72 + ks * 32 + fq * 8) * 2); }
            f32x4 acc[4]; float q = 0.f;
#pragma unroll
            for (int dvi = 0; dvi < 4; ++dvi) { const int dvr = dvh * 64 + 32 * (dvi >> 1) + 8 * (fr >> 2) + 4 * (dvi & 1) + (fr & 3); f32x4 a = (f32x4){0.f, 0.f, 0.f, 0.f};
#pragma unroll
                for (int ks = 0; ks < 2; ++ks) { a = mfma16(lds_frag(lds + GC_VT + (dvr * RS72 + ks * 32 + fq * 8) * 2), yv[ks], a);
                    a = mfma16(lds_frag(lds + GC_STF + (dvr * RS72 + ks * 32 + fq * 8) * 2), yv[2 + ks], a); a = mfma16(lds_frag(lds + GC_STB + (dvr * RS72 + ks * 32 + fq * 8) * 2), yv[4 + ks], a); }
                acc[dvi] = a; q += (a[0] * a[0] + a[1] * a[1]) + (a[2] * a[2] + a[3] * a[3]); }
            q += __shfl_xor(q, 16); q += __shfl_xor(q, 32);
            if (fq == 0) RS[dvh * 64 + t] = q;
            lds_barrier();
            const float rn = rsqrtf((RS[t] + RS[64 + t]) * (1.0f / 128.0f) + EPS);
#pragma unroll
            for (int pp = 0; pp < 2; ++pp) { const int col = h * 128 + dvh * 64 + 32 * pp + 8 * fq; const u32x4 g4 = gg[pp];
                const f32x4 n0 = ngv[2 * pp], n1 = ngv[2 * pp + 1], a0 = acc[2 * pp], a1 = acc[2 * pp + 1];
                u32x4 w; w.x = pk2(a0[0] * rn * n0[0] * silu_f(bflo(g4.x)), a0[1] * rn * n0[1] * silu_f(bfhi(g4.x))); w.y = pk2(a0[2] * rn * n0[2] * silu_f(bflo(g4.y)), a0[3] * rn * n0[3] * silu_f(bfhi(g4.y)));
                w.z = pk2(a1[0] * rn * n1[0] * silu_f(bflo(g4.z)), a1[1] * rn * n1[1] * silu_f(bfhi(g4.z))); w.w = pk2(a1[2] * rn * n1[2] * silu_f(bflo(g4.w)), a1[3] * rn * n1[3] * silu_f(bfhi(g4.w)));
                *(u32x4*)(Y + (size_t)(tok0 + t) * DM + col) = w; }
        }
    }
    lds_barrier();
#undef GC_LOAD
}
DI void final_norm(const Args& A, int tid, float* dst) {
    const int lane = tid & 63, wid = tid >> 6; const float* ssq = (const float*)(A.ws + WS_SSQ2); const float* gf = A.in[17];
    f32x4 gv[4];
#pragma unroll
    for (int j = 0; j < 4; ++j) gv[j] = *(const f32x4*)(gf + lane * 4 + 256 * j);
    for (int row = blockIdx.x * 8 + wid; row < NTOK; row += gridDim.x * 8) { float* xr = A.out + (size_t)row * DM; float* dr = dst + (size_t)row * DM; const float rs = rsqrtf(ssq[row] * (1.0f / 1024.0f) + EPS);
#pragma unroll
        for (int j = 0; j < 4; ++j) { const int o = lane * 4 + 256 * j; *(f32x4*)(dr + o) = *(const f32x4*)(xr + o) * rs * gv[j]; } }
}

__global__ void __launch_bounds__(512, 2) fwd_kernel(Args args) {
    extern __shared__ __attribute__((aligned(16))) unsigned char lds_raw[];
    LAS unsigned char* lds = (LAS unsigned char*)lds_raw;
    const int tid = threadIdx.x, lo = args.ph_lo, hi = args.ph_hi;
#define IN(k) (lo <= (k) && (k) < hi)
    volatile LAS unsigned* xst = (volatile LAS unsigned*)(lds + LDS_BYTES - 16);
    if (tid < 2) xst[tid] = 0u;
    __syncthreads();
    const XcdBarrier xbar = xcd_barrier_post((unsigned*)(args.ws + WS_BAR), xst);
    if (hi > NPH) cg::this_grid().sync();
#define SEAM(k) do { if (IN(k) && IN((k) + 1)) xcd_barrier(xbar); } while (0)
    if (IN(0)) { DUP(0) p0_prologue(args, lds, tid); } SEAM(0);
    if (IN(1)) { pg8::Gemm g{(const bf16*)(args.ws + WS_H), (const bf16*)(args.ws + WS_BT1), NTOK, N1, DM}; OrderG1 S; S.init(gridDim.x, blockIdx.x);
        Epi1 E{(bf16*)(args.ws + WS_P), (bf16*)(args.ws + WS_PU), (bf16*)(args.ws + WS_LR)};
        pg8::gemm_phase<Epi1, OrderG1, true, true, 10>(lds, g, S, E); } SEAM(1);
    if (IN(2)) { DUP(2) { gmlp_phase(args, lds, tid); __syncthreads(); } DUP(3) { gla_pass_a(args, lds, tid); } } SEAM(2);
    if (IN(3)) { gla_scan(args, lds, tid); if ((PROBE_DUP >> 9) & 1) { xcd_barrier(xbar); gla_pass_a(args, lds, tid); xcd_barrier(xbar); gla_scan(args, lds, tid); } } SEAM(3);
    if (IN(4)) { DUP(4) gla_pass_c(args, lds, tid); } SEAM(4);
    if (IN(5)) { pg8::Gemm g{(const bf16*)(args.ws + WS_Y), (const bf16*)(args.ws + WS_BT2), NTOK, DM, DM}; pg8::StaticOrder S; S.init(NTOK, DM, gridDim.x, blockIdx.x);
        EpiRes<0> E{(const float*)(args.ws + WS_XSC), (const bf16*)(args.ws + WS_H), args.in[1], (bf16*)(args.ws + WS_ST), (float*)(args.ws + WS_SSQ1)}; pg8::gemm_phase<EpiRes<0>, pg8::StaticOrder, true, true>(lds, g, S, E); } SEAM(5);
    if (IN(6)) { pg8::Gemm g{(const bf16*)(args.ws + WS_ST), (const bf16*)(args.ws + WS_BT3), NTOK, N3, DM}; pg8::StaticOrder S; S.init(NTOK, N3, gridDim.x, blockIdx.x);
        Epi3 E{(bf16*)(args.ws + WS_P), (const float*)(args.ws + WS_SSQ1)}; DUP(6) pg8::gemm_phase<Epi3, pg8::StaticOrder, true, true>(lds, g, S, E); } SEAM(6);
    if (IN(7)) { pg8::Gemm g{(const bf16*)(args.ws + WS_P), (const bf16*)(args.ws + WS_BT4), NTOK, DM, DFF}; pg8::StaticOrder S; S.init(NTOK, DM, gridDim.x, blockIdx.x);
        if (gridDim.x == 256) {
            EpiFinal E{(const bf16*)(args.ws + WS_ST), args.out, (float*)(args.ws + WS_SSQ2), (unsigned*)(args.ws + WS_CNT), args.in[17]}; pg8::gemm_phase<EpiFinal, pg8::StaticOrder, true, true>(lds, g, S, E); }
        else { EpiRes<1> E{nullptr, (const bf16*)(args.ws + WS_ST), (const float*)args.out, nullptr, (float*)(args.ws + WS_SSQ2)}; pg8::gemm_phase<EpiRes<1>, pg8::StaticOrder, true, true>(lds, g, S, E); } }
    if (gridDim.x != 256) SEAM(7);
    if (IN(8) && gridDim.x != 256) { final_norm(args, tid, args.out); }
#undef IN
#undef SEAM
}

extern "C" void kernel_launch(void* const* d_in, const int* in_sizes, int n_in, void* d_out, int out_size, void* d_ws, size_t ws_size, hipStream_t stream) {
    static int grid = 0;
    if (grid == 0) {
        if (n_in != 18 || out_size != NTOK * DM || ws_size < WS_END) { fprintf(stderr, "kernel_launch: unexpected shapes (n_in %d out %d ws %zu)\n", n_in, out_size, ws_size); grid = -1; return; }
        int dev = 0, cus = 0, per_cu = 0;
        hipGetDevice(&dev); hipDeviceGetAttribute(&cus, hipDeviceAttributeMultiprocessorCount, dev);
        if (hipFuncSetAttribute((const void*)fwd_kernel, hipFuncAttributeMaxDynamicSharedMemorySize, LDS_BYTES) != hipSuccess) { fprintf(stderr, "kernel_launch: hipFuncSetAttribute failed\n"); grid = -1; return; }
        if (hipOccupancyMaxActiveBlocksPerMultiprocessor(&per_cu, (const void*)fwd_kernel, 512, LDS_BYTES) != hipSuccess || per_cu < 1) { fprintf(stderr, "kernel_launch: occupancy query says %d\n", per_cu); per_cu = 1; }
        (void)hipGetLastError();
        grid = cus * 1;
        fprintf(stderr, "kernel_launch: grid %d (cus %d, per_cu %d)\n", grid, cus, per_cu);
    }
    if (grid < 0) return;
    Args a{};
    for (int i = 0; i < 18; ++i) a.in[i] = (const float*)d_in[i];
    a.out = (float*)d_out; a.ws = (unsigned char*)d_ws;
    if (hipMemsetAsync((char*)d_ws + WS_BAR, 0, WS_BAR_BYTES, stream) != hipSuccess) { fprintf(stderr, "kernel_launch: memset failed\n"); return; }
#if MK_N_LAUNCHES == 1
    a.ph_lo = 0; a.ph_hi = NPH;
    void* kargs[] = {&a};
    hipError_t e = hipLaunchCooperativeKernel((const void*)fwd_kernel, dim3(grid), dim3(512), kargs, LDS_BYTES, stream);
    if (e != hipSuccess) fprintf(stderr, "kernel_launch: cooperative launch failed: %s (grid %d)\n", hipGetErrorString(e), grid);
#else
    for (int ph = 0; ph < 9; ++ph) { a.ph_lo = ph; a.ph_hi = ph + 1; hipLaunchKernelGGL(fwd_kernel, dim3(grid), dim3(512), LDS_BYTES, stream, a); }
#endif
}
```

```cpp
#include <hip/hip_runtime.h>
#include <hip/hip_cooperative_groups.h>
#include <cstdio>
#include <cstdint>
namespace pg8 {
#define PG8_LAS __attribute__((address_space(3)))
typedef unsigned short bf16_t;
typedef short bf16x8 __attribute__((ext_vector_type(8)));
typedef float f32x4 __attribute__((ext_vector_type(4)));
typedef unsigned u32x4 __attribute__((ext_vector_type(4)));
constexpr int BM = 256, BK = 64, HALF = 128, HTB = HALF * BK * 2  , STAGE_BYTES = 8 * HTB, NXCD = 8, WGM = 8;

__host__ __device__ __forceinline__ int lds_byte(int r, int c) { const int st = (r >> 4) * 2 + (c >> 5), rr = r & 15, cc = c & 31, ob = rr * 64 + cc * 2; return st * 1024 + (ob ^ (((ob >> 9) & 1) << 5)); }
__host__ __device__ __forceinline__ void stage_rc(int b, int& R, int& C) { const int st = b / 1024, sb = b % 1024, swz = sb ^ (((sb >> 9) & 1) << 5); R = (st >> 1) * 16 + swz / 64; C = (st & 1) * 32 + (swz % 64) / 2; }
__host__ __device__ __forceinline__ int perm32(int rho) { const int n = rho >> 4, i = rho & 15; return 8 * (i >> 2) + 4 * n + (i & 3); }

struct Unit { int pm, pn; };
struct Gemm { const bf16_t* A; const bf16_t* Bt; int M, N, K; };

struct StaticOrder {
    int nM, nN, nwg, G, c;
    __host__ __device__ void init(int M, int N, int G_, int c_) { nM = M / BM; nN = N / BM; nwg = nM * nN; G = G_; c = c_; }
    __host__ __device__ bool next(int i, Unit& u) const {
        const long L = (long)i * G + c; if (L >= nwg) return false;
        int wgid = (int)L; { const int q = nwg / NXCD, r = nwg % NXCD, xcd = wgid % NXCD, off = wgid / NXCD; wgid = (xcd < r ? xcd * (q + 1) : r * (q + 1) + (xcd - r) * q) + off; }
        const int nig = WGM * nN, gid = wgid / nig, fm = gid * WGM, gsz = (nM - fm) < WGM ? (nM - fm) : WGM;
        u.pm = fm + ((wgid % nig) % gsz); u.pn = (wgid % nig) / gsz; return true;
    }
    __device__ __forceinline__ void a_ready(const Unit&) const {}
    __device__ __forceinline__ void done(const Unit&) const {}
};
__device__ __forceinline__ unsigned cvt_pk_bf16(float lo, float hi) { unsigned r; asm volatile("v_cvt_pk_bf16_f32 %0, %1, %2" : "=v"(r) : "v"(lo), "v"(hi)); return r; }
typedef float f32x2 __attribute__((ext_vector_type(2)));
__device__ __forceinline__ f32x2 gelu_pk(f32x2 v) {
    const f32x2 av = __builtin_elementwise_abs(v), d = av * 0.2316418882f + 1.0f;
    f32x2 t; t.x = __builtin_amdgcn_rcpf(d.x); t.y = __builtin_amdgcn_rcpf(d.y);
    f32x2 q = t * 0.5307027145f + (-0.7265760135f); q = q * t + 0.7107068705f; q = q * t + (-0.142248368f); q = q * t + 0.127414796f; q = q * t;
    const f32x2 s = (v * v) * (-0.72134752044f);
    f32x2 e; e.x = __builtin_amdgcn_exp2f(s.x); e.y = __builtin_amdgcn_exp2f(s.y);
    const f32x2 m = v * (q * e), r = v - m;
    f32x2 o; o.x = v.x < 0.f ? m.x : r.x; o.y = v.y < 0.f ? m.y : r.y; return o;
}
template <class Epi, class Sched, bool ALIGN_EPI = false, bool SP2 = false, int NARROW_PN = -1  >
__device__ __forceinline__ void gemm_phase(PG8_LAS unsigned char* lds, const Gemm g, const Sched& S, const Epi& E) {
    const int tid = threadIdx.x, wid = __builtin_amdgcn_readfirstlane(tid >> 6), lane = tid & 63, wr = wid >> 2, wc = wid & 3, fr = lane & 15, fq = lane >> 4;
    const int K = g.K, nt = K / BK;
    unsigned voffA[2], voffB[2];
#pragma unroll
    for (int i = 0; i < 2; ++i) { int R, C; stage_rc(tid * 16 + i * 8192, R, C); const int Rb = Epi::PERM ? ((R & ~31) + perm32(R & 31)) : R;
        voffA[i] = (unsigned)(R * K + C) * 2u; voffB[i] = (unsigned)(Rb * K + C) * 2u; }
    const size_t kstep = (size_t)(BK * 2);
    const size_t hstep = (size_t)HALF * K * 2;
    const size_t tstep = 2 * hstep;
    const unsigned ldsw = (unsigned)wid * 1024u;
    const int aoff = lds_byte(wr * 64 + fr, fq * 8), boff = lds_byte(wc * 32 + fr, fq * 8);
#define PG8_SA(b, h) (((b) * 2 + (h)) * HTB)
#define PG8_SB(b, h) ((4 + (b) * 2 + (h)) * HTB)
#define PG8_STAGE(bufoff, gbase, voff) do { _Pragma("unroll") for (int _i = 0; _i < 2; ++_i) \
        __builtin_amdgcn_global_load_lds((const unsigned*)((const char*)(gbase) + (voff)[_i]), (PG8_LAS unsigned*)(lds + (bufoff) + ldsw + _i * 8192), 16, 0, 0); } while (0)
#define PG8_LDA(dst, b, h) do { _Pragma("unroll") for (int m = 0; m < 4; ++m) _Pragma("unroll") for (int k = 0; k < 2; ++k) dst[m][k] = *(const PG8_LAS bf16x8*)(lds + PG8_SA(b, h) + aoff + m * 2048 + k * 1024); } while (0)
#define PG8_LDB(dst, b, h) do { _Pragma("unroll") for (int n = 0; n < 2; ++n) _Pragma("unroll") for (int k = 0; k < 2; ++k) dst[n][k] = *(const PG8_LAS bf16x8*)(lds + PG8_SB(b, h) + boff + n * 2048 + k * 1024); } while (0)
#define PG8_MMA(ai, bj, At, Bt) do { __builtin_amdgcn_s_setprio(1); _Pragma("unroll") for (int m = 0; m < 4; ++m) _Pragma("unroll") for (int n = 0; n < 2; ++n) _Pragma("unroll") for (int k = 0; k < 2; ++k) \
        acc[ai][bj][m][n] = __builtin_amdgcn_mfma_f32_16x16x32_bf16(Bt[n][k], At[m][k], acc[ai][bj][m][n], 0, 0, 0); __builtin_amdgcn_s_setprio(0); } while (0)
#define PG8_WAIT_V(n) asm volatile("s_waitcnt vmcnt(" #n ")" ::: "memory")
#define PG8_WAIT_L(n) asm volatile("s_waitcnt lgkmcnt(" #n ")" ::: "memory")
#define PG8_BAR __builtin_amdgcn_s_barrier()
#define PG8_SCHED __builtin_amdgcn_sched_barrier(0)
    Unit cur, nxt; int ui = 0;
    if (!S.next(0, cur)) return;
    f32x4 acc[2][2][4][2];
#pragma unroll
    for (int a = 0; a < 2; ++a)
#pragma unroll
        for (int b = 0; b < 2; ++b)
#pragma unroll
            for (int m = 0; m < 4; ++m)
#pragma unroll
                for (int n = 0; n < 2; ++n) acc[a][b][m][n] = (f32x4){0.f, 0.f, 0.f, 0.f};
    bf16x8 At[4][2], B0[2][2], B1[2][2];
    const char* cA = (const char*)g.A + (size_t)cur.pm * tstep; const char* cB = (const char*)g.Bt + (size_t)cur.pn * tstep;
    S.a_ready(cur);
    if constexpr (SP2) {
        PG8_STAGE(PG8_SB(0, 0), cB, voffB); PG8_STAGE(PG8_SB(0, 1), cB + hstep, voffB); PG8_STAGE(PG8_SA(0, 0), cA, voffA); PG8_STAGE(PG8_SA(0, 1), cA + hstep, voffA);
        if (wr == 1) PG8_BAR;
        PG8_WAIT_V(2); PG8_BAR;
        PG8_STAGE(PG8_SB(1, 0), cB + kstep, voffB); PG8_STAGE(PG8_SA(1, 0), cA + kstep, voffA); PG8_STAGE(PG8_SB(1, 1), cB + hstep + kstep, voffB);
        PG8_WAIT_V(6); PG8_BAR;
    } else {
        PG8_STAGE(PG8_SB(0, 0), cB, voffB); PG8_STAGE(PG8_SA(0, 0), cA, voffA); PG8_STAGE(PG8_SB(0, 1), cB + hstep, voffB); PG8_STAGE(PG8_SA(0, 1), cA + hstep, voffA);
        if (wr == 1) PG8_BAR;
        PG8_WAIT_V(4); PG8_BAR;
        PG8_STAGE(PG8_SB(1, 0), cB + kstep, voffB); PG8_STAGE(PG8_SA(1, 0), cA + kstep, voffA); PG8_STAGE(PG8_SB(1, 1), cB + hstep + kstep, voffB);
        PG8_WAIT_V(6); PG8_BAR;
    }
    for (;;) {
        const bool has_next = S.next(ui + 1, nxt); const bool narrow = (NARROW_PN >= 0) && (cur.pn == NARROW_PN);
        const char* nA = has_next ? (const char*)g.A + (size_t)nxt.pm * tstep : cA; const char* nB = has_next ? (const char*)g.Bt + (size_t)nxt.pn * tstep : cB;
        for (int t = 0; t < nt; t += 2) {
            const bool last = (t == nt - 2);
            const char* a1 = cA + (size_t)(t + 1) * kstep;
            const char* a2 = last ? nA : cA + (size_t)(t + 2) * kstep; const char* b2 = last ? nB : cB + (size_t)(t + 2) * kstep;
            const char* a3 = a2 + kstep; const char* b3 = b2 + kstep;
            if (last && has_next) S.a_ready(nxt);
            if constexpr (SP2) {
            PG8_LDB(B0, 0, 0); PG8_LDB(B1, 0, 1); PG8_SCHED; PG8_LDA(At, 0, 0); PG8_STAGE(PG8_SA(1, 1), a1 + hstep, voffA);
            PG8_WAIT_V(8); PG8_WAIT_L(0); PG8_BAR; PG8_MMA(0, 0, At, B0); if (NARROW_PN < 0 || !narrow) PG8_MMA(0, 1, At, B1); PG8_BAR; PG8_SCHED;
            PG8_LDA(At, 0, 1); PG8_STAGE(PG8_SB(0, 0), b2, voffB); PG8_STAGE(PG8_SB(0, 1), b2 + hstep, voffB); PG8_STAGE(PG8_SA(0, 0), a2, voffA);
            PG8_WAIT_V(8); PG8_WAIT_L(0); PG8_BAR; PG8_MMA(1, 0, At, B0); if (NARROW_PN < 0 || !narrow) PG8_MMA(1, 1, At, B1); PG8_BAR; PG8_SCHED;
            PG8_LDB(B0, 1, 0); PG8_LDB(B1, 1, 1); PG8_SCHED; PG8_LDA(At, 1, 0); PG8_STAGE(PG8_SA(0, 1), a2 + hstep, voffA);
            PG8_WAIT_V(8); PG8_WAIT_L(0); PG8_BAR; PG8_MMA(0, 0, At, B0); if (NARROW_PN < 0 || !narrow) PG8_MMA(0, 1, At, B1); PG8_BAR; PG8_SCHED;
            PG8_LDA(At, 1, 1); PG8_STAGE(PG8_SB(1, 0), b3, voffB); PG8_STAGE(PG8_SB(1, 1), b3 + hstep, voffB); PG8_STAGE(PG8_SA(1, 0), a3, voffA);
            PG8_WAIT_V(8); PG8_WAIT_L(0); PG8_BAR; PG8_MMA(1, 0, At, B0); if (NARROW_PN < 0 || !narrow) PG8_MMA(1, 1, At, B1); PG8_BAR; PG8_SCHED;
            } else {
            PG8_LDB(B0, 0, 0); PG8_SCHED; PG8_LDA(At, 0, 0); PG8_STAGE(PG8_SA(1, 1), a1 + hstep, voffA);
            PG8_WAIT_L(8); PG8_BAR; PG8_WAIT_L(0); PG8_MMA(0, 0, At, B0); PG8_BAR; PG8_SCHED;
            PG8_LDB(B1, 0, 1); PG8_STAGE(PG8_SB(0, 0), b2, voffB);
            PG8_BAR; PG8_WAIT_L(0); PG8_MMA(0, 1, At, B1); PG8_BAR;
            PG8_LDA(At, 0, 1); PG8_STAGE(PG8_SA(0, 0), a2, voffA);
            PG8_BAR; PG8_WAIT_L(0); PG8_MMA(1, 0, At, B0); PG8_BAR; PG8_SCHED;
            PG8_STAGE(PG8_SB(0, 1), b2 + hstep, voffB);
            PG8_WAIT_V(6); PG8_BAR; PG8_MMA(1, 1, At, B1); PG8_BAR;
            PG8_LDB(B0, 1, 0); PG8_SCHED; PG8_LDA(At, 1, 0); PG8_STAGE(PG8_SA(0, 1), a2 + hstep, voffA);
            PG8_WAIT_L(8); PG8_BAR; PG8_WAIT_L(0); PG8_MMA(0, 0, At, B0); PG8_BAR; PG8_SCHED;
            PG8_LDB(B1, 1, 1); PG8_STAGE(PG8_SB(1, 0), b3, voffB);
            PG8_BAR; PG8_WAIT_L(0); PG8_MMA(0, 1, At, B1); PG8_BAR;
            PG8_LDA(At, 1, 1); PG8_STAGE(PG8_SA(1, 0), a3, voffA);
            PG8_BAR; PG8_WAIT_L(0); PG8_MMA(1, 0, At, B0); PG8_BAR; PG8_SCHED;
            PG8_STAGE(PG8_SB(1, 1), b3 + hstep, voffB);
            PG8_WAIT_V(6); PG8_BAR; PG8_MMA(1, 1, At, B1); PG8_BAR;
            }
        }
        if constexpr (ALIGN_EPI) { if (wr == 0) PG8_BAR; }
        if constexpr (!Epi::AFTER_DRAIN) { E(acc, cur, wr, wc, fr, fq); S.done(cur); }
        if (!has_next) break;
#pragma unroll
        for (int a = 0; a < 2; ++a)
#pragma unroll
            for (int b = 0; b < 2; ++b)
#pragma unroll
                for (int m = 0; m < 4; ++m)
#pragma unroll
                    for (int n = 0; n < 2; ++n) acc[a][b][m][n] = (f32x4){0.f, 0.f, 0.f, 0.f};
        cur = nxt; cA = nA; cB = nB; ++ui;
        if constexpr (ALIGN_EPI) { if (wr == 1) PG8_BAR; }
    }
    PG8_WAIT_V(0);
    if constexpr (!ALIGN_EPI) { if (wr == 0) PG8_BAR; }
    PG8_BAR;
    if constexpr (Epi::AFTER_DRAIN) { E.fused(acc, cur, wr, wc, fr, fq, lds, wid, lane); S.done(cur); }
#undef PG8_SA
#undef PG8_SB
#undef PG8_STAGE
#undef PG8_LDA
#undef PG8_LDB
#undef PG8_MMA
#undef PG8_WAIT_V
#undef PG8_WAIT_L
#undef PG8_BAR
#undef PG8_SCHED
}
}

namespace cg = cooperative_groups;
#define LAS __attribute__((address_space(3)))
#define DI __device__ __forceinline__
typedef unsigned short bf16;
typedef short bf16x8 __attribute__((ext_vector_type(8)));
typedef float f32x4 __attribute__((ext_vector_type(4)));
typedef unsigned u32x4 __attribute__((ext_vector_type(4)));
typedef unsigned u32x2 __attribute__((ext_vector_type(2)));

#ifndef MK_N_LAUNCHES
#define MK_N_LAUNCHES 1
#endif
#define PROBE_DUP 0
#define DUP(bit) for (int rep_ = 0; rep_ < (((PROBE_DUP) >> (bit)) & 1) + 1; ++rep_)
constexpr int NPH = 10;
constexpr int NTOK = 32768, DM = 1024, PWSRC = 2592, N1 = 2816, PHS = 384, PUS = 1024, DFF = 2816, N3 = 5632;
constexpr float EPS = 1e-6f;
constexpr size_t MiB = 1u << 20;
constexpr size_t WS_SSQ1 = 0, WS_SSQ2 = 128 * 1024, WS_XSC = 256 * 1024, WS_WSB = 1 * MiB, WS_RSW = 1 * MiB + 256 * 1024, WS_BT1 = 2 * MiB, WS_BT2 = 8 * MiB, WS_BT3 = 10 * MiB, WS_BT4 = 21 * MiB,
                 WS_DEC = 27 * MiB, WS_LR = 28 * MiB, WS_H = 32 * MiB  , WS_ST = 96 * MiB  ,
                 WS_P = 160 * MiB  , WS_Y = 336 * MiB  , WS_END = 400 * MiB;
constexpr size_t WS_BAR = 512 * 1024, WS_CNT = WS_BAR + 16384, WS_BAR_BYTES = 16384 + 32768;
constexpr size_t WS_PU = WS_P + (size_t)4 * NTOK * PHS * 2;
constexpr int LDS_BYTES = 151552;

typedef float f32x2_t __attribute__((ext_vector_type(2))); typedef __bf16 bf16x2_t __attribute__((ext_vector_type(2)));
DI unsigned pk2(float lo, float hi) { f32x2_t v = {lo, hi}; bf16x2_t b = __builtin_convertvector(v, bf16x2_t); return __builtin_bit_cast(unsigned, b); }
DI float bflo(unsigned u) { return __uint_as_float(u << 16); }
DI float bfhi(unsigned u) { return __uint_as_float(u & 0xffff0000u); }
DI float silu_f(float g) { return g * __builtin_amdgcn_rcpf(1.0f + __expf(-g)); }
DI float logsig(float z) { return fminf(z, 0.f) - __logf(1.0f + __expf(-fabsf(z))); }
DI void lds_barrier() { asm volatile("s_waitcnt lgkmcnt(0)" ::: "memory"); __builtin_amdgcn_s_barrier(); asm volatile("" ::: "memory"); }
DI bf16x8 lds_frag(LAS const unsigned char* p) { return *(LAS const bf16x8*)p; }
DI f32x4 mfma16(bf16x8 a, bf16x8 b, f32x4 c) { return __builtin_amdgcn_mfma_f32_16x16x32_bf16(a, b, c, 0, 0, 0); }

#define XB_TMO      128
#define XB_XCNT(j)  (256  + 64 * (j))
#define XB_XSUB(j)  (1280 + 64 * (j))
#define XB_XGEN(j)  (2304 + 64 * (j))
#define XB_TOP      3328
#define XB_TOPGEN   3392
#define XCD_BAR_WORDS 3456
#define XB_SPIN_CAP (1u << 18)

__device__ __forceinline__ unsigned xb_ld(unsigned* p)              { return __hip_atomic_load(p, __ATOMIC_RELAXED, __HIP_MEMORY_SCOPE_AGENT); }
__device__ __forceinline__ unsigned xb_add(unsigned* p, unsigned v) { return __hip_atomic_fetch_add(p, v, __ATOMIC_RELAXED, __HIP_MEMORY_SCOPE_AGENT); }
__device__ __forceinline__ unsigned xb_xcc_id() { return (unsigned)__builtin_amdgcn_s_getreg((3 << 11) | 20) & 0xFu; }
#define XB_SPIN(cond, bar) do { unsigned _sp = 0; while (cond) { __builtin_amdgcn_s_sleep(1); \
    if ((++_sp & 255u) == 0u) { if (xb_ld(&(bar)[XB_TMO])) break; if (_sp > XB_SPIN_CAP) { atomicAdd(&(bar)[XB_TMO], 1u); break; } } } } while (0)

struct XcdBarrier {
    unsigned* bar; unsigned x;
    volatile LAS unsigned* st;
};

__device__ __forceinline__ XcdBarrier xcd_barrier_post(unsigned* bar, volatile LAS unsigned* st) {
    XcdBarrier b; b.bar = bar; b.x = xb_xcc_id(); b.st = st;
    if (threadIdx.x == 0) (void)xb_add(&bar[XB_XCNT(b.x)], 1u);
    return b;
}
__device__ __forceinline__ void xcd_barrier_complete(unsigned* bar, unsigned x, unsigned& nloc, unsigned& nx) {
    const unsigned G = gridDim.x * gridDim.y * gridDim.z;
    unsigned sum, cnt, mine, sp = 0u;
    for (;;) {
        sum = 0u; cnt = 0u; mine = 0u;
#pragma unroll
        for (unsigned j = 0; j < 16; ++j) { const unsigned c = xb_ld(&bar[XB_XCNT(j)]); sum += c; cnt += (c > 0u) ? 1u : 0u; mine = (j == x) ? c : mine; }
        if (sum == G) break;
        __builtin_amdgcn_s_sleep(1);
        if ((++sp & 255u) == 0u) { if (xb_ld(&bar[XB_TMO])) break; if (sp > XB_SPIN_CAP) { atomicAdd(&bar[XB_TMO], 1u); break; } }
    }
    nloc = mine > 0u ? mine : 1u; nx = cnt > 0u ? cnt : 1u;
}

__device__ __forceinline__ void xcd_barrier(const XcdBarrier& b) {
    asm volatile("s_waitcnt vmcnt(0)" ::: "memory");
    __syncthreads();
    if (threadIdx.x == 0) {
        unsigned* bar = b.bar;
        __builtin_amdgcn_s_waitcnt(0);
        unsigned nloc = b.st[0], nx = b.st[1];
        if (nloc == 0u) { xcd_barrier_complete(bar, b.x, nloc, nx); b.st[0] = nloc; b.st[1] = nx; }
        const unsigned old = xb_add(&bar[XB_XSUB(b.x)], 1u);
        const unsigned gen = old / nloc;
        if (old + 1u == (gen + 1u) * nloc) {
            __builtin_amdgcn_fence(__ATOMIC_RELEASE, "agent");
            asm volatile("s_waitcnt vmcnt(0)" ::: "memory");
            const unsigned og = xb_add(&bar[XB_TOP], 1u);
            const unsigned tg = og / nx;
            if (og + 1u == (tg + 1u) * nx) xb_add(&bar[XB_TOPGEN], 1u);
            else XB_SPIN(xb_ld(&bar[XB_TOPGEN]) == tg, bar);
            __builtin_amdgcn_fence(__ATOMIC_ACQUIRE, "agent");
            xb_add(&bar[XB_XGEN(b.x)], 1u);
            asm volatile("s_waitcnt vmcnt(0)" ::: "memory");
        } else {
            XB_SPIN(xb_ld(&bar[XB_XGEN(b.x)]) == gen, bar);
            __builtin_amdgcn_fence(__ATOMIC_ACQUIRE, "agent");
            asm volatile("s_waitcnt vmcnt(0)" ::: "memory");
        }
    }
    __syncthreads();
}

struct OrderG1 { pg8::StaticOrder full, all; bool special; int c;
    __device__ void init(int G, int c_) { special = (G == 256); c = c_; full.init(NTOK, 2560, G, c_); all.init(NTOK, N1, G, c_); }
    __device__ bool next(int i, pg8::Unit& u) const { if (!special) return all.next(i, u); if (i < 5) return full.next(i, u); if (i == 5 && c < 128) { u.pm = c; u.pn = 10; return true; } return false; }
    __device__ __forceinline__ void a_ready(const pg8::Unit&) const {}
    __device__ __forceinline__ void done(const pg8::Unit&) const {}
};
struct Args { const float* in[18]; float* out; unsigned char* ws; int ph_lo, ph_hi; };

struct Epi1 {
    static constexpr bool PERM = true, AFTER_DRAIN = false;
    bf16* P; bf16* PU; bf16* LR;
    DI void operator()(const f32x4 (&acc)[2][2][4][2], const pg8::Unit& u, int wr, int wc, int fr, int fq) const {
        const int row0 = u.pm * 256 + wr * 64 + fr;
        if (u.pn == 10) {
            if (wc == 0) {
#pragma unroll
                for (int ai = 0; ai < 2; ++ai)
#pragma unroll
                    for (int m = 0; m < 4; ++m) { bf16* p = LR + (size_t)(row0 + ai * 128 + m * 16) * 64 + (fq >> 1) * 32 + (fq & 1) * 8; u32x4 hv, lv;
#pragma unroll
                        for (int e = 0; e < 4; ++e) { const float x0 = acc[ai][0][m][e >> 1][(e & 1) * 2], x1 = acc[ai][0][m][e >> 1][(e & 1) * 2 + 1]; const unsigned hp = pk2(x0, x1);
                            hv[e] = hp; lv[e] = pk2(x0 - bflo(hp), x1 - bfhi(hp)); }
                        *(u32x4*)p = hv; *(u32x4*)(p + 16) = lv; }
            }
            return;
        }
        const bool act = u.pn >= 6;
        const int col0 = u.pn * 256 + wc * 32 + 8 * fq;
#pragma unroll
        for (int ai = 0; ai < 2; ++ai)
#pragma unroll
            for (int m = 0; m < 4; ++m) { const int row = row0 + ai * 128 + m * 16;
#pragma unroll
                for (int bj = 0; bj < 2; ++bj) { const int col = col0 + bj * 128;
                    bf16* dst = act ? PU + (size_t)row * PUS + (col - 1536) : P + ((size_t)(col / 384) * NTOK + row) * PHS + col % 384;
                    f32x4 v0 = acc[ai][bj][m][0], v1 = acc[ai][bj][m][1];
                    if (act) { pg8::f32x2 a = pg8::gelu_pk((pg8::f32x2){v0[0], v0[1]}), b = pg8::gelu_pk((pg8::f32x2){v0[2], v0[3]}), c = pg8::gelu_pk((pg8::f32x2){v1[0], v1[1]}), d = pg8::gelu_pk((pg8::f32x2){v1[2], v1[3]});
                        v0 = (f32x4){a.x, a.y, b.x, b.y}; v1 = (f32x4){c.x, c.y, d.x, d.y}; }
                    u32x4 w; w.x = pk2(v0[0], v0[1]); w.y = pk2(v0[2], v0[3]); w.z = pk2(v1[0], v1[1]); w.w = pk2(v1[2], v1[3]);
                    *(u32x4*)dst = w; } }
    }
};
template <int MODE> struct EpiRes {
    static constexpr bool PERM = true, AFTER_DRAIN = false;
    const float* xsc; const bf16* baseb; const float* aux  ; bf16* ob; float* ssq;
    DI void operator()(const f32x4 (&acc)[2][2][4][2], const pg8::Unit& u, int wr, int wc, int fr, int fq) const {
        const int row0 = u.pm * 256 + wr * 64 + fr, col0 = u.pn * 256 + wc * 32 + 8 * fq;
        f32x4 gi[2][2];
        if (MODE == 0) {
#pragma unroll
            for (int bj = 0; bj < 2; ++bj)
#pragma unroll
                for (int n = 0; n < 2; ++n) { const f32x4 gq = *(const f32x4*)(aux + col0 + bj * 128 + n * 4); gi[bj][n] = (f32x4){1.0f / gq[0], 1.0f / gq[1], 1.0f / gq[2], 1.0f / gq[3]}; } }
#pragma unroll
        for (int ai = 0; ai < 2; ++ai) {
            u32x4 bw[4][2]; float sc[4];
#pragma unroll
            for (int m = 0; m < 4; ++m) { if (MODE == 0) sc[m] = xsc[row0 + ai * 128 + m * 16];
#pragma unroll
                for (int bj = 0; bj < 2; ++bj) bw[m][bj] = *(const u32x4*)(baseb + (size_t)(row0 + ai * 128 + m * 16) * DM + col0 + bj * 128); }
#pragma unroll
            for (int m = 0; m < 4; ++m) { const int row = row0 + ai * 128 + m * 16; float s = 0.f;
#pragma unroll
                for (int bj = 0; bj < 2; ++bj) { const size_t o = (size_t)row * DM + col0 + bj * 128; const u32x4 w = bw[m][bj];
                    f32x4 v0 = (f32x4){bflo(w.x), bfhi(w.x), bflo(w.y), bfhi(w.y)}, v1 = (f32x4){bflo(w.z), bfhi(w.z), bflo(w.w), bfhi(w.w)};
                    if (MODE == 0) { v0 = v0 * sc[m] * gi[bj][0]; v1 = v1 * sc[m] * gi[bj][1]; }
                    v0 = v0 + acc[ai][bj][m][0]; v1 = v1 + acc[ai][bj][m][1];
                    s += ((v0[0] * v0[0] + v0[1] * v0[1]) + (v0[2] * v0[2] + v0[3] * v0[3])) + ((v1[0] * v1[0] + v1[1] * v1[1]) + (v1[2] * v1[2] + v1[3] * v1[3]));
                    if (MODE == 0) { u32x4 wo; wo.x = pk2(v0[0], v0[1]); wo.y = pk2(v0[2], v0[3]); wo.z = pk2(v1[0], v1[1]); wo.w = pk2(v1[2], v1[3]); *(u32x4*)(ob + o) = wo; }
                    else { *(f32x4*)((float*)aux + o) = v0; *(f32x4*)((float*)aux + o + 4) = v1; } }
                s += __shfl_xor(s, 16); s += __shfl_xor(s, 32);
                if (fq == 0) atomicAdd(ssq + row, s); }
        }
    }
};
struct EpiFinal {
    static constexpr bool PERM = true, AFTER_DRAIN = false;
    const bf16* base; float* out; float* ssq; unsigned* cnt; const float* gf;
    DI void operator()(f32x4 (&acc)[2][2][4][2], const pg8::Unit& u, int wr, int wc, int fr, int fq) const {
        const int row0 = u.pm * 256 + wr * 64 + fr, col0 = u.pn * 256 + wc * 32 + 8 * fq;
        u32x4 bw[2][4][2];
#pragma unroll
        for (int ai = 0; ai < 2; ++ai)
#pragma unroll
            for (int m = 0; m < 4; ++m)
#pragma unroll
                for (int bj = 0; bj < 2; ++bj) bw[ai][m][bj] = *(const u32x4*)(base + (size_t)(row0 + ai * 128 + m * 16) * DM + col0 + bj * 128);
        f32x4 gv[2][2];
#pragma unroll
        for (int bj = 0; bj < 2; ++bj)
#pragma unroll
            for (int n = 0; n < 2; ++n) gv[bj][n] = *(const f32x4*)(gf + col0 + bj * 128 + n * 4);
#pragma unroll
        for (int ai = 0; ai < 2; ++ai)
#pragma unroll
            for (int m = 0; m < 4; ++m) { const int row = row0 + ai * 128 + m * 16; float s = 0.f;
#pragma unroll
                for (int bj = 0; bj < 2; ++bj) { const u32x4 w = bw[ai][m][bj];
                    const f32x4 v0 = (f32x4){bflo(w.x), bfhi(w.x), bflo(w.y), bfhi(w.y)} + acc[ai][bj][m][0], v1 = (f32x4){bflo(w.z), bfhi(w.z), bflo(w.w), bfhi(w.w)} + acc[ai][bj][m][1];
                    acc[ai][bj][m][0] = v0; acc[ai][bj][m][1] = v1;
                    s += ((v0[0] * v0[0] + v0[1] * v0[1]) + (v0[2] * v0[2] + v0[3] * v0[3])) + ((v1[0] * v1[0] + v1[1] * v1[1]) + (v1[2] * v1[2] + v1[3] * v1[3])); }
                s += __shfl_xor(s, 16); s += __shfl_xor(s, 32);
                if (fq == 0) atomicAdd(ssq + row, s); }
        asm volatile("s_waitcnt vmcnt(0)" ::: "memory");
        unsigned* c = cnt + 64 * u.pm;
        if (fr == 0 && fq == 0) __hip_atomic_fetch_add(c, 1u, __ATOMIC_RELAXED, __HIP_MEMORY_SCOPE_AGENT);
        { unsigned sp = 0; while ((unsigned)__builtin_amdgcn_readfirstlane(__hip_atomic_load(c, __ATOMIC_RELAXED, __HIP_MEMORY_SCOPE_AGENT)) < 32u) { __builtin_amdgcn_s_sleep(2); if (++sp > (1u << 22)) break; } }
        float sv[8];
#pragma unroll
        for (int i = 0; i < 8; ++i) sv[i] = __hip_atomic_load(ssq + row0 + (i >> 2) * 128 + (i & 3) * 16, __ATOMIC_RELAXED, __HIP_MEMORY_SCOPE_AGENT);
#pragma unroll
        for (int ai = 0; ai < 2; ++ai)
#pragma unroll
            for (int m = 0; m < 4; ++m) { const int row = row0 + ai * 128 + m * 16; const float rs = rsqrtf(sv[ai * 4 + m] * (1.0f / 1024.0f) + EPS);
#pragma unroll
                for (int bj = 0; bj < 2; ++bj)
#pragma unroll
                    for (int n = 0; n < 2; ++n) *(f32x4*)(out + (size_t)row * DM + col0 + bj * 128 + n * 4) = acc[ai][bj][m][n] * rs * gv[bj][n]; }
    }
};
struct Epi3 {
    static constexpr bool PERM = true, AFTER_DRAIN = false;
    bf16* ACT; const float* ssq;
    DI void operator()(const f32x4 (&acc)[2][2][4][2], const pg8::Unit& u, int wr, int wc, int fr, int fq) const {
        const int row0 = u.pm * 256 + wr * 64 + fr, col0 = u.pn * 128 + wc * 32 + 8 * fq;
        float sv[8];
#pragma unroll
        for (int i = 0; i < 8; ++i) sv[i] = ssq[row0 + (i >> 2) * 128 + (i & 3) * 16];
#pragma unroll
        for (int ai = 0; ai < 2; ++ai)
#pragma unroll
            for (int m = 0; m < 4; ++m) { const int row = row0 + ai * 128 + m * 16; const float rs = rsqrtf(sv[ai * 4 + m] * (1.0f / 1024.0f) + EPS);
                float o[8];
#pragma unroll
                for (int n = 0; n < 2; ++n)
#pragma unroll
                    for (int e = 0; e < 4; ++e) o[n * 4 + e] = silu_f(acc[ai][0][m][n][e] * rs) * (acc[ai][1][m][n][e] * rs);
                u32x4 w; w.x = pk2(o[0], o[1]); w.y = pk2(o[2], o[3]); w.z = pk2(o[4], o[5]); w.w = pk2(o[6], o[7]);
                *(u32x4*)(ACT + (size_t)row * DFF + col0) = w; }
    }
};

DI void p0_item(const Args& A, int it, LAS float* scr, int tid) {
    int mat, ntile, kt;
    if (it < 704) { mat = 1; ntile = it >> 4; kt = it & 15; }
    else if (it < 960) { it -= 704; mat = 2; ntile = it >> 4; kt = it & 15; }
    else if (it < 2368) { it -= 960; mat = 3; ntile = it >> 4; kt = it & 15; }
    else { it -= 2368; mat = 4; ntile = it / 44; kt = it % 44; }
    const int kl = tid >> 3, n8 = tid & 7, nd = ntile * 64 + n8 * 8, k = kt * 64 + kl;
    const float* src = nullptr; int ldw = 0, sc = 0; float scale = 1.f; bf16* dst; int K = 1024;
    if (mat == 1) { ldw = PWSRC; dst = (bf16*)(A.ws + WS_BT1);
        if (nd < 1536) { const int hh = nd / 384, c = nd % 384; sc = c < 64 ? hh * 64 + c : (c < 128 ? 256 + hh * 64 + (c - 64) : (c < 256 ? 512 + hh * 128 + (c - 128) : 1024 + hh * 128 + (c - 256))); if (c < 64) scale = 0.125f; }
        else if (nd < 2560) sc = nd + 32; else if (nd < 2592) sc = nd - 2560 + 1536; else sc = -1;
        if (sc >= 0) src = A.in[2]; }
    else if (mat == 2) { ldw = 1024; dst = (bf16*)(A.ws + WS_BT2); sc = nd; src = A.in[12]; }
    else if (mat == 3) { ldw = DFF; dst = (bf16*)(A.ws + WS_BT3); const int tl = nd >> 8, r = nd & 255; if (r < 128) { src = A.in[14]; sc = tl * 128 + r; } else { src = A.in[15]; sc = tl * 128 + r - 128; } scale = A.in[13][k]; }
    else { ldw = 1024; dst = (bf16*)(A.ws + WS_BT4); sc = nd; src = A.in[16]; K = DFF; }
    f32x4 a = (f32x4){0.f, 0.f, 0.f, 0.f}, b = a;
    if (src) { const float* p = src + (size_t)k * ldw + sc; a = *(const f32x4*)p * scale; b = *(const f32x4*)(p + 4) * scale; }
    LAS float* w = scr + kl * 65 + n8 * 8;
    w[0] = a[0]; w[1] = a[1]; w[2] = a[2]; w[3] = a[3]; w[4] = b[0]; w[5] = b[1]; w[6] = b[2]; w[7] = b[3];
    __syncthreads();
    const int nl = tid >> 3, k8 = tid & 7; float v[8];
#pragma unroll
    for (int j = 0; j < 8; ++j) v[j] = scr[(k8 * 8 + j) * 65 + nl];
    u32x4 o; o.x = pk2(v[0], v[1]); o.y = pk2(v[2], v[3]); o.z = pk2(v[4], v[5]); o.w = pk2(v[6], v[7]);
    *(u32x4*)(dst + (size_t)(ntile * 64 + nl) * K + kt * 64 + k8 * 8) = o;
    __syncthreads();
}
DI void p0_prologue(const Args& A, LAS unsigned char* lds, int tid) {
    const int G = gridDim.x, bx = blockIdx.x, lane = tid & 63, wid = tid >> 6;
    for (int i = bx * 512 + tid; i < 65536; i += G * 512) ((float*)(A.ws + WS_SSQ1))[i] = 0.f;
    for (int i = bx * 512 + tid; i < 65536; i += G * 512) { ((bf16*)(A.ws + WS_WSB))[i] = (bf16)(pk2(A.in[10][i], 0.f) & 0xffffu); }
    for (int i = bx * 512 + tid; i < 512; i += G * 512) { const float* w = A.in[10] + (size_t)i * 128; float r = 0.f;
        for (int j = 0; j < 128; j += 4) { const f32x4 v = *(const f32x4*)(w + j); r += (v[0] + v[1]) + (v[2] + v[3]); }
        ((float*)(A.ws + WS_RSW))[i] = r; }
    for (int it = bx; it < 3072; it += G) p0_item(A, it, (LAS float*)lds, tid);
    const float* x = A.in[0]; const float* g1 = A.in[1]; bf16* H = (bf16*)(A.ws + WS_H);
    f32x4 gv[4];
#pragma unroll
    for (int j = 0; j < 4; ++j) gv[j] = *(const f32x4*)(g1 + lane * 4 + 256 * j);
    for (int row = bx * 8 + wid; row < NTOK; row += G * 8) {
        const float* xr = x + (size_t)row * DM; f32x4 v[4]; float s = 0.f;
#pragma unroll
        for (int j = 0; j < 4; ++j) { v[j] = *(const f32x4*)(xr + lane * 4 + 256 * j); s += (v[j][0] * v[j][0] + v[j][1] * v[j][1]) + (v[j][2] * v[j][2] + v[j][3] * v[j][3]); }
#pragma unroll
        for (int o = 1; o < 64; o <<= 1) s += __shfl_xor(s, o);
        const float rs = rsqrtf(s * (1.0f / 1024.0f) + EPS);
        if (lane == 0) ((float*)(A.ws + WS_XSC))[row] = sqrtf(s * (1.0f / 1024.0f) + EPS);
#pragma unroll
        for (int j = 0; j < 4; ++j) { const f32x4 y = v[j] * rs * gv[j]; u32x2 w; w.x = pk2(y[0], y[1]); w.y = pk2(y[2], y[3]); *(u32x2*)(H + (size_t)row * DM + lane * 4 + 256 * j) = w; }
    }
}

constexpr int GM_VTS = 136, GM_PART = (128 * GM_VTS + 16) * 2  , GM_LN = 4 * GM_PART;
static_assert(GM_LN + 4096 <= 151552 - 16, "gMLP LDS map");
DI void gmlp_phase(const Args& A, LAS unsigned char* lds, int tid) {
    const int lane = tid & 63, wid = tid >> 6, fr = lane & 15, fq = lane >> 4;
    const bf16* PU = (const bf16*)(A.ws + WS_PU); bf16* Y = (bf16*)(A.ws + WS_Y); const bf16* WS = (const bf16*)(A.ws + WS_WSB); const float* RSW = (const float*)(A.ws + WS_RSW);
    const float* bsp = A.in[11];
    LAS float* LN = (LAS float*)(lds + GM_LN);
    for (int unit = blockIdx.x; unit < 256; unit += gridDim.x) {
        const int tok0 = unit * 128, j = tid >> 2, part = tid & 3, irow = wid * 16 + fr;
        u32x4 w[16];
        { const bf16* p = PU + (size_t)(tok0 + j) * PUS + 512 + part * 128;
#pragma unroll
          for (int i = 0; i < 16; ++i) w[i] = *(const u32x4*)(p + i * 8); }
        bf16x8 wfn[4]; u32x4 uvn[4];
#define GM_LOADG(g_) do { _Pragma("unroll") for (int ks_ = 0; ks_ < 4; ++ks_) wfn[ks_] = *(const bf16x8*)(WS + (size_t)(g_) * 16384 + irow * 128 + ks_ * 32 + fq * 8); \
        _Pragma("unroll") for (int pp_ = 0; pp_ < 4; ++pp_) uvn[pp_] = *(const u32x4*)(PU + (size_t)(tok0 + irow) * PUS + (g_) * 128 + pp_ * 32 + 8 * fq); } while (0)
        lds_barrier();
        LN[tid] = A.in[8][tid]; LN[512 + tid] = A.in[9][tid];
        float sm = 0.f, sq = 0.f;
#pragma unroll
        for (int i = 0; i < 16; ++i)
#pragma unroll
            for (int e = 0; e < 4; ++e) { const float a = bflo(w[i][e]), b = bfhi(w[i][e]); sm += a + b; sq += a * a + b * b; }
        sm += __shfl_xor(sm, 1); sm += __shfl_xor(sm, 2); sq += __shfl_xor(sq, 1); sq += __shfl_xor(sq, 2);
        const float mean = sm * (1.0f / 512.0f), rstd = rsqrtf(fmaxf(sq * (1.0f / 512.0f) - mean * mean, 0.f) + EPS);
        LAS unsigned short* vt = (LAS unsigned short*)(lds + part * GM_PART) + j;
#pragma unroll
        for (int i = 0; i < 16; ++i)
#pragma unroll
            for (int e = 0; e < 4; ++e) { const unsigned pv = pk2((bflo(w[i][e]) - mean) * rstd, (bfhi(w[i][e]) - mean) * rstd); const int c = i * 8 + e * 2;
                vt[c * GM_VTS] = (unsigned short)(pv & 0xffffu); vt[(c + 1) * GM_VTS] = (unsigned short)(pv >> 16); }
        GM_LOADG(0);
        lds_barrier();
        for (int g = 0; g < 4; ++g) {
            bf16x8 wf[4]; u32x4 uv[4];
#pragma unroll
            for (int ks = 0; ks < 4; ++ks) wf[ks] = wfn[ks];
#pragma unroll
            for (int pp = 0; pp < 4; ++pp) uv[pp] = uvn[pp];
            if (g < 3) GM_LOADG(g + 1);
            const float bias = bsp[g * 128 + irow], rsw = RSW[g * 128 + irow];
#pragma unroll
            for (int pp = 0; pp < 4; ++pp) {
                f32x4 a0 = (f32x4){0.f, 0.f, 0.f, 0.f}, a1 = a0;
#pragma unroll
                for (int ks = 0; ks < 4; ++ks) { a0 = mfma16(lds_frag(lds + g * GM_PART + ((32 * pp + 8 * (fr >> 2) + (fr & 3)) * GM_VTS + ks * 32 + fq * 8) * 2), wf[ks], a0);
                    a1 = mfma16(lds_frag(lds + g * GM_PART + ((32 * pp + 8 * (fr >> 2) + 4 + (fr & 3)) * GM_VTS + ks * 32 + fq * 8) * 2), wf[ks], a1); }
                const int c = 32 * pp + 8 * fq; const u32x4 uu = uv[pp];
                const f32x4 lg0 = *(LAS const f32x4*)(LN + g * 128 + c), lg1 = *(LAS const f32x4*)(LN + g * 128 + c + 4), lb0 = *(LAS const f32x4*)(LN + 512 + g * 128 + c), lb1 = *(LAS const f32x4*)(LN + 512 + g * 128 + c + 4);
                u32x4 o; o.x = pk2(bflo(uu.x) * (lg0[0] * a0[0] + lb0[0] * rsw + bias), bfhi(uu.x) * (lg0[1] * a0[1] + lb0[1] * rsw + bias));
                o.y = pk2(bflo(uu.y) * (lg0[2] * a0[2] + lb0[2] * rsw + bias), bfhi(uu.y) * (lg0[3] * a0[3] + lb0[3] * rsw + bias));
                o.z = pk2(bflo(uu.z) * (lg1[0] * a1[0] + lb1[0] * rsw + bias), bfhi(uu.z) * (lg1[1] * a1[1] + lb1[1] * rsw + bias));
                o.w = pk2(bflo(uu.w) * (lg1[2] * a1[2] + lb1[2] * rsw + bias), bfhi(uu.w) * (lg1[3] * a1[3] + lb1[3] * rsw + bias));
                *(u32x4*)(Y + (size_t)(tok0 + irow) * DM + 512 + g * 128 + c) = o; }
        }
#undef GM_LOADG
    }
}

constexpr int G_LR = 0, G_WD = 8192, G_BD = 16384, G_SEG = 16896, G_LA = 18944, G_A0 = 52224, RS72 = 72;
constexpr int GA_KTF = G_A0, GA_KTB = G_A0 + 9216, GA_VT = G_A0 + 18432;
constexpr int GC_QDF = G_A0, GC_QDB = G_A0 + 9216, GC_KDF = G_A0 + 18432, GC_KDB = G_A0 + 27648, GC_VT = G_A0 + 36864, GC_SS = GC_VT + 18432, GC_RS = GC_SS + 9216;
constexpr int GC_STF = 0, GC_STB = 132096;
static_assert(GC_RS + 512 <= 131072 && GC_STF + 18432 <= G_LA && GC_STB + 18432 <= 151552 - 16, "GLA LDS map");
struct DecayW { bf16x8 bh, bl; float bias; };
DI unsigned hi16(float x) { return pk2(x, 0.f) & 0xffffu; }
DI DecayW gla_decay_w(const Args& A, int h, int wid, int fr, int fq) {
    const int dir = wid >> 2, d = h * 64 + 16 * (wid & 3) + fr; const float* w = (dir ? A.in[5] : A.in[3]) + ((fq & 1) * 8) * 256 + d;
    DecayW o; unsigned hh[8], ll[8];
#pragma unroll
    for (int j = 0; j < 8; ++j) { const float x = w[j * 256]; hh[j] = hi16(x); ll[j] = (fq < 2) ? hi16(x - __uint_as_float(hh[j] << 16)) : 0u; }
    u32x4 a, b;
#pragma unroll
    for (int e = 0; e < 4; ++e) { a[e] = hh[2 * e] | (hh[2 * e + 1] << 16); b[e] = ll[2 * e] | (ll[2 * e + 1] << 16); }
    o.bh = __builtin_bit_cast(bf16x8, a); o.bl = __builtin_bit_cast(bf16x8, b); o.bias = (dir ? A.in[6] : A.in[4])[d];
    return o;
}
struct LrRows { bf16x8 v[4]; };
DI LrRows gla_load_lr(const bf16* LRg, int tok0, int wid, int fr, int fq) {
    LrRows o; const bf16* p = LRg + (size_t)(tok0 + fr) * 64 + (wid >> 2) * 32 + fq * 8;
#pragma unroll
    for (int tt = 0; tt < 4; ++tt) o.v[tt] = *(const bf16x8*)(p + tt * 1024);
    return o;
}
DI void gla_decay(LAS unsigned char* lds, const LrRows& L, const DecayW& W, int wid, int fr, int fq) {
    LAS float* LA = (LAS float*)(lds + G_LA); const int dir = wid >> 2, d = 16 * (wid & 3) + fr;
    float la[4][4], p[4][4], S[4], ex[4], tot[4];
#pragma unroll
    for (int tt = 0; tt < 4; ++tt) {
        const bf16x8 a1 = L.v[tt]; const bf16x8 a2 = (fq < 2) ? a1 : (bf16x8){0, 0, 0, 0, 0, 0, 0, 0};
        f32x4 z = (f32x4){0.f, 0.f, 0.f, 0.f};
        z = mfma16(a1, W.bh, z); z = mfma16(a2, W.bl, z);
#pragma unroll
        for (int r = 0; r < 4; ++r) la[tt][r] = logsig(z[r] + W.bias) * (1.0f / 16.0f);
        p[tt][0] = la[tt][0]; p[tt][1] = p[tt][0] + la[tt][1]; p[tt][2] = p[tt][1] + la[tt][2]; p[tt][3] = p[tt][2] + la[tt][3]; S[tt] = p[tt][3];
    }
#pragma unroll
    for (int tt = 0; tt < 4; ++tt) { const float s1 = __shfl_xor(S[tt], 16), s2 = __shfl_xor(S[tt], 32), s3 = __shfl_xor(s1, 32);
        tot[tt] = (S[tt] + s1) + (s2 + s3); ex[tt] = fq == 0 ? 0.f : (fq == 1 ? s1 : (fq == 2 ? s2 + s3 : s1 + s2 + s3)); }
    const float T = (tot[0] + tot[1]) + (tot[2] + tot[3]); float base = 0.f;
#pragma unroll
    for (int tt = 0; tt < 4; ++tt) {
#pragma unroll
        for (int r = 0; r < 4; ++r) { const float pre = base + ex[tt] + p[tt][r]; LA[(dir * 64 + 16 * tt + 4 * fq + r) * 65 + d] = dir ? (T - pre + la[tt][r]) : pre; }
        base += tot[tt]; }
    lds_barrier();
}
DI int vt_rot(int dv) { return 8 * ((dv >> 3) & 3); }
DI int kt_rot(int d) { return 4 * ((d >> 2) & 7); }
DI bf16x8 rot_frag(LAS const unsigned char* img, int row, int ks, int fq, int rot) { return *(LAS const bf16x8*)(img + row * (RS72 * 2) + (((16 * ks + 4 * fq) + rot) & 31) * 4); }
DI void gla_build_vt(const u32x4 a, const u32x4 b, LAS unsigned char* vtb, int tid) {
    const int sp = tid >> 4, dvb = tid & 15, col = (sp + vt_rot(dvb * 8)) & 31; LAS unsigned* vt = (LAS unsigned*)vtb;
#pragma unroll
    for (int e = 0; e < 4; ++e) { const int dv = dvb * 8 + 2 * e;
        vt[dv * (RS72 / 2) + col] = (a[e] & 0xffffu) | (b[e] << 16);
        vt[(dv + 1) * (RS72 / 2) + col] = (a[e] >> 16) | (b[e] & 0xffff0000u); }
}
DI size_t st_off(int dir, int b, int h, int n) { return ((size_t)((dir * 4 + b) * 4 + h) * 128 + n) * 8192; }
DI void gla_pass_a(const Args& A, LAS unsigned char* lds, int tid) {
    const int lane = tid & 63, wid = tid >> 6, fr = lane & 15, fq = lane >> 4;
    const bf16* P = (const bf16*)(A.ws + WS_P); bf16* ST = (bf16*)(A.ws + WS_ST); float* DEC = (float*)(A.ws + WS_DEC);
    LAS float* LA = (LAS float*)(lds + G_LA);
    const bf16* LRg = (const bf16*)(A.ws + WS_LR); int h_loaded = -1; DecayW dw; dw.bh = (bf16x8){0,0,0,0,0,0,0,0}; dw.bl = dw.bh; dw.bias = 0.f;
    const int sp = tid >> 4, db = tid & 15;
    LrRows lrn; u32x2 k0n, k1n; u32x4 van, vbn;
#define GA_LOAD(un) do { const int h_ = (un) & 3, tok_ = ((un) >> 2) * 64; lrn = gla_load_lr(LRg, tok_, wid, fr, fq); \
        const bf16* kp_ = P + ((size_t)h_ * NTOK + tok_ + 2 * sp) * PHS + 64 + db * 4; k0n = *(const u32x2*)kp_; k1n = *(const u32x2*)(kp_ + PHS); \
        const bf16* vp_ = P + ((size_t)h_ * NTOK + tok_ + 2 * sp) * PHS + 128 + db * 8; van = *(const u32x4*)vp_; vbn = *(const u32x4*)(vp_ + PHS); } while (0)
    if (blockIdx.x < 2048) GA_LOAD(blockIdx.x);
    for (int unit = blockIdx.x; unit < 2048; unit += gridDim.x) {
        const int h = unit & 3, cn = unit >> 2, b = cn >> 7, n = cn & 127;
        if (h != h_loaded) { dw = gla_decay_w(A, h, wid, fr, fq); h_loaded = h; }
        const LrRows lrc = lrn; const u32x2 k0 = k0n, k1 = k1n; const u32x4 va = van, vb = vbn;
        if (unit + (int)gridDim.x < 2048) GA_LOAD(unit + gridDim.x);
        gla_decay(lds, lrc, dw, wid, fr, fq);
        {
            const float kk0[4] = {bflo(k0.x), bfhi(k0.x), bflo(k0.y), bfhi(k0.y)}, kk1[4] = {bflo(k1.x), bfhi(k1.x), bflo(k1.y), bfhi(k1.y)};
#pragma unroll
            for (int dir = 0; dir < 2; ++dir) { LAS unsigned* kt = (LAS unsigned*)(lds + (dir ? GA_KTB : GA_KTF));
#pragma unroll
                for (int j = 0; j < 4; ++j) { const int d = db * 4 + j; const float be = LA[(dir * 64 + (dir ? 0 : 63)) * 65 + d];
                    const float e0 = __expf(be - LA[(dir * 64 + 2 * sp) * 65 + d]), e1 = __expf(be - LA[(dir * 64 + 2 * sp + 1) * 65 + d]);
                    kt[d * (RS72 / 2) + ((sp + kt_rot(d)) & 31)] = pk2(kk0[j] * e0, kk1[j] * e1); } }
            if (tid < 128) { const int dir = tid >> 6, d = tid & 63; DEC[((size_t)((dir * 4 + b) * 4 + h) * 128 + n) * 64 + d] = __expf(LA[(dir * 64 + (dir ? 0 : 63)) * 65 + d]); }
        }
        gla_build_vt(va, vb, lds + GA_VT, tid);
        lds_barrier();
        {
            const int dir = wid >> 2, dvt0 = (wid & 3) * 2; LAS const unsigned char* kt = lds + (dir ? GA_KTB : GA_KTF);
            bf16x8 yv[2][2];
#pragma unroll
            for (int dvi = 0; dvi < 2; ++dvi)
#pragma unroll
                for (int ks = 0; ks < 2; ++ks) yv[dvi][ks] = rot_frag(lds + GA_VT, (dvt0 + dvi) * 16 + fr, ks, fq, vt_rot((dvt0 + dvi) * 16 + fr));
            bf16* stp = ST + st_off(dir, b, h, n);
#pragma unroll
            for (int pp = 0; pp < 2; ++pp) {
                bf16x8 x[2][2];
#pragma unroll
                for (int nn = 0; nn < 2; ++nn)
#pragma unroll
                    for (int ks = 0; ks < 2; ++ks) { const int dkr = 32 * pp + 8 * (fr >> 2) + 4 * nn + (fr & 3); x[nn][ks] = rot_frag(kt, dkr, ks, fq, kt_rot(dkr)); }
#pragma unroll
                for (int dvi = 0; dvi < 2; ++dvi) { f32x4 a0 = (f32x4){0.f, 0.f, 0.f, 0.f}, a1 = a0;
                    a0 = mfma16(x[0][0], yv[dvi][0], a0); a0 = mfma16(x[0][1], yv[dvi][1], a0); a1 = mfma16(x[1][0], yv[dvi][0], a1); a1 = mfma16(x[1][1], yv[dvi][1], a1);
                    u32x4 w; w.x = pk2(a0[0], a0[1]); w.y = pk2(a0[2], a0[3]); w.z = pk2(a1[0], a1[1]); w.w = pk2(a1[2], a1[3]);
                    *(u32x4*)(stp + ((dvt0 + dvi) * 16 + fr) * 64 + 32 * pp + 8 * fq) = w; } }
        }
    }
    lds_barrier();
#undef GA_LOAD
}
DI void gla_scan(const Args& A, LAS unsigned char* lds, int tid) {
    unsigned* ST = (unsigned*)(A.ws + WS_ST); const float* DEC = (const float*)(A.ws + WS_DEC); LAS float* DL = (LAS float*)lds;
    for (int g0 = blockIdx.x * 512; g0 < 131072; g0 += gridDim.x * 512) {
        const int gt = g0 + tid, seq = g0 >> 12, e2 = gt & 4095, dir = seq >> 4, dk = (2 * e2) & 63;
        __syncthreads();
#pragma unroll
        for (int i = 0; i < 4; ++i) *(LAS f32x4*)(DL + (tid + 512 * i) * 4) = *(const f32x4*)(DEC + (size_t)seq * 8192 + (tid + 512 * i) * 4);
        __syncthreads();
        unsigned* sp = ST + (size_t)seq * 128 * 4096 + e2;
        float s0 = 0.f, s1 = 0.f;
        unsigned nx[32];
#pragma unroll
        for (int j = 0; j < 32; ++j) { const int n = dir ? 127 - j : j; nx[j] = __builtin_nontemporal_load(sp + (size_t)n * 4096); }
#pragma unroll 1
        for (int i0 = 0; i0 < 128; i0 += 32) {
            unsigned ds[32];
#pragma unroll
            for (int j = 0; j < 32; ++j) ds[j] = nx[j];
            if (i0 + 32 < 128) {
#pragma unroll
                for (int j = 0; j < 32; ++j) { const int n = dir ? 127 - (i0 + 32 + j) : i0 + 32 + j; nx[j] = __builtin_nontemporal_load(sp + (size_t)n * 4096); } }
#pragma unroll
            for (int j = 0; j < 32; ++j) { const int n = dir ? 127 - (i0 + j) : i0 + j; const float d0 = DL[n * 64 + dk], d1 = DL[n * 64 + dk + 1];
                sp[(size_t)n * 4096] = pk2(s0, s1); s0 = d0 * s0 + bflo(ds[j]); s1 = d1 * s1 + bfhi(ds[j]); }
        }
    }
}
DI void gla_pass_c(const Args& A, LAS unsigned char* lds, int tid) {
    const int lane = tid & 63, wid = tid >> 6, fr = lane & 15, fq = lane >> 4;
    const bf16* P = (const bf16*)(A.ws + WS_P); const bf16* ST = (const bf16*)(A.ws + WS_ST); bf16* Y = (bf16*)(A.ws + WS_Y);
    LAS float* LA = (LAS float*)(lds + G_LA); LAS float* RS = (LAS float*)(lds + GC_RS);
    const bf16* LRg = (const bf16*)(A.ws + WS_LR); int h_loaded = -1; DecayW dw; dw.bh = (bf16x8){0,0,0,0,0,0,0,0}; dw.bl = dw.bh; dw.bias = 0.f;
    const int t = tid >> 3, d8 = (tid & 7) * 8, vsp = tid >> 4, vdb = tid & 15, ott = wid & 3, odvh = wid >> 2, ot = ott * 16 + fr;
    LrRows lrn; u32x4 qn, kn, van, vbn, stn[4], ggn[2]; f32x4 ngv[4];
#pragma unroll
    for (int i = 0; i < 4; ++i) ngv[i] = (f32x4){0.f, 0.f, 0.f, 0.f};
#define GC_LOAD(un) do { const int h_ = (un) & 3, cn_ = (un) >> 2, tok_ = cn_ * 64; lrn = gla_load_lr(LRg, tok_, wid, fr, fq); \
        const bf16* qp_ = P + ((size_t)h_ * NTOK + tok_ + t) * PHS + d8; qn = *(const u32x4*)qp_; kn = *(const u32x4*)(qp_ + 64); \
        const bf16* vp_ = P + ((size_t)h_ * NTOK + tok_ + 2 * vsp) * PHS + 128 + vdb * 8; van = *(const u32x4*)vp_; vbn = *(const u32x4*)(vp_ + PHS); \
        _Pragma("unroll") for (int i_ = 0; i_ < 4; ++i_) { const int ci_ = tid + 512 * i_; stn[i_] = *(const u32x4*)(ST + st_off(ci_ >> 10, cn_ >> 7, h_, cn_ & 127) + (ci_ & 1023) * 8); } \
        _Pragma("unroll") for (int pp_ = 0; pp_ < 2; ++pp_) ggn[pp_] = *(const u32x4*)(P + ((size_t)h_ * NTOK + tok_ + ot) * PHS + 256 + odvh * 64 + 32 * pp_ + 8 * fq); } while (0)
    if (blockIdx.x < 2048) GC_LOAD(blockIdx.x);
    for (int unit = blockIdx.x; unit < 2048; unit += gridDim.x) {
        const int h = unit & 3, cn = unit >> 2, tok0 = cn * 64;
        if (h != h_loaded) { dw = gla_decay_w(A, h, wid, fr, fq); h_loaded = h;
#pragma unroll
            for (int dvi = 0; dvi < 4; ++dvi) ngv[dvi] = *(const f32x4*)(A.in[7] + h * 128 + odvh * 64 + 32 * (dvi >> 1) + 8 * fq + 4 * (dvi & 1)); }
        const LrRows lrc = lrn; const u32x4 q = qn, k = kn, va = van, vb = vbn; u32x4 stc[4]; const u32x4 gg[2] = {ggn[0], ggn[1]};
#pragma unroll
        for (int i = 0; i < 4; ++i) stc[i] = stn[i];
        if (unit + (int)gridDim.x < 2048) GC_LOAD(unit + gridDim.x);
        DUP(13) gla_decay(lds, lrc, dw, wid, fr, fq);
        DUP(10) {
#pragma unroll
            for (int dir = 0; dir < 2; ++dir) { u32x4 qo, ko;
#pragma unroll
                for (int e = 0; e < 4; ++e) { const float b0 = LA[(dir * 64 + t) * 65 + d8 + 2 * e], b1 = LA[(dir * 64 + t) * 65 + d8 + 2 * e + 1];
                    qo[e] = pk2(bflo(q[e]) * __expf(b0), bfhi(q[e]) * __expf(b1)); ko[e] = pk2(bflo(k[e]) * __expf(-b0), bfhi(k[e]) * __expf(-b1)); }
                *(LAS u32x4*)(lds + (dir ? GC_QDB : GC_QDF) + (t * RS72 + d8) * 2) = qo; *(LAS u32x4*)(lds + (dir ? GC_KDB : GC_KDF) + (t * RS72 + d8) * 2) = ko; }
        }
        gla_build_vt(va, vb, lds + GC_VT, tid);
#pragma unroll
        for (int i = 0; i < 4; ++i) { const int ci = tid + 512 * i, cc = ci & 1023; *(LAS u32x4*)(lds + ((ci >> 10) ? GC_STB : GC_STF) + ((cc >> 3) * RS72 + (cc & 7) * 8) * 2) = stc[i]; }
        lds_barrier();
        DUP(11) {
#pragma unroll
            for (int ti = 0; ti < 2; ++ti) { const int tile = wid * 2 + ti, tt = tile >> 2, st = tile & 3;
                f32x4 af = (f32x4){0.f, 0.f, 0.f, 0.f}, ab = af;
                if (st <= tt) {
#pragma unroll
                    for (int ks = 0; ks < 2; ++ks) af = mfma16(lds_frag(lds + GC_KDF + ((st * 16 + fr) * RS72 + ks * 32 + fq * 8) * 2), lds_frag(lds + GC_QDF + ((tt * 16 + fr) * RS72 + ks * 32 + fq * 8) * 2), af); }
                if (st >= tt) {
#pragma unroll
                    for (int ks = 0; ks < 2; ++ks) ab = mfma16(lds_frag(lds + GC_KDB + ((st * 16 + fr) * RS72 + ks * 32 + fq * 8) * 2), lds_frag(lds + GC_QDB + ((tt * 16 + fr) * RS72 + ks * 32 + fq * 8) * 2), ab); }
                const int t = tt * 16 + fr, s0 = st * 16 + 4 * fq; float v[4];
#pragma unroll
                for (int r = 0; r < 4; ++r) v[r] = ((s0 + r) <= t ? af[r] : 0.f) + ((s0 + r) >= t ? ab[r] : 0.f);
                u32x2 w; w.x = pk2(v[0], v[1]); w.y = pk2(v[2], v[3]);
                *(LAS u32x2*)(lds + GC_SS + (t * RS72 + s0) * 2) = w; }
        }
        lds_barrier();
        DUP(12) {
            const int tt = wid & 3, dvh = wid >> 2, t = tt * 16 + fr;
            bf16x8 yv[6];
#pragma unroll
            for (int ks = 0; ks < 2; ++ks) { yv[ks] = lds_frag(lds + GC_SS + (t * RS72 + ks * 32 + fq * 8) * 2); yv[2 + ks] = lds_frag(lds + GC_QDF + (t * RS72 + ks * 32 + fq * 8) * 2); yv[4 + ks] = lds_frag(lds + GC_QDB + (t * RS72 + ks * 32 + fq * 8) * 2); }
            f32x4 acc[4]; float q = 0.f;
#pragma unroll
            for (int dvi = 0; dvi < 4; ++dvi) { const int dvr = dvh * 64 + 32 * (dvi >> 1) + 8 * (fr >> 2) + 4 * (dvi & 1) + (fr & 3); f32x4 a = (f32x4){0.f, 0.f, 0.f, 0.f};
#pragma unroll
                for (int ks = 0; ks < 2; ++ks) { a = mfma16(rot_frag(lds + GC_VT, dvr, ks, fq, vt_rot(dvr)), yv[ks], a);
                    a = mfma16(lds_frag(lds + GC_STF + (dvr * RS72 + ks * 32 + fq * 8) * 2), yv[2 + ks], a); a = mfma16(lds_frag(lds + GC_STB + (dvr * RS72 + ks * 32 + fq * 8) * 2), yv[4 + ks], a); }
                acc[dvi] = a; q += (a[0] * a[0] + a[1] * a[1]) + (a[2] * a[2] + a[3] * a[3]); }
            q += __shfl_xor(q, 16); q += __shfl_xor(q, 32);
            if (fq == 0) RS[dvh * 64 + t] = q;
            lds_barrier();
            const float rn = rsqrtf((RS[t] + RS[64 + t]) * (1.0f / 128.0f) + EPS);
#pragma unroll
            for (int pp = 0; pp < 2; ++pp) { const int col = h * 128 + dvh * 64 + 32 * pp + 8 * fq; const u32x4 g4 = gg[pp];
                const f32x4 n0 = ngv[2 * pp], n1 = ngv[2 * pp + 1], a0 = acc[2 * pp], a1 = acc[2 * pp + 1];
                u32x4 w; w.x = pk2(a0[0] * rn * n0[0] * silu_f(bflo(g4.x)), a0[1] * rn * n0[1] * silu_f(bfhi(g4.x))); w.y = pk2(a0[2] * rn * n0[2] * silu_f(bflo(g4.y)), a0[3] * rn * n0[3] * silu_f(bfhi(g4.y)));
                w.z = pk2(a1[0] * rn * n1[0] * silu_f(bflo(g4.z)), a1[1] * rn * n1[1] * silu_f(bfhi(g4.z))); w.w = pk2(a1[2] * rn * n1[2] * silu_f(bflo(g4.w)), a1[3] * rn * n1[3] * silu_f(bfhi(g4.w)));
                *(u32x4*)(Y + (size_t)(tok0 + t) * DM + col) = w; }
        }
    }
    lds_barrier();
#undef GC_LOAD
}
DI void final_norm(const Args& A, int tid, float* dst) {
    const int lane = tid & 63, wid = tid >> 6; const float* ssq = (const float*)(A.ws + WS_SSQ2); const float* gf = A.in[17];
    f32x4 gv[4];
#pragma unroll
    for (int j = 0; j < 4; ++j) gv[j] = *(const f32x4*)(gf + lane * 4 + 256 * j);
    for (int row = blockIdx.x * 8 + wid; row < NTOK; row += gridDim.x * 8) { float* xr = A.out + (size_t)row * DM; float* dr = dst + (size_t)row * DM; const float rs = rsqrtf(ssq[row] * (1.0f / 1024.0f) + EPS);
#pragma unroll
        for (int j = 0; j < 4; ++j) { const int o = lane * 4 + 256 * j; *(f32x4*)(dr + o) = *(const f32x4*)(xr + o) * rs * gv[j]; } }
}

__global__ void __launch_bounds__(512, 2) fwd_kernel(Args args) {
    extern __shared__ __attribute__((aligned(16))) unsigned char lds_raw[];
    LAS unsigned char* lds = (LAS unsigned char*)lds_raw;
    const int tid = threadIdx.x, lo = args.ph_lo, hi = args.ph_hi;
#define IN(k) (lo <= (k) && (k) < hi)
    volatile LAS unsigned* xst = (volatile LAS unsigned*)(lds + LDS_BYTES - 16);
    if (tid < 2) xst[tid] = 0u;
    __syncthreads();
    const XcdBarrier xbar = xcd_barrier_post((unsigned*)(args.ws + WS_BAR), xst);
    if (hi > NPH) cg::this_grid().sync();
#define SEAM(k) do { if (IN(k) && IN((k) + 1)) xcd_barrier(xbar); } while (0)
    if (IN(0)) { DUP(0) p0_prologue(args, lds, tid); } SEAM(0);
    if (IN(1)) { pg8::Gemm g{(const bf16*)(args.ws + WS_H), (const bf16*)(args.ws + WS_BT1), NTOK, N1, DM}; OrderG1 S; S.init(gridDim.x, blockIdx.x);
        Epi1 E{(bf16*)(args.ws + WS_P), (bf16*)(args.ws + WS_PU), (bf16*)(args.ws + WS_LR)};
        pg8::gemm_phase<Epi1, OrderG1, true, true, 10>(lds, g, S, E); } SEAM(1);
    if (IN(2)) { DUP(2) { gmlp_phase(args, lds, tid); __syncthreads(); } DUP(3) { gla_pass_a(args, lds, tid); } } SEAM(2);
    if (IN(3)) { gla_scan(args, lds, tid); if ((PROBE_DUP >> 9) & 1) { xcd_barrier(xbar); gla_pass_a(args, lds, tid); xcd_barrier(xbar); gla_scan(args, lds, tid); } } SEAM(3);
    if (IN(4)) { DUP(4) gla_pass_c(args, lds, tid); } SEAM(4);
    if (IN(5)) { pg8::Gemm g{(const bf16*)(args.ws + WS_Y), (const bf16*)(args.ws + WS_BT2), NTOK, DM, DM}; pg8::StaticOrder S; S.init(NTOK, DM, gridDim.x, blockIdx.x);
        EpiRes<0> E{(const float*)(args.ws + WS_XSC), (const bf16*)(args.ws + WS_H), args.in[1], (bf16*)(args.ws + WS_ST), (float*)(args.ws + WS_SSQ1)}; pg8::gemm_phase<EpiRes<0>, pg8::StaticOrder, true, true>(lds, g, S, E); } SEAM(5);
    if (IN(6)) { pg8::Gemm g{(const bf16*)(args.ws + WS_ST), (const bf16*)(args.ws + WS_BT3), NTOK, N3, DM}; pg8::StaticOrder S; S.init(NTOK, N3, gridDim.x, blockIdx.x);
        Epi3 E{(bf16*)(args.ws + WS_P), (const float*)(args.ws + WS_SSQ1)}; DUP(6) pg8::gemm_phase<Epi3, pg8::StaticOrder, true, true>(lds, g, S, E); } SEAM(6);
    if (IN(7)) { pg8::Gemm g{(const bf16*)(args.ws + WS_P), (const bf16*)(args.ws + WS_BT4), NTOK, DM, DFF}; pg8::StaticOrder S; S.init(NTOK, DM, gridDim.x, blockIdx.x);
        if (gridDim.x == 256) {
            EpiFinal E{(const bf16*)(args.ws + WS_ST), args.out, (float*)(args.ws + WS_SSQ2), (unsigned*)(args.ws + WS_CNT), args.in[17]}; pg8::gemm_phase<EpiFinal, pg8::StaticOrder, true, true>(lds, g, S, E); }
        else { EpiRes<1> E{nullptr, (const bf16*)(args.ws + WS_ST), (const float*)args.out, nullptr, (float*)(args.ws + WS_SSQ2)}; pg8::gemm_phase<EpiRes<1>, pg8::StaticOrder, true, true>(lds, g, S, E); } }
    if (gridDim.x != 256) SEAM(7);
    if (IN(8) && gridDim.x != 256) { final_norm(args, tid, args.out); }
#undef IN
#undef SEAM
}

extern "C" void kernel_launch(void* const* d_in, const int* in_sizes, int n_in, void* d_out, int out_size, void* d_ws, size_t ws_size, hipStream_t stream) {
    static int grid = 0;
    if (grid == 0) {
        if (n_in != 18 || out_size != NTOK * DM || ws_size < WS_END) { fprintf(stderr, "kernel_launch: unexpected shapes (n_in %d out %d ws %zu)\n", n_in, out_size, ws_size); grid = -1; return; }
        int dev = 0, cus = 0, per_cu = 0;
        hipGetDevice(&dev); hipDeviceGetAttribute(&cus, hipDeviceAttributeMultiprocessorCount, dev);
        if (hipFuncSetAttribute((const void*)fwd_kernel, hipFuncAttributeMaxDynamicSharedMemorySize, LDS_BYTES) != hipSuccess) { fprintf(stderr, "kernel_launch: hipFuncSetAttribute failed\n"); grid = -1; return; }
        if (hipOccupancyMaxActiveBlocksPerMultiprocessor(&per_cu, (const void*)fwd_kernel, 512, LDS_BYTES) != hipSuccess || per_cu < 1) { fprintf(stderr, "kernel_launch: occupancy query says %d\n", per_cu); per_cu = 1; }
        (void)hipGetLastError();
        grid = cus * 1;
        fprintf(stderr, "kernel_launch: grid %d (cus %d, per_cu %d)\n", grid, cus, per_cu);
    }
    if (grid < 0) return;
    Args a{};
    for (int i = 0; i < 18; ++i) a.in[i] = (const float*)d_in[i];
    a.out = (float*)d_out; a.ws = (unsigned char*)d_ws;
    if (hipMemsetAsync((char*)d_ws + WS_BAR, 0, WS_BAR_BYTES, stream) != hipSuccess) { fprintf(stderr, "kernel_launch: memset failed\n"); return; }
#if MK_N_LAUNCHES == 1
    a.ph_lo = 0; a.ph_hi = NPH;
    void* kargs[] = {&a};
    hipError_t e = hipLaunchCooperativeKernel((const void*)fwd_kernel, dim3(grid), dim3(512), kargs, LDS_BYTES, stream);
    if (e != hipSuccess) fprintf(stderr, "kernel_launch: cooperative launch failed: %s (grid %d)\n", hipGetErrorString(e), grid);
#else
    for (int ph = 0; ph < 9; ++ph) { a.ph_lo = ph; a.ph_hi = ph + 1; hipLaunchKernelGGL(fwd_kernel, dim3(grid), dim3(512), LDS_BYTES, stream, a); }
#endif
}
```

```cpp
#include <hip/hip_runtime.h>
#include <hip/hip_cooperative_groups.h>
#include <cstdio>
#include <cstdint>
namespace pg8 {
#define PG8_LAS __attribute__((address_space(3)))
typedef unsigned short bf16_t;
typedef short bf16x8 __attribute__((ext_vector_type(8)));
typedef float f32x4 __attribute__((ext_vector_type(4)));
typedef unsigned u32x4 __attribute__((ext_vector_type(4)));
constexpr int BM = 256, BK = 64, HALF = 128, HTB = HALF * BK * 2  , STAGE_BYTES = 8 * HTB, NXCD = 8, WGM = 8;

__host__ __device__ __forceinline__ int lds_byte(int r, int c) { const int st = (r >> 4) * 2 + (c >> 5), rr = r & 15, cc = c & 31, ob = rr * 64 + cc * 2; return st * 1024 + (ob ^ (((ob >> 9) & 1) << 5)); }
__host__ __device__ __forceinline__ void stage_rc(int b, int& R, int& C) { const int st = b / 1024, sb = b % 1024, swz = sb ^ (((sb >> 9) & 1) << 5); R = (st >> 1) * 16 + swz / 64; C = (st & 1) * 32 + (swz % 64) / 2; }
__host__ __device__ __forceinline__ int perm32(int rho) { const int n = rho >> 4, i = rho & 15; return 8 * (i >> 2) + 4 * n + (i & 3); }

struct Unit { int pm, pn; };
struct Gemm { const bf16_t* A; const bf16_t* Bt; int M, N, K; };

struct StaticOrder {
    int nM, nN, nwg, G, c, wgm;
    __host__ __device__ void init(int M, int N, int G_, int c_, int wgm_ = WGM) { nM = M / BM; nN = N / BM; nwg = nM * nN; G = G_; c = c_; wgm = wgm_; }
    __host__ __device__ bool next(int i, Unit& u) const {
        const long L = (long)i * G + c; if (L >= nwg) return false;
        int wgid = (int)L; { const int q = nwg / NXCD, r = nwg % NXCD, xcd = wgid % NXCD, off = wgid / NXCD; wgid = (xcd < r ? xcd * (q + 1) : r * (q + 1) + (xcd - r) * q) + off; }
        const int nig = wgm * nN, gid = wgid / nig, fm = gid * wgm, gsz = (nM - fm) < wgm ? (nM - fm) : wgm;
        u.pm = fm + ((wgid % nig) % gsz); u.pn = (wgid % nig) / gsz; return true;
    }
    __device__ __forceinline__ void a_ready(const Unit&) const {}
    __device__ __forceinline__ void done(const Unit&) const {}
};
__device__ __forceinline__ unsigned cvt_pk_bf16(float lo, float hi) { unsigned r; asm volatile("v_cvt_pk_bf16_f32 %0, %1, %2" : "=v"(r) : "v"(lo), "v"(hi)); return r; }
typedef float f32x2 __attribute__((ext_vector_type(2)));
__device__ __forceinline__ f32x2 gelu_pk(f32x2 v) {
    const f32x2 av = __builtin_elementwise_abs(v), d = av * 0.2316418882f + 1.0f;
    f32x2 t; t.x = __builtin_amdgcn_rcpf(d.x); t.y = __builtin_amdgcn_rcpf(d.y);
    f32x2 q = t * 0.5307027145f + (-0.7265760135f); q = q * t + 0.7107068705f; q = q * t + (-0.142248368f); q = q * t + 0.127414796f; q = q * t;
    const f32x2 s = (v * v) * (-0.72134752044f);
    f32x2 e; e.x = __builtin_amdgcn_exp2f(s.x); e.y = __builtin_amdgcn_exp2f(s.y);
    const f32x2 m = v * (q * e), r = v - m;
    f32x2 o; o.x = v.x < 0.f ? m.x : r.x; o.y = v.y < 0.f ? m.y : r.y; return o;
}
template <class Epi, class Sched, bool ALIGN_EPI = false, bool SP2 = false, int NARROW_PN = -1  >
__device__ __forceinline__ void gemm_phase(PG8_LAS unsigned char* lds, const Gemm g, const Sched& S, const Epi& E) {
    const int tid = threadIdx.x, wid = __builtin_amdgcn_readfirstlane(tid >> 6), lane = tid & 63, wr = wid >> 2, wc = wid & 3, fr = lane & 15, fq = lane >> 4;
    const int K = g.K, nt = K / BK;
    unsigned voffA[2], voffB[2];
#pragma unroll
    for (int i = 0; i < 2; ++i) { int R, C; stage_rc(tid * 16 + i * 8192, R, C); const int Rb = Epi::PERM ? ((R & ~31) + perm32(R & 31)) : R;
        voffA[i] = (unsigned)(R * K + C) * 2u; voffB[i] = (unsigned)(Rb * K + C) * 2u; }
    const size_t kstep = (size_t)(BK * 2);
    const size_t hstep = (size_t)HALF * K * 2;
    const size_t tstep = 2 * hstep;
    const unsigned ldsw = (unsigned)wid * 1024u;
    const int aoff = lds_byte(wr * 64 + fr, fq * 8), boff = lds_byte(wc * 32 + fr, fq * 8);
#define PG8_SA(b, h) (((b) * 2 + (h)) * HTB)
#define PG8_SB(b, h) ((4 + (b) * 2 + (h)) * HTB)
#define PG8_STAGE(bufoff, gbase, voff) do { _Pragma("unroll") for (int _i = 0; _i < 2; ++_i) \
        __builtin_amdgcn_global_load_lds((const unsigned*)((const char*)(gbase) + (voff)[_i]), (PG8_LAS unsigned*)(lds + (bufoff) + ldsw + _i * 8192), 16, 0, 0); } while (0)
#define PG8_LDA(dst, b, h) do { _Pragma("unroll") for (int m = 0; m < 4; ++m) _Pragma("unroll") for (int k = 0; k < 2; ++k) dst[m][k] = *(const PG8_LAS bf16x8*)(lds + PG8_SA(b, h) + aoff + m * 2048 + k * 1024); } while (0)
#define PG8_LDB(dst, b, h) do { _Pragma("unroll") for (int n = 0; n < 2; ++n) _Pragma("unroll") for (int k = 0; k < 2; ++k) dst[n][k] = *(const PG8_LAS bf16x8*)(lds + PG8_SB(b, h) + boff + n * 2048 + k * 1024); } while (0)
#define PG8_MMA(ai, bj, At, Bt) do { __builtin_amdgcn_s_setprio(1); _Pragma("unroll") for (int m = 0; m < 4; ++m) _Pragma("unroll") for (int n = 0; n < 2; ++n) _Pragma("unroll") for (int k = 0; k < 2; ++k) \
        acc[ai][bj][m][n] = __builtin_amdgcn_mfma_f32_16x16x32_bf16(Bt[n][k], At[m][k], acc[ai][bj][m][n], 0, 0, 0); __builtin_amdgcn_s_setprio(0); } while (0)
#define PG8_WAIT_V(n) asm volatile("s_waitcnt vmcnt(" #n ")" ::: "memory")
#define PG8_WAIT_L(n) asm volatile("s_waitcnt lgkmcnt(" #n ")" ::: "memory")
#define PG8_BAR __builtin_amdgcn_s_barrier()
#define PG8_SCHED __builtin_amdgcn_sched_barrier(0)
    Unit cur, nxt; int ui = 0;
    if (!S.next(0, cur)) return;
    f32x4 acc[2][2][4][2];
#pragma unroll
    for (int a = 0; a < 2; ++a)
#pragma unroll
        for (int b = 0; b < 2; ++b)
#pragma unroll
            for (int m = 0; m < 4; ++m)
#pragma unroll
                for (int n = 0; n < 2; ++n) acc[a][b][m][n] = (f32x4){0.f, 0.f, 0.f, 0.f};
    bf16x8 At[4][2], B0[2][2], B1[2][2];
    const char* cA = (const char*)g.A + (size_t)cur.pm * tstep; const char* cB = (const char*)g.Bt + (size_t)cur.pn * tstep;
    S.a_ready(cur);
    if constexpr (SP2) {
        PG8_STAGE(PG8_SB(0, 0), cB, voffB); PG8_STAGE(PG8_SB(0, 1), cB + hstep, voffB); PG8_STAGE(PG8_SA(0, 0), cA, voffA); PG8_STAGE(PG8_SA(0, 1), cA + hstep, voffA);
        if (wr == 1) PG8_BAR;
        PG8_WAIT_V(2); PG8_BAR;
        PG8_STAGE(PG8_SB(1, 0), cB + kstep, voffB); PG8_STAGE(PG8_SA(1, 0), cA + kstep, voffA); PG8_STAGE(PG8_SB(1, 1), cB + hstep + kstep, voffB);
        PG8_WAIT_V(6); PG8_BAR;
    } else {
        PG8_STAGE(PG8_SB(0, 0), cB, voffB); PG8_STAGE(PG8_SA(0, 0), cA, voffA); PG8_STAGE(PG8_SB(0, 1), cB + hstep, voffB); PG8_STAGE(PG8_SA(0, 1), cA + hstep, voffA);
        if (wr == 1) PG8_BAR;
        PG8_WAIT_V(4); PG8_BAR;
        PG8_STAGE(PG8_SB(1, 0), cB + kstep, voffB); PG8_STAGE(PG8_SA(1, 0), cA + kstep, voffA); PG8_STAGE(PG8_SB(1, 1), cB + hstep + kstep, voffB);
        PG8_WAIT_V(6); PG8_BAR;
    }
    for (;;) {
        const bool has_next = S.next(ui + 1, nxt); const bool narrow = (NARROW_PN >= 0) && (cur.pn == NARROW_PN);
        const char* nA = has_next ? (const char*)g.A + (size_t)nxt.pm * tstep : cA; const char* nB = has_next ? (const char*)g.Bt + (size_t)nxt.pn * tstep : cB;
        for (int t = 0; t < nt; t += 2) {
            const bool last = (t == nt - 2);
            const char* a1 = cA + (size_t)(t + 1) * kstep;
            const char* a2 = last ? nA : cA + (size_t)(t + 2) * kstep; const char* b2 = last ? nB : cB + (size_t)(t + 2) * kstep;
            const char* a3 = a2 + kstep; const char* b3 = b2 + kstep;
            if (last && has_next) S.a_ready(nxt);
            if constexpr (SP2) {
            PG8_LDB(B0, 0, 0); PG8_LDB(B1, 0, 1); PG8_SCHED; PG8_LDA(At, 0, 0); PG8_STAGE(PG8_SA(1, 1), a1 + hstep, voffA);
            PG8_WAIT_V(8); PG8_WAIT_L(0); PG8_BAR; PG8_MMA(0, 0, At, B0); if (NARROW_PN < 0 || !narrow) PG8_MMA(0, 1, At, B1); PG8_BAR; PG8_SCHED;
            PG8_LDA(At, 0, 1); PG8_STAGE(PG8_SB(0, 0), b2, voffB); PG8_STAGE(PG8_SB(0, 1), b2 + hstep, voffB); PG8_STAGE(PG8_SA(0, 0), a2, voffA);
            PG8_WAIT_V(8); PG8_WAIT_L(0); PG8_BAR; PG8_MMA(1, 0, At, B0); if (NARROW_PN < 0 || !narrow) PG8_MMA(1, 1, At, B1); PG8_BAR; PG8_SCHED;
            PG8_LDB(B0, 1, 0); PG8_LDB(B1, 1, 1); PG8_SCHED; PG8_LDA(At, 1, 0); PG8_STAGE(PG8_SA(0, 1), a2 + hstep, voffA);
            PG8_WAIT_V(8); PG8_WAIT_L(0); PG8_BAR; PG8_MMA(0, 0, At, B0); if (NARROW_PN < 0 || !narrow) PG8_MMA(0, 1, At, B1); PG8_BAR; PG8_SCHED;
            PG8_LDA(At, 1, 1); PG8_STAGE(PG8_SB(1, 0), b3, voffB); PG8_STAGE(PG8_SB(1, 1), b3 + hstep, voffB); PG8_STAGE(PG8_SA(1, 0), a3, voffA);
            PG8_WAIT_V(8); PG8_WAIT_L(0); PG8_BAR; PG8_MMA(1, 0, At, B0); if (NARROW_PN < 0 || !narrow) PG8_MMA(1, 1, At, B1); PG8_BAR; PG8_SCHED;
            } else {
            PG8_LDB(B0, 0, 0); PG8_SCHED; PG8_LDA(At, 0, 0); PG8_STAGE(PG8_SA(1, 1), a1 + hstep, voffA);
            PG8_WAIT_L(8); PG8_BAR; PG8_WAIT_L(0); PG8_MMA(0, 0, At, B0); PG8_BAR; PG8_SCHED;
            PG8_LDB(B1, 0, 1); PG8_STAGE(PG8_SB(0, 0), b2, voffB);
            PG8_BAR; PG8_WAIT_L(0); PG8_MMA(0, 1, At, B1); PG8_BAR;
            PG8_LDA(At, 0, 1); PG8_STAGE(PG8_SA(0, 0), a2, voffA);
            PG8_BAR; PG8_WAIT_L(0); PG8_MMA(1, 0, At, B0); PG8_BAR; PG8_SCHED;
            PG8_STAGE(PG8_SB(0, 1), b2 + hstep, voffB);
            PG8_WAIT_V(6); PG8_BAR; PG8_MMA(1, 1, At, B1); PG8_BAR;
            PG8_LDB(B0, 1, 0); PG8_SCHED; PG8_LDA(At, 1, 0); PG8_STAGE(PG8_SA(0, 1), a2 + hstep, voffA);
            PG8_WAIT_L(8); PG8_BAR; PG8_WAIT_L(0); PG8_MMA(0, 0, At, B0); PG8_BAR; PG8_SCHED;
            PG8_LDB(B1, 1, 1); PG8_STAGE(PG8_SB(1, 0), b3, voffB);
            PG8_BAR; PG8_WAIT_L(0); PG8_MMA(0, 1, At, B1); PG8_BAR;
            PG8_LDA(At, 1, 1); PG8_STAGE(PG8_SA(1, 0), a3, voffA);
            PG8_BAR; PG8_WAIT_L(0); PG8_MMA(1, 0, At, B0); PG8_BAR; PG8_SCHED;
            PG8_STAGE(PG8_SB(1, 1), b3 + hstep, voffB);
            PG8_WAIT_V(6); PG8_BAR; PG8_MMA(1, 1, At, B1); PG8_BAR;
            }
        }
        if constexpr (ALIGN_EPI) { if (wr == 0) PG8_BAR; }
        if constexpr (!Epi::AFTER_DRAIN) { E(acc, cur, wr, wc, fr, fq); S.done(cur); }
        if (!has_next) break;
#pragma unroll
        for (int a = 0; a < 2; ++a)
#pragma unroll
            for (int b = 0; b < 2; ++b)
#pragma unroll
                for (int m = 0; m < 4; ++m)
#pragma unroll
                    for (int n = 0; n < 2; ++n) acc[a][b][m][n] = (f32x4){0.f, 0.f, 0.f, 0.f};
        cur = nxt; cA = nA; cB = nB; ++ui;
        if constexpr (ALIGN_EPI) { if (wr == 1) PG8_BAR; }
    }
    PG8_WAIT_V(0);
    if constexpr (!ALIGN_EPI) { if (wr == 0) PG8_BAR; }
    PG8_BAR;
    if constexpr (Epi::AFTER_DRAIN) { E.fused(acc, cur, wr, wc, fr, fq, lds, wid, lane); S.done(cur); }
#undef PG8_SA
#undef PG8_SB
#undef PG8_STAGE
#undef PG8_LDA
#undef PG8_LDB
#undef PG8_MMA
#undef PG8_WAIT_V
#undef PG8_WAIT_L
#undef PG8_BAR
#undef PG8_SCHED
}
}

namespace cg = cooperative_groups;
#define LAS __attribute__((address_space(3)))
#define DI __device__ __forceinline__
typedef unsigned short bf16;
typedef short bf16x8 __attribute__((ext_vector_type(8)));
typedef float f32x4 __attribute__((ext_vector_type(4)));
typedef unsigned u32x4 __attribute__((ext_vector_type(4)));
typedef unsigned u32x2 __attribute__((ext_vector_type(2)));

#ifndef MK_N_LAUNCHES
#define MK_N_LAUNCHES 1
#endif
#define PROBE_DUP 0
#define DUP(bit) for (int rep_ = 0; rep_ < (((PROBE_DUP) >> (bit)) & 1) + 1; ++rep_)
constexpr int NPH = 10;
constexpr int NTOK = 32768, DM = 1024, PWSRC = 2592, N1 = 2816, PHS = 384, PUS = 1024, DFF = 2816, N3 = 5632;
constexpr float EPS = 1e-6f;
constexpr size_t MiB = 1u << 20;
constexpr size_t WS_SSQ1 = 0, WS_SSQ2 = 128 * 1024, WS_XSC = 256 * 1024, WS_WSB = 1 * MiB, WS_RSW = 1 * MiB + 256 * 1024, WS_BT1 = 2 * MiB, WS_BT2 = 8 * MiB, WS_BT3 = 10 * MiB, WS_BT4 = 21 * MiB,
                 WS_DEC = 27 * MiB, WS_LR = 28 * MiB, WS_H = 32 * MiB  , WS_ST = 96 * MiB  ,
                 WS_P = 160 * MiB  , WS_Y = 336 * MiB  , WS_END = 400 * MiB;
constexpr size_t WS_BAR = 512 * 1024, WS_CNT = WS_BAR + 16384, WS_BAR_BYTES = 16384 + 32768;
constexpr size_t WS_PU = WS_P + (size_t)4 * NTOK * PHS * 2;
constexpr int LDS_BYTES = 151552;

typedef float f32x2_t __attribute__((ext_vector_type(2))); typedef __bf16 bf16x2_t __attribute__((ext_vector_type(2)));
DI unsigned pk2(float lo, float hi) { f32x2_t v = {lo, hi}; bf16x2_t b = __builtin_convertvector(v, bf16x2_t); return __builtin_bit_cast(unsigned, b); }
DI float bflo(unsigned u) { return __uint_as_float(u << 16); }
DI float bfhi(unsigned u) { return __uint_as_float(u & 0xffff0000u); }
DI float silu_f(float g) { return g * __builtin_amdgcn_rcpf(1.0f + __expf(-g)); }
DI float logsig(float z) { return fminf(z, 0.f) - __logf(1.0f + __expf(-fabsf(z))); }
DI void lds_barrier() { asm volatile("s_waitcnt lgkmcnt(0)" ::: "memory"); __builtin_amdgcn_s_barrier(); asm volatile("" ::: "memory"); }
DI bf16x8 lds_frag(LAS const unsigned char* p) { return *(LAS const bf16x8*)p; }
DI f32x4 mfma16(bf16x8 a, bf16x8 b, f32x4 c) { return __builtin_amdgcn_mfma_f32_16x16x32_bf16(a, b, c, 0, 0, 0); }

#define XB_TMO      128
#define XB_XCNT(j)  (256  + 64 * (j))
#define XB_XSUB(j)  (1280 + 64 * (j))
#define XB_XGEN(j)  (2304 + 64 * (j))
#define XB_TOP      3328
#define XB_TOPGEN   3392
#define XCD_BAR_WORDS 3456
#define XB_SPIN_CAP (1u << 18)

__device__ __forceinline__ unsigned xb_ld(unsigned* p)              { return __hip_atomic_load(p, __ATOMIC_RELAXED, __HIP_MEMORY_SCOPE_AGENT); }
__device__ __forceinline__ unsigned xb_add(unsigned* p, unsigned v) { return __hip_atomic_fetch_add(p, v, __ATOMIC_RELAXED, __HIP_MEMORY_SCOPE_AGENT); }
__device__ __forceinline__ unsigned xb_xcc_id() { return (unsigned)__builtin_amdgcn_s_getreg((3 << 11) | 20) & 0xFu; }
#define XB_SPIN(cond, bar) do { unsigned _sp = 0; while (cond) { __builtin_amdgcn_s_sleep(1); \
    if ((++_sp & 255u) == 0u) { if (xb_ld(&(bar)[XB_TMO])) break; if (_sp > XB_SPIN_CAP) { atomicAdd(&(bar)[XB_TMO], 1u); break; } } } } while (0)

struct XcdBarrier {
    unsigned* bar; unsigned x;
    volatile LAS unsigned* st;
};

__device__ __forceinline__ XcdBarrier xcd_barrier_post(unsigned* bar, volatile LAS unsigned* st) {
    XcdBarrier b; b.bar = bar; b.x = xb_xcc_id(); b.st = st;
    if (threadIdx.x == 0) (void)xb_add(&bar[XB_XCNT(b.x)], 1u);
    return b;
}
__device__ __forceinline__ void xcd_barrier_complete(unsigned* bar, unsigned x, unsigned& nloc, unsigned& nx) {
    const unsigned G = gridDim.x * gridDim.y * gridDim.z;
    unsigned sum, cnt, mine, sp = 0u;
    for (;;) {
        sum = 0u; cnt = 0u; mine = 0u;
#pragma unroll
        for (unsigned j = 0; j < 16; ++j) { const unsigned c = xb_ld(&bar[XB_XCNT(j)]); sum += c; cnt += (c > 0u) ? 1u : 0u; mine = (j == x) ? c : mine; }
        if (sum == G) break;
        __builtin_amdgcn_s_sleep(1);
        if ((++sp & 255u) == 0u) { if (xb_ld(&bar[XB_TMO])) break; if (sp > XB_SPIN_CAP) { atomicAdd(&bar[XB_TMO], 1u); break; } }
    }
    nloc = mine > 0u ? mine : 1u; nx = cnt > 0u ? cnt : 1u;
}

__device__ __forceinline__ void xcd_barrier(const XcdBarrier& b) {
    asm volatile("s_waitcnt vmcnt(0)" ::: "memory");
    __syncthreads();
    if (threadIdx.x == 0) {
        unsigned* bar = b.bar;
        __builtin_amdgcn_s_waitcnt(0);
        unsigned nloc = b.st[0], nx = b.st[1];
        if (nloc == 0u) { xcd_barrier_complete(bar, b.x, nloc, nx); b.st[0] = nloc; b.st[1] = nx; }
        const unsigned old = xb_add(&bar[XB_XSUB(b.x)], 1u);
        const unsigned gen = old / nloc;
        if (old + 1u == (gen + 1u) * nloc) {
            __builtin_amdgcn_fence(__ATOMIC_RELEASE, "agent");
            asm volatile("s_waitcnt vmcnt(0)" ::: "memory");
            const unsigned og = xb_add(&bar[XB_TOP], 1u);
            const unsigned tg = og / nx;
            if (og + 1u == (tg + 1u) * nx) xb_add(&bar[XB_TOPGEN], 1u);
            else XB_SPIN(xb_ld(&bar[XB_TOPGEN]) == tg, bar);
            __builtin_amdgcn_fence(__ATOMIC_ACQUIRE, "agent");
            xb_add(&bar[XB_XGEN(b.x)], 1u);
            asm volatile("s_waitcnt vmcnt(0)" ::: "memory");
        } else {
            XB_SPIN(xb_ld(&bar[XB_XGEN(b.x)]) == gen, bar);
            __builtin_amdgcn_fence(__ATOMIC_ACQUIRE, "agent");
            asm volatile("s_waitcnt vmcnt(0)" ::: "memory");
        }
    }
    __syncthreads();
}

struct OrderG1 { pg8::StaticOrder full, all; bool special; int c;
    __device__ void init(int G, int c_) { special = (G == 256); c = c_; full.init(NTOK, 2560, G, c_, 4); all.init(NTOK, N1, G, c_); }
    __device__ bool next(int i, pg8::Unit& u) const { if (!special) return all.next(i, u); if (i < 5) return full.next(i, u); if (i == 5 && c < 128) { u.pm = c; u.pn = 10; return true; } return false; }
    __device__ __forceinline__ void a_ready(const pg8::Unit&) const {}
    __device__ __forceinline__ void done(const pg8::Unit&) const {}
};
struct Args { const float* in[18]; float* out; unsigned char* ws; int ph_lo, ph_hi; };

struct Epi1 {
    static constexpr bool PERM = true, AFTER_DRAIN = false;
    bf16* P; bf16* PU; bf16* LR;
    DI void operator()(const f32x4 (&acc)[2][2][4][2], const pg8::Unit& u, int wr, int wc, int fr, int fq) const {
        const int row0 = u.pm * 256 + wr * 64 + fr;
        if (u.pn == 10) {
            if (wc == 0) {
#pragma unroll
                for (int ai = 0; ai < 2; ++ai)
#pragma unroll
                    for (int m = 0; m < 4; ++m) { bf16* p = LR + (size_t)(row0 + ai * 128 + m * 16) * 64 + (fq >> 1) * 32 + (fq & 1) * 8; u32x4 hv, lv;
#pragma unroll
                        for (int e = 0; e < 4; ++e) { const float x0 = acc[ai][0][m][e >> 1][(e & 1) * 2], x1 = acc[ai][0][m][e >> 1][(e & 1) * 2 + 1]; const unsigned hp = pk2(x0, x1);
                            hv[e] = hp; lv[e] = pk2(x0 - bflo(hp), x1 - bfhi(hp)); }
                        *(u32x4*)p = hv; *(u32x4*)(p + 16) = lv; }
            }
            return;
        }
        const bool act = u.pn >= 6;
        const int col0 = u.pn * 256 + wc * 32 + 8 * fq;
#pragma unroll
        for (int ai = 0; ai < 2; ++ai)
#pragma unroll
            for (int m = 0; m < 4; ++m) { const int row = row0 + ai * 128 + m * 16;
#pragma unroll
                for (int bj = 0; bj < 2; ++bj) { const int col = col0 + bj * 128;
                    bf16* dst = act ? PU + (size_t)row * PUS + (col - 1536) : P + ((size_t)(col / 384) * NTOK + row) * PHS + col % 384;
                    f32x4 v0 = acc[ai][bj][m][0], v1 = acc[ai][bj][m][1];
                    if (act) { pg8::f32x2 a = pg8::gelu_pk((pg8::f32x2){v0[0], v0[1]}), b = pg8::gelu_pk((pg8::f32x2){v0[2], v0[3]}), c = pg8::gelu_pk((pg8::f32x2){v1[0], v1[1]}), d = pg8::gelu_pk((pg8::f32x2){v1[2], v1[3]});
                        v0 = (f32x4){a.x, a.y, b.x, b.y}; v1 = (f32x4){c.x, c.y, d.x, d.y}; }
                    u32x4 w; w.x = pk2(v0[0], v0[1]); w.y = pk2(v0[2], v0[3]); w.z = pk2(v1[0], v1[1]); w.w = pk2(v1[2], v1[3]);
                    *(u32x4*)dst = w; } }
    }
};
template <int MODE> struct EpiRes {
    static constexpr bool PERM = true, AFTER_DRAIN = false;
    const float* xsc; const bf16* baseb; const float* aux  ; bf16* ob; float* ssq;
    DI void operator()(const f32x4 (&acc)[2][2][4][2], const pg8::Unit& u, int wr, int wc, int fr, int fq) const {
        const int row0 = u.pm * 256 + wr * 64 + fr, col0 = u.pn * 256 + wc * 32 + 8 * fq;
        f32x4 gi[2][2];
        if (MODE == 0) {
#pragma unroll
            for (int bj = 0; bj < 2; ++bj)
#pragma unroll
                for (int n = 0; n < 2; ++n) { const f32x4 gq = *(const f32x4*)(aux + col0 + bj * 128 + n * 4); gi[bj][n] = (f32x4){1.0f / gq[0], 1.0f / gq[1], 1.0f / gq[2], 1.0f / gq[3]}; } }
#pragma unroll
        for (int ai = 0; ai < 2; ++ai) {
            u32x4 bw[4][2]; float sc[4];
#pragma unroll
            for (int m = 0; m < 4; ++m) { if (MODE == 0) sc[m] = xsc[row0 + ai * 128 + m * 16];
#pragma unroll
                for (int bj = 0; bj < 2; ++bj) bw[m][bj] = *(const u32x4*)(baseb + (size_t)(row0 + ai * 128 + m * 16) * DM + col0 + bj * 128); }
#pragma unroll
            for (int m = 0; m < 4; ++m) { const int row = row0 + ai * 128 + m * 16; float s = 0.f;
#pragma unroll
                for (int bj = 0; bj < 2; ++bj) { const size_t o = (size_t)row * DM + col0 + bj * 128; const u32x4 w = bw[m][bj];
                    f32x4 v0 = (f32x4){bflo(w.x), bfhi(w.x), bflo(w.y), bfhi(w.y)}, v1 = (f32x4){bflo(w.z), bfhi(w.z), bflo(w.w), bfhi(w.w)};
                    if (MODE == 0) { v0 = v0 * sc[m] * gi[bj][0]; v1 = v1 * sc[m] * gi[bj][1]; }
                    v0 = v0 + acc[ai][bj][m][0]; v1 = v1 + acc[ai][bj][m][1];
                    s += ((v0[0] * v0[0] + v0[1] * v0[1]) + (v0[2] * v0[2] + v0[3] * v0[3])) + ((v1[0] * v1[0] + v1[1] * v1[1]) + (v1[2] * v1[2] + v1[3] * v1[3]));
                    if (MODE == 0) { u32x4 wo; wo.x = pk2(v0[0], v0[1]); wo.y = pk2(v0[2], v0[3]); wo.z = pk2(v1[0], v1[1]); wo.w = pk2(v1[2], v1[3]); *(u32x4*)(ob + o) = wo; }
                    else { *(f32x4*)((float*)aux + o) = v0; *(f32x4*)((float*)aux + o + 4) = v1; } }
                s += __shfl_xor(s, 16); s += __shfl_xor(s, 32);
                if (fq == 0) atomicAdd(ssq + row, s); }
        }
    }
};
struct EpiFinal {
    static constexpr bool PERM = true, AFTER_DRAIN = false;
    const bf16* base; float* out; float* ssq; unsigned* cnt; const float* gf;
    DI void operator()(f32x4 (&acc)[2][2][4][2], const pg8::Unit& u, int wr, int wc, int fr, int fq) const {
        const int row0 = u.pm * 256 + wr * 64 + fr, col0 = u.pn * 256 + wc * 32 + 8 * fq;
        u32x4 bw[2][4][2];
#pragma unroll
        for (int ai = 0; ai < 2; ++ai)
#pragma unroll
            for (int m = 0; m < 4; ++m)
#pragma unroll
                for (int bj = 0; bj < 2; ++bj) bw[ai][m][bj] = *(const u32x4*)(base + (size_t)(row0 + ai * 128 + m * 16) * DM + col0 + bj * 128);
        f32x4 gv[2][2];
#pragma unroll
        for (int bj = 0; bj < 2; ++bj)
#pragma unroll
            for (int n = 0; n < 2; ++n) gv[bj][n] = *(const f32x4*)(gf + col0 + bj * 128 + n * 4);
#pragma unroll
        for (int ai = 0; ai < 2; ++ai)
#pragma unroll
            for (int m = 0; m < 4; ++m) { const int row = row0 + ai * 128 + m * 16; float s = 0.f;
#pragma unroll
                for (int bj = 0; bj < 2; ++bj) { const u32x4 w = bw[ai][m][bj];
                    const f32x4 v0 = (f32x4){bflo(w.x), bfhi(w.x), bflo(w.y), bfhi(w.y)} + acc[ai][bj][m][0], v1 = (f32x4){bflo(w.z), bfhi(w.z), bflo(w.w), bfhi(w.w)} + acc[ai][bj][m][1];
                    acc[ai][bj][m][0] = v0; acc[ai][bj][m][1] = v1;
                    s += ((v0[0] * v0[0] + v0[1] * v0[1]) + (v0[2] * v0[2] + v0[3] * v0[3])) + ((v1[0] * v1[0] + v1[1] * v1[1]) + (v1[2] * v1[2] + v1[3] * v1[3])); }
                s += __shfl_xor(s, 16); s += __shfl_xor(s, 32);
                if (fq == 0) atomicAdd(ssq + row, s); }
        asm volatile("s_waitcnt vmcnt(0)" ::: "memory");
        unsigned* c = cnt + 64 * u.pm;
        if (fr == 0 && fq == 0) __hip_atomic_fetch_add(c, 1u, __ATOMIC_RELAXED, __HIP_MEMORY_SCOPE_AGENT);
        { unsigned sp = 0; while ((unsigned)__builtin_amdgcn_readfirstlane(__hip_atomic_load(c, __ATOMIC_RELAXED, __HIP_MEMORY_SCOPE_AGENT)) < 32u) { __builtin_amdgcn_s_sleep(2); if (++sp > (1u << 22)) break; } }
        float sv[8];
#pragma unroll
        for (int i = 0; i < 8; ++i) sv[i] = __hip_atomic_load(ssq + row0 + (i >> 2) * 128 + (i & 3) * 16, __ATOMIC_RELAXED, __HIP_MEMORY_SCOPE_AGENT);
#pragma unroll
        for (int ai = 0; ai < 2; ++ai)
#pragma unroll
            for (int m = 0; m < 4; ++m) { const int row = row0 + ai * 128 + m * 16; const float rs = rsqrtf(sv[ai * 4 + m] * (1.0f / 1024.0f) + EPS);
#pragma unroll
                for (int bj = 0; bj < 2; ++bj)
#pragma unroll
                    for (int n = 0; n < 2; ++n) *(f32x4*)(out + (size_t)row * DM + col0 + bj * 128 + n * 4) = acc[ai][bj][m][n] * rs * gv[bj][n]; }
    }
};
struct Epi3 {
    static constexpr bool PERM = true, AFTER_DRAIN = false;
    bf16* ACT; const float* ssq;
    DI void operator()(const f32x4 (&acc)[2][2][4][2], const pg8::Unit& u, int wr, int wc, int fr, int fq) const {
        const int row0 = u.pm * 256 + wr * 64 + fr, col0 = u.pn * 128 + wc * 32 + 8 * fq;
        float sv[8];
#pragma unroll
        for (int i = 0; i < 8; ++i) sv[i] = ssq[row0 + (i >> 2) * 128 + (i & 3) * 16];
#pragma unroll
        for (int ai = 0; ai < 2; ++ai)
#pragma unroll
            for (int m = 0; m < 4; ++m) { const int row = row0 + ai * 128 + m * 16; const float rs = rsqrtf(sv[ai * 4 + m] * (1.0f / 1024.0f) + EPS);
                float o[8];
#pragma unroll
                for (int n = 0; n < 2; ++n)
#pragma unroll
                    for (int e = 0; e < 4; ++e) o[n * 4 + e] = silu_f(acc[ai][0][m][n][e] * rs) * (acc[ai][1][m][n][e] * rs);
                u32x4 w; w.x = pk2(o[0], o[1]); w.y = pk2(o[2], o[3]); w.z = pk2(o[4], o[5]); w.w = pk2(o[6], o[7]);
                *(u32x4*)(ACT + (size_t)row * DFF + col0) = w; }
    }
};

DI void p0_item(const Args& A, int it, LAS float* scr, int tid) {
    int mat, ntile, kt;
    if (it < 704) { mat = 1; ntile = it >> 4; kt = it & 15; }
    else if (it < 960) { it -= 704; mat = 2; ntile = it >> 4; kt = it & 15; }
    else if (it < 2368) { it -= 960; mat = 3; ntile = it >> 4; kt = it & 15; }
    else { it -= 2368; mat = 4; ntile = it / 44; kt = it % 44; }
    const int kl = tid >> 3, n8 = tid & 7, nd = ntile * 64 + n8 * 8, k = kt * 64 + kl;
    const float* src = nullptr; int ldw = 0, sc = 0; float scale = 1.f; bf16* dst; int K = 1024;
    if (mat == 1) { ldw = PWSRC; dst = (bf16*)(A.ws + WS_BT1);
        if (nd < 1536) { const int hh = nd / 384, c = nd % 384; sc = c < 64 ? hh * 64 + c : (c < 128 ? 256 + hh * 64 + (c - 64) : (c < 256 ? 512 + hh * 128 + (c - 128) : 1024 + hh * 128 + (c - 256))); if (c < 64) scale = 0.125f; }
        else if (nd < 2560) sc = nd + 32; else if (nd < 2592) sc = nd - 2560 + 1536; else sc = -1;
        if (sc >= 0) src = A.in[2]; }
    else if (mat == 2) { ldw = 1024; dst = (bf16*)(A.ws + WS_BT2); sc = nd; src = A.in[12]; }
    else if (mat == 3) { ldw = DFF; dst = (bf16*)(A.ws + WS_BT3); const int tl = nd >> 8, r = nd & 255; if (r < 128) { src = A.in[14]; sc = tl * 128 + r; } else { src = A.in[15]; sc = tl * 128 + r - 128; } scale = A.in[13][k]; }
    else { ldw = 1024; dst = (bf16*)(A.ws + WS_BT4); sc = nd; src = A.in[16]; K = DFF; }
    f32x4 a = (f32x4){0.f, 0.f, 0.f, 0.f}, b = a;
    if (src) { const float* p = src + (size_t)k * ldw + sc; a = *(const f32x4*)p * scale; b = *(const f32x4*)(p + 4) * scale; }
    LAS float* w = scr + kl * 65 + n8 * 8;
    w[0] = a[0]; w[1] = a[1]; w[2] = a[2]; w[3] = a[3]; w[4] = b[0]; w[5] = b[1]; w[6] = b[2]; w[7] = b[3];
    __syncthreads();
    const int nl = tid >> 3, k8 = tid & 7; float v[8];
#pragma unroll
    for (int j = 0; j < 8; ++j) v[j] = scr[(k8 * 8 + j) * 65 + nl];
    u32x4 o; o.x = pk2(v[0], v[1]); o.y = pk2(v[2], v[3]); o.z = pk2(v[4], v[5]); o.w = pk2(v[6], v[7]);
    *(u32x4*)(dst + (size_t)(ntile * 64 + nl) * K + kt * 64 + k8 * 8) = o;
    __syncthreads();
}
DI void p0_prologue(const Args& A, LAS unsigned char* lds, int tid) {
    const int G = gridDim.x, bx = blockIdx.x, lane = tid & 63, wid = tid >> 6;
    for (int i = bx * 512 + tid; i < 65536; i += G * 512) ((float*)(A.ws + WS_SSQ1))[i] = 0.f;
    for (int i = bx * 512 + tid; i < 65536; i += G * 512) { ((bf16*)(A.ws + WS_WSB))[i] = (bf16)(pk2(A.in[10][i], 0.f) & 0xffffu); }
    for (int i = bx * 512 + tid; i < 512; i += G * 512) { const float* w = A.in[10] + (size_t)i * 128; float r = 0.f;
        for (int j = 0; j < 128; j += 4) { const f32x4 v = *(const f32x4*)(w + j); r += (v[0] + v[1]) + (v[2] + v[3]); }
        ((float*)(A.ws + WS_RSW))[i] = r; }
    for (int it = bx; it < 3072; it += G) p0_item(A, it, (LAS float*)lds, tid);
    const float* x = A.in[0]; const float* g1 = A.in[1]; bf16* H = (bf16*)(A.ws + WS_H);
    f32x4 gv[4];
#pragma unroll
    for (int j = 0; j < 4; ++j) gv[j] = *(const f32x4*)(g1 + lane * 4 + 256 * j);
    for (int row = bx * 8 + wid; row < NTOK; row += G * 8) {
        const float* xr = x + (size_t)row * DM; f32x4 v[4]; float s = 0.f;
#pragma unroll
        for (int j = 0; j < 4; ++j) { v[j] = *(const f32x4*)(xr + lane * 4 + 256 * j); s += (v[j][0] * v[j][0] + v[j][1] * v[j][1]) + (v[j][2] * v[j][2] + v[j][3] * v[j][3]); }
#pragma unroll
        for (int o = 1; o < 64; o <<= 1) s += __shfl_xor(s, o);
        const float rs = rsqrtf(s * (1.0f / 1024.0f) + EPS);
        if (lane == 0) ((float*)(A.ws + WS_XSC))[row] = sqrtf(s * (1.0f / 1024.0f) + EPS);
#pragma unroll
        for (int j = 0; j < 4; ++j) { const f32x4 y = v[j] * rs * gv[j]; u32x2 w; w.x = pk2(y[0], y[1]); w.y = pk2(y[2], y[3]); *(u32x2*)(H + (size_t)row * DM + lane * 4 + 256 * j) = w; }
    }
}

constexpr int GM_VTS = 136, GM_PART = (128 * GM_VTS + 16) * 2  , GM_LN = 4 * GM_PART;
static_assert(GM_LN + 4096 <= 151552 - 16, "gMLP LDS map");
DI void gmlp_phase(const Args& A, LAS unsigned char* lds, int tid) {
    const int lane = tid & 63, wid = tid >> 6, fr = lane & 15, fq = lane >> 4;
    const bf16* PU = (const bf16*)(A.ws + WS_PU); bf16* Y = (bf16*)(A.ws + WS_Y); const bf16* WS = (const bf16*)(A.ws + WS_WSB); const float* RSW = (const float*)(A.ws + WS_RSW);
    const float* bsp = A.in[11];
    LAS float* LN = (LAS float*)(lds + GM_LN);
    for (int unit = blockIdx.x; unit < 256; unit += gridDim.x) {
        const int tok0 = unit * 128, j = tid >> 2, part = tid & 3, irow = wid * 16 + fr;
        u32x4 w[16];
        { const bf16* p = PU + (size_t)(tok0 + j) * PUS + 512 + part * 128;
#pragma unroll
          for (int i = 0; i < 16; ++i) w[i] = *(const u32x4*)(p + i * 8); }
        bf16x8 wfn[4]; u32x4 uvn[4];
#define GM_LOADG(g_) do { _Pragma("unroll") for (int ks_ = 0; ks_ < 4; ++ks_) wfn[ks_] = *(const bf16x8*)(WS + (size_t)(g_) * 16384 + irow * 128 + ks_ * 32 + fq * 8); \
        _Pragma("unroll") for (int pp_ = 0; pp_ < 4; ++pp_) uvn[pp_] = *(const u32x4*)(PU + (size_t)(tok0 + irow) * PUS + (g_) * 128 + pp_ * 32 + 8 * fq); } while (0)
        lds_barrier();
        LN[tid] = A.in[8][tid]; LN[512 + tid] = A.in[9][tid];
        float sm = 0.f, sq = 0.f;
#pragma unroll
        for (int i = 0; i < 16; ++i)
#pragma unroll
            for (int e = 0; e < 4; ++e) { const float a = bflo(w[i][e]), b = bfhi(w[i][e]); sm += a + b; sq += a * a + b * b; }
        sm += __shfl_xor(sm, 1); sm += __shfl_xor(sm, 2); sq += __shfl_xor(sq, 1); sq += __shfl_xor(sq, 2);
        const float mean = sm * (1.0f / 512.0f), rstd = rsqrtf(fmaxf(sq * (1.0f / 512.0f) - mean * mean, 0.f) + EPS);
        LAS unsigned short* vt = (LAS unsigned short*)(lds + part * GM_PART) + j;
#pragma unroll
        for (int i = 0; i < 16; ++i)
#pragma unroll
            for (int e = 0; e < 4; ++e) { const unsigned pv = pk2((bflo(w[i][e]) - mean) * rstd, (bfhi(w[i][e]) - mean) * rstd); const int c = i * 8 + e * 2;
                vt[c * GM_VTS] = (unsigned short)(pv & 0xffffu); vt[(c + 1) * GM_VTS] = (unsigned short)(pv >> 16); }
        GM_LOADG(0);
        lds_barrier();
        for (int g = 0; g < 4; ++g) {
            bf16x8 wf[4]; u32x4 uv[4];
#pragma unroll
            for (int ks = 0; ks < 4; ++ks) wf[ks] = wfn[ks];
#pragma unroll
            for (int pp = 0; pp < 4; ++pp) uv[pp] = uvn[pp];
            if (g < 3) GM_LOADG(g + 1);
            const float bias = bsp[g * 128 + irow], rsw = RSW[g * 128 + irow];
#pragma unroll
            for (int pp = 0; pp < 4; ++pp) {
                f32x4 a0 = (f32x4){0.f, 0.f, 0.f, 0.f}, a1 = a0;
#pragma unroll
                for (int ks = 0; ks < 4; ++ks) { a0 = mfma16(lds_frag(lds + g * GM_PART + ((32 * pp + 8 * (fr >> 2) + (fr & 3)) * GM_VTS + ks * 32 + fq * 8) * 2), wf[ks], a0);
                    a1 = mfma16(lds_frag(lds + g * GM_PART + ((32 * pp + 8 * (fr >> 2) + 4 + (fr & 3)) * GM_VTS + ks * 32 + fq * 8) * 2), wf[ks], a1); }
                const int c = 32 * pp + 8 * fq; const u32x4 uu = uv[pp];
                const f32x4 lg0 = *(LAS const f32x4*)(LN + g * 128 + c), lg1 = *(LAS const f32x4*)(LN + g * 128 + c + 4), lb0 = *(LAS const f32x4*)(LN + 512 + g * 128 + c), lb1 = *(LAS const f32x4*)(LN + 512 + g * 128 + c + 4);
                u32x4 o; o.x = pk2(bflo(uu.x) * (lg0[0] * a0[0] + lb0[0] * rsw + bias), bfhi(uu.x) * (lg0[1] * a0[1] + lb0[1] * rsw + bias));
                o.y = pk2(bflo(uu.y) * (lg0[2] * a0[2] + lb0[2] * rsw + bias), bfhi(uu.y) * (lg0[3] * a0[3] + lb0[3] * rsw + bias));
                o.z = pk2(bflo(uu.z) * (lg1[0] * a1[0] + lb1[0] * rsw + bias), bfhi(uu.z) * (lg1[1] * a1[1] + lb1[1] * rsw + bias));
                o.w = pk2(bflo(uu.w) * (lg1[2] * a1[2] + lb1[2] * rsw + bias), bfhi(uu.w) * (lg1[3] * a1[3] + lb1[3] * rsw + bias));
                *(u32x4*)(Y + (size_t)(tok0 + irow) * DM + 512 + g * 128 + c) = o; }
        }
#undef GM_LOADG
    }
}

constexpr int G_LR = 0, G_WD = 8192, G_BD = 16384, G_SEG = 16896, G_LA = 18944, G_A0 = 52224, RS72 = 72;
constexpr int GA_KTF = G_A0, GA_KTB = G_A0 + 9216, GA_VT = G_A0 + 18432;
constexpr int GC_QDF = G_A0, GC_QDB = G_A0 + 9216, GC_KDF = G_A0 + 18432, GC_KDB = G_A0 + 27648, GC_VT = G_A0 + 36864, GC_SS = GC_VT + 18432, GC_RS = GC_SS + 9216;
constexpr int GC_STF = 0, GC_STB = 132096;
static_assert(GC_RS + 512 <= 131072 && GC_STF + 18432 <= G_LA && GC_STB + 18432 <= 151552 - 16, "GLA LDS map");
struct DecayW { bf16x8 bh, bl; float bias; };
DI unsigned hi16(float x) { return pk2(x, 0.f) & 0xffffu; }
DI DecayW gla_decay_w(const Args& A, int h, int wid, int fr, int fq) {
    const int dir = wid >> 2, d = h * 64 + 16 * (wid & 3) + fr; const float* w = (dir ? A.in[5] : A.in[3]) + ((fq & 1) * 8) * 256 + d;
    DecayW o; unsigned hh[8], ll[8];
#pragma unroll
    for (int j = 0; j < 8; ++j) { const float x = w[j * 256]; hh[j] = hi16(x); ll[j] = (fq < 2) ? hi16(x - __uint_as_float(hh[j] << 16)) : 0u; }
    u32x4 a, b;
#pragma unroll
    for (int e = 0; e < 4; ++e) { a[e] = hh[2 * e] | (hh[2 * e + 1] << 16); b[e] = ll[2 * e] | (ll[2 * e + 1] << 16); }
    o.bh = __builtin_bit_cast(bf16x8, a); o.bl = __builtin_bit_cast(bf16x8, b); o.bias = (dir ? A.in[6] : A.in[4])[d];
    return o;
}
struct LrRows { bf16x8 v[4]; };
DI LrRows gla_load_lr(const bf16* LRg, int tok0, int wid, int fr, int fq) {
    LrRows o; const bf16* p = LRg + (size_t)(tok0 + fr) * 64 + (wid >> 2) * 32 + fq * 8;
#pragma unroll
    for (int tt = 0; tt < 4; ++tt) o.v[tt] = *(const bf16x8*)(p + tt * 1024);
    return o;
}
DI void gla_decay(LAS unsigned char* lds, const LrRows& L, const DecayW& W, int wid, int fr, int fq) {
    LAS float* LA = (LAS float*)(lds + G_LA); const int dir = wid >> 2, d = 16 * (wid & 3) + fr;
    float la[4][4], p[4][4], S[4], ex[4], tot[4];
#pragma unroll
    for (int tt = 0; tt < 4; ++tt) {
        const bf16x8 a1 = L.v[tt]; const bf16x8 a2 = (fq < 2) ? a1 : (bf16x8){0, 0, 0, 0, 0, 0, 0, 0};
        f32x4 z = (f32x4){0.f, 0.f, 0.f, 0.f};
        z = mfma16(a1, W.bh, z); z = mfma16(a2, W.bl, z);
#pragma unroll
        for (int r = 0; r < 4; ++r) la[tt][r] = logsig(z[r] + W.bias) * (1.0f / 16.0f);
        p[tt][0] = la[tt][0]; p[tt][1] = p[tt][0] + la[tt][1]; p[tt][2] = p[tt][1] + la[tt][2]; p[tt][3] = p[tt][2] + la[tt][3]; S[tt] = p[tt][3];
    }
#pragma unroll
    for (int tt = 0; tt < 4; ++tt) { const float s1 = __shfl_xor(S[tt], 16), s2 = __shfl_xor(S[tt], 32), s3 = __shfl_xor(s1, 32);
        tot[tt] = (S[tt] + s1) + (s2 + s3); ex[tt] = fq == 0 ? 0.f : (fq == 1 ? s1 : (fq == 2 ? s2 + s3 : s1 + s2 + s3)); }
    const float T = (tot[0] + tot[1]) + (tot[2] + tot[3]); float base = 0.f;
#pragma unroll
    for (int tt = 0; tt < 4; ++tt) {
#pragma unroll
        for (int r = 0; r < 4; ++r) { const float pre = base + ex[tt] + p[tt][r]; LA[(dir * 64 + 16 * tt + 4 * fq + r) * 65 + d] = dir ? (T - pre + la[tt][r]) : pre; }
        base += tot[tt]; }
    lds_barrier();
}
DI int vt_rot(int dv) { return 8 * ((dv >> 3) & 3); }
DI int kt_rot(int d) { return 4 * ((d >> 2) & 7); }
DI bf16x8 rot_frag(LAS const unsigned char* img, int row, int ks, int fq, int rot) { return *(LAS const bf16x8*)(img + row * (RS72 * 2) + (((16 * ks + 4 * fq) + rot) & 31) * 4); }
DI void gla_build_vt(const u32x4 a, const u32x4 b, LAS unsigned char* vtb, int tid) {
    const int sp = tid >> 4, dvb = tid & 15, col = (sp + vt_rot(dvb * 8)) & 31; LAS unsigned* vt = (LAS unsigned*)vtb;
#pragma unroll
    for (int e = 0; e < 4; ++e) { const int dv = dvb * 8 + 2 * e;
        vt[dv * (RS72 / 2) + col] = (a[e] & 0xffffu) | (b[e] << 16);
        vt[(dv + 1) * (RS72 / 2) + col] = (a[e] >> 16) | (b[e] & 0xffff0000u); }
}
DI size_t st_off(int dir, int b, int h, int n) { return ((size_t)((dir * 4 + b) * 4 + h) * 128 + n) * 8192; }
DI void gla_pass_a(const Args& A, LAS unsigned char* lds, int tid) {
    const int lane = tid & 63, wid = tid >> 6, fr = lane & 15, fq = lane >> 4;
    const bf16* P = (const bf16*)(A.ws + WS_P); bf16* ST = (bf16*)(A.ws + WS_ST); float* DEC = (float*)(A.ws + WS_DEC);
    LAS float* LA = (LAS float*)(lds + G_LA);
    const bf16* LRg = (const bf16*)(A.ws + WS_LR); int h_loaded = -1; DecayW dw; dw.bh = (bf16x8){0,0,0,0,0,0,0,0}; dw.bl = dw.bh; dw.bias = 0.f;
    const int sp = tid >> 4, db = tid & 15;
    LrRows lrn; u32x2 k0n, k1n; u32x4 van, vbn;
#define GA_LOAD(un) do { const int h_ = (un) & 3, tok_ = ((un) >> 2) * 64; lrn = gla_load_lr(LRg, tok_, wid, fr, fq); \
        const bf16* kp_ = P + ((size_t)h_ * NTOK + tok_ + 2 * sp) * PHS + 64 + db * 4; k0n = *(const u32x2*)kp_; k1n = *(const u32x2*)(kp_ + PHS); \
        const bf16* vp_ = P + ((size_t)h_ * NTOK + tok_ + 2 * sp) * PHS + 128 + db * 8; van = *(const u32x4*)vp_; vbn = *(const u32x4*)(vp_ + PHS); } while (0)
    if (blockIdx.x < 2048) GA_LOAD(blockIdx.x);
    for (int unit = blockIdx.x; unit < 2048; unit += gridDim.x) {
        const int h = unit & 3, cn = unit >> 2, b = cn >> 7, n = cn & 127;
        if (h != h_loaded) { dw = gla_decay_w(A, h, wid, fr, fq); h_loaded = h; }
        const LrRows lrc = lrn; const u32x2 k0 = k0n, k1 = k1n; const u32x4 va = van, vb = vbn;
        if (unit + (int)gridDim.x < 2048) GA_LOAD(unit + gridDim.x);
        gla_decay(lds, lrc, dw, wid, fr, fq);
        {
            const float kk0[4] = {bflo(k0.x), bfhi(k0.x), bflo(k0.y), bfhi(k0.y)}, kk1[4] = {bflo(k1.x), bfhi(k1.x), bflo(k1.y), bfhi(k1.y)};
#pragma unroll
            for (int dir = 0; dir < 2; ++dir) { LAS unsigned* kt = (LAS unsigned*)(lds + (dir ? GA_KTB : GA_KTF));
#pragma unroll
                for (int j = 0; j < 4; ++j) { const int d = db * 4 + j; const float be = LA[(dir * 64 + (dir ? 0 : 63)) * 65 + d];
                    const float e0 = __expf(be - LA[(dir * 64 + 2 * sp) * 65 + d]), e1 = __expf(be - LA[(dir * 64 + 2 * sp + 1) * 65 + d]);
                    kt[d * (RS72 / 2) + ((sp + kt_rot(d)) & 31)] = pk2(kk0[j] * e0, kk1[j] * e1); } }
            if (tid < 128) { const int dir = tid >> 6, d = tid & 63; DEC[((size_t)((dir * 4 + b) * 4 + h) * 128 + n) * 64 + d] = __expf(LA[(dir * 64 + (dir ? 0 : 63)) * 65 + d]); }
        }
        gla_build_vt(va, vb, lds + GA_VT, tid);
        lds_barrier();
        {
            const int dir = wid >> 2, dvt0 = (wid & 3) * 2; LAS const unsigned char* kt = lds + (dir ? GA_KTB : GA_KTF);
            bf16x8 yv[2][2];
#pragma unroll
            for (int dvi = 0; dvi < 2; ++dvi)
#pragma unroll
                for (int ks = 0; ks < 2; ++ks) yv[dvi][ks] = rot_frag(lds + GA_VT, (dvt0 + dvi) * 16 + fr, ks, fq, vt_rot((dvt0 + dvi) * 16 + fr));
            bf16* stp = ST + st_off(dir, b, h, n);
#pragma unroll
            for (int pp = 0; pp < 2; ++pp) {
                bf16x8 x[2][2];
#pragma unroll
                for (int nn = 0; nn < 2; ++nn)
#pragma unroll
                    for (int ks = 0; ks < 2; ++ks) { const int dkr = 32 * pp + 8 * (fr >> 2) + 4 * nn + (fr & 3); x[nn][ks] = rot_frag(kt, dkr, ks, fq, kt_rot(dkr)); }
#pragma unroll
                for (int dvi = 0; dvi < 2; ++dvi) { f32x4 a0 = (f32x4){0.f, 0.f, 0.f, 0.f}, a1 = a0;
                    a0 = mfma16(x[0][0], yv[dvi][0], a0); a0 = mfma16(x[0][1], yv[dvi][1], a0); a1 = mfma16(x[1][0], yv[dvi][0], a1); a1 = mfma16(x[1][1], yv[dvi][1], a1);
                    u32x4 w; w.x = pk2(a0[0], a0[1]); w.y = pk2(a0[2], a0[3]); w.z = pk2(a1[0], a1[1]); w.w = pk2(a1[2], a1[3]);
                    *(u32x4*)(stp + ((dvt0 + dvi) * 16 + fr) * 64 + 32 * pp + 8 * fq) = w; } }
        }
    }
    lds_barrier();
#undef GA_LOAD
}
DI void gla_scan(const Args& A, LAS unsigned char* lds, int tid) {
    unsigned* ST = (unsigned*)(A.ws + WS_ST); const float* DEC = (const float*)(A.ws + WS_DEC); LAS float* DL = (LAS float*)lds;
    for (int g0 = blockIdx.x * 512; g0 < 131072; g0 += gridDim.x * 512) {
        const int gt = g0 + tid, seq = g0 >> 12, e2 = gt & 4095, dir = seq >> 4, dk = (2 * e2) & 63;
        __syncthreads();
#pragma unroll
        for (int i = 0; i < 4; ++i) *(LAS f32x4*)(DL + (tid + 512 * i) * 4) = *(const f32x4*)(DEC + (size_t)seq * 8192 + (tid + 512 * i) * 4);
        __syncthreads();
        unsigned* sp = ST + (size_t)seq * 128 * 4096 + e2;
        float s0 = 0.f, s1 = 0.f;
        unsigned nx[32];
#pragma unroll
        for (int j = 0; j < 32; ++j) { const int n = dir ? 127 - j : j; nx[j] = __builtin_nontemporal_load(sp + (size_t)n * 4096); }
#pragma unroll 1
        for (int i0 = 0; i0 < 128; i0 += 32) {
            unsigned ds[32];
#pragma unroll
            for (int j = 0; j < 32; ++j) ds[j] = nx[j];
            if (i0 + 32 < 128) {
#pragma unroll
                for (int j = 0; j < 32; ++j) { const int n = dir ? 127 - (i0 + 32 + j) : i0 + 32 + j; nx[j] = __builtin_nontemporal_load(sp + (size_t)n * 4096); } }
#pragma unroll
            for (int j = 0; j < 32; ++j) { const int n = dir ? 127 - (i0 + j) : i0 + j; const float d0 = DL[n * 64 + dk], d1 = DL[n * 64 + dk + 1];
                sp[(size_t)n * 4096] = pk2(s0, s1); s0 = d0 * s0 + bflo(ds[j]); s1 = d1 * s1 + bfhi(ds[j]); }
        }
    }
}
DI void gla_pass_c(const Args& A, LAS unsigned char* lds, int tid) {
    const int lane = tid & 63, wid = tid >> 6, fr = lane & 15, fq = lane >> 4;
    const bf16* P = (const bf16*)(A.ws + WS_P); const bf16* ST = (const bf16*)(A.ws + WS_ST); bf16* Y = (bf16*)(A.ws + WS_Y);
    LAS float* LA = (LAS float*)(lds + G_LA); LAS float* RS = (LAS float*)(lds + GC_RS);
    const bf16* LRg = (const bf16*)(A.ws + WS_LR); int h_loaded = -1; DecayW dw; dw.bh = (bf16x8){0,0,0,0,0,0,0,0}; dw.bl = dw.bh; dw.bias = 0.f;
    const int t = tid >> 3, d8 = (tid & 7) * 8, vsp = tid >> 4, vdb = tid & 15, ott = wid & 3, odvh = wid >> 2, ot = ott * 16 + fr;
    LrRows lrn; u32x4 qn, kn, van, vbn, stn[4], ggn[2]; f32x4 ngv[4];
#pragma unroll
    for (int i = 0; i < 4; ++i) ngv[i] = (f32x4){0.f, 0.f, 0.f, 0.f};
#define GC_LOAD(un) do { const int h_ = (un) & 3, cn_ = (un) >> 2, tok_ = cn_ * 64; lrn = gla_load_lr(LRg, tok_, wid, fr, fq); \
        const bf16* qp_ = P + ((size_t)h_ * NTOK + tok_ + t) * PHS + d8; qn = *(const u32x4*)qp_; kn = *(const u32x4*)(qp_ + 64); \
        const bf16* vp_ = P + ((size_t)h_ * NTOK + tok_ + 2 * vsp) * PHS + 128 + vdb * 8; van = *(const u32x4*)vp_; vbn = *(const u32x4*)(vp_ + PHS); \
        _Pragma("unroll") for (int i_ = 0; i_ < 4; ++i_) { const int ci_ = tid + 512 * i_; stn[i_] = *(const u32x4*)(ST + st_off(ci_ >> 10, cn_ >> 7, h_, cn_ & 127) + (ci_ & 1023) * 8); } \
        _Pragma("unroll") for (int pp_ = 0; pp_ < 2; ++pp_) ggn[pp_] = *(const u32x4*)(P + ((size_t)h_ * NTOK + tok_ + ot) * PHS + 256 + odvh * 64 + 32 * pp_ + 8 * fq); } while (0)
    if (blockIdx.x < 2048) GC_LOAD(blockIdx.x);
    for (int unit = blockIdx.x; unit < 2048; unit += gridDim.x) {
        const int h = unit & 3, cn = unit >> 2, tok0 = cn * 64;
        if (h != h_loaded) { dw = gla_decay_w(A, h, wid, fr, fq); h_loaded = h;
#pragma unroll
            for (int dvi = 0; dvi < 4; ++dvi) ngv[dvi] = *(const f32x4*)(A.in[7] + h * 128 + odvh * 64 + 32 * (dvi >> 1) + 8 * fq + 4 * (dvi & 1)); }
        const LrRows lrc = lrn; const u32x4 q = qn, k = kn, va = van, vb = vbn; u32x4 stc[4]; const u32x4 gg[2] = {ggn[0], ggn[1]};
#pragma unroll
        for (int i = 0; i < 4; ++i) stc[i] = stn[i];
        if (unit + (int)gridDim.x < 2048) GC_LOAD(unit + gridDim.x);
        DUP(13) gla_decay(lds, lrc, dw, wid, fr, fq);
        DUP(10) {
#pragma unroll
            for (int dir = 0; dir < 2; ++dir) { u32x4 qo, ko;
#pragma unroll
                for (int e = 0; e < 4; ++e) { const float b0 = LA[(dir * 64 + t) * 65 + d8 + 2 * e], b1 = LA[(dir * 64 + t) * 65 + d8 + 2 * e + 1];
                    qo[e] = pk2(bflo(q[e]) * __expf(b0), bfhi(q[e]) * __expf(b1)); ko[e] = pk2(bflo(k[e]) * __expf(-b0), bfhi(k[e]) * __expf(-b1)); }
                *(LAS u32x4*)(lds + (dir ? GC_QDB : GC_QDF) + (t * RS72 + d8) * 2) = qo; *(LAS u32x4*)(lds + (dir ? GC_KDB : GC_KDF) + (t * RS72 + d8) * 2) = ko; }
        }
        gla_build_vt(va, vb, lds + GC_VT, tid);
#pragma unroll
        for (int i = 0; i < 4; ++i) { const int ci = tid + 512 * i, cc = ci & 1023; *(LAS u32x4*)(lds + ((ci >> 10) ? GC_STB : GC_STF) + ((cc >> 3) * RS72 + (cc & 7) * 8) * 2) = stc[i]; }
        lds_barrier();
        DUP(11) {
#pragma unroll
            for (int ti = 0; ti < 2; ++ti) { const int tile = wid * 2 + ti, tt = tile >> 2, st = tile & 3;
                f32x4 af = (f32x4){0.f, 0.f, 0.f, 0.f}, ab = af;
                if (st <= tt) {
#pragma unroll
                    for (int ks = 0; ks < 2; ++ks) af = mfma16(lds_frag(lds + GC_KDF + ((st * 16 + fr) * RS72 + ks * 32 + fq * 8) * 2), lds_frag(lds + GC_QDF + ((tt * 16 + fr) * RS72 + ks * 32 + fq * 8) * 2), af); }
                if (st >= tt) {
#pragma unroll
                    for (int ks = 0; ks < 2; ++ks) ab = mfma16(lds_frag(lds + GC_KDB + ((st * 16 + fr) * RS72 + ks * 32 + fq * 8) * 2), lds_frag(lds + GC_QDB + ((tt * 16 + fr) * RS72 + ks * 32 + fq * 8) * 2), ab); }
                const int t = tt * 16 + fr, s0 = st * 16 + 4 * fq; float v[4];
#pragma unroll
                for (int r = 0; r < 4; ++r) v[r] = ((s0 + r) <= t ? af[r] : 0.f) + ((s0 + r) >= t ? ab[r] : 0.f);
                u32x2 w; w.x = pk2(v[0], v[1]); w.y = pk2(v[2], v[3]);
                *(LAS u32x2*)(lds + GC_SS + (t * RS72 + s0) * 2) = w; }
        }
        lds_barrier();
        DUP(12) {
            const int tt = wid & 3, dvh = wid >> 2, t = tt * 16 + fr;
            bf16x8 yv[6];
#pragma unroll
            for (int ks = 0; ks < 2; ++ks) { yv[ks] = lds_frag(lds + GC_SS + (t * RS72 + ks * 32 + fq * 8) * 2); yv[2 + ks] = lds_frag(lds + GC_QDF + (t * RS72 + ks * 32 + fq * 8) * 2); yv[4 + ks] = lds_frag(lds + GC_QDB + (t * RS72 + ks * 32 + fq * 8) * 2); }
            f32x4 acc[4]; float q = 0.f;
#pragma unroll
            for (int dvi = 0; dvi < 4; ++dvi) { const int dvr = dvh * 64 + 32 * (dvi >> 1) + 8 * (fr >> 2) + 4 * (dvi & 1) + (fr & 3); f32x4 a = (f32x4){0.f, 0.f, 0.f, 0.f};
#pragma unroll
                for (int ks = 0; ks < 2; ++ks) { a = mfma16(rot_frag(lds + GC_VT, dvr, ks, fq, vt_rot(dvr)), yv[ks], a);
                    a = mfma16(lds_frag(lds + GC_STF + (dvr * RS72 + ks * 32 + fq * 8) * 2), yv[2 + ks], a); a = mfma16(lds_frag(lds + GC_STB + (dvr * RS72 + ks * 32 + fq * 8) * 2), yv[4 + ks], a); }
                acc[dvi] = a; q += (a[0] * a[0] + a[1] * a[1]) + (a[2] * a[2] + a[3] * a[3]); }
            q += __shfl_xor(q, 16); q += __shfl_xor(q, 32);
            if (fq == 0) RS[dvh * 64 + t] = q;
            lds_barrier();
            const float rn = rsqrtf((RS[t] + RS[64 + t]) * (1.0f / 128.0f) + EPS);
#pragma unroll
            for (int pp = 0; pp < 2; ++pp) { const int col = h * 128 + dvh * 64 + 32 * pp + 8 * fq; const u32x4 g4 = gg[pp];
                const f32x4 n0 = ngv[2 * pp], n1 = ngv[2 * pp + 1], a0 = acc[2 * pp], a1 = acc[2 * pp + 1];
                u32x4 w; w.x = pk2(a0[0] * rn * n0[0] * silu_f(bflo(g4.x)), a0[1] * rn * n0[1] * silu_f(bfhi(g4.x))); w.y = pk2(a0[2] * rn * n0[2] * silu_f(bflo(g4.y)), a0[3] * rn * n0[3] * silu_f(bfhi(g4.y)));
                w.z = pk2(a1[0] * rn * n1[0] * silu_f(bflo(g4.z)), a1[1] * rn * n1[1] * silu_f(bfhi(g4.z))); w.w = pk2(a1[2] * rn * n1[2] * silu_f(bflo(g4.w)), a1[3] * rn * n1[3] * silu_f(bfhi(g4.w)));
                *(u32x4*)(Y + (size_t)(tok0 + t) * DM + col) = w; }
        }
    }
    lds_barrier();
#undef GC_LOAD
}
DI void final_norm(const Args& A, int tid, float* dst) {
    const int lane = tid & 63, wid = tid >> 6; const float* ssq = (const float*)(A.ws + WS_SSQ2); const float* gf = A.in[17];
    f32x4 gv[4];
#pragma unroll
    for (int j = 0; j < 4; ++j) gv[j] = *(const f32x4*)(gf + lane * 4 + 256 * j);
    for (int row = blockIdx.x * 8 + wid; row < NTOK; row += gridDim.x * 8) { float* xr = A.out + (size_t)row * DM; float* dr = dst + (size_t)row * DM; const float rs = rsqrtf(ssq[row] * (1.0f / 1024.0f) + EPS);
#pragma unroll
        for (int j = 0; j < 4; ++j) { const int o = lane * 4 + 256 * j; *(f32x4*)(dr + o) = *(const f32x4*)(xr + o) * rs * gv[j]; } }
}

__global__ void __launch_bounds__(512, 2) fwd_kernel(Args args) {
    extern __shared__ __attribute__((aligned(16))) unsigned char lds_raw[];
    LAS unsigned char* lds = (LAS unsigned char*)lds_raw;
    const int tid = threadIdx.x, lo = args.ph_lo, hi = args.ph_hi;
#define IN(k) (lo <= (k) && (k) < hi)
    volatile LAS unsigned* xst = (volatile LAS unsigned*)(lds + LDS_BYTES - 16);
    if (tid < 2) xst[tid] = 0u;
    __syncthreads();
    const XcdBarrier xbar = xcd_barrier_post((unsigned*)(args.ws + WS_BAR), xst);
    if (hi > NPH) cg::this_grid().sync();
#define SEAM(k) do { if (IN(k) && IN((k) + 1)) xcd_barrier(xbar); } while (0)
    if (IN(0)) { DUP(0) p0_prologue(args, lds, tid); } SEAM(0);
    if (IN(1)) { pg8::Gemm g{(const bf16*)(args.ws + WS_H), (const bf16*)(args.ws + WS_BT1), NTOK, N1, DM}; OrderG1 S; S.init(gridDim.x, blockIdx.x);
        Epi1 E{(bf16*)(args.ws + WS_P), (bf16*)(args.ws + WS_PU), (bf16*)(args.ws + WS_LR)};
        pg8::gemm_phase<Epi1, OrderG1, true, true, 10>(lds, g, S, E); } SEAM(1);
    if (IN(2)) { DUP(2) { gmlp_phase(args, lds, tid); __syncthreads(); } DUP(3) { gla_pass_a(args, lds, tid); } } SEAM(2);
    if (IN(3)) { gla_scan(args, lds, tid); if ((PROBE_DUP >> 9) & 1) { xcd_barrier(xbar); gla_pass_a(args, lds, tid); xcd_barrier(xbar); gla_scan(args, lds, tid); } } SEAM(3);
    if (IN(4)) { DUP(4) gla_pass_c(args, lds, tid); } SEAM(4);
    if (IN(5)) { pg8::Gemm g{(const bf16*)(args.ws + WS_Y), (const bf16*)(args.ws + WS_BT2), NTOK, DM, DM}; pg8::StaticOrder S; S.init(NTOK, DM, gridDim.x, blockIdx.x);
        EpiRes<0> E{(const float*)(args.ws + WS_XSC), (const bf16*)(args.ws + WS_H), args.in[1], (bf16*)(args.ws + WS_ST), (float*)(args.ws + WS_SSQ1)}; pg8::gemm_phase<EpiRes<0>, pg8::StaticOrder, true, true>(lds, g, S, E); } SEAM(5);
    if (IN(6)) { pg8::Gemm g{(const bf16*)(args.ws + WS_ST), (const bf16*)(args.ws + WS_BT3), NTOK, N3, DM}; pg8::StaticOrder S; S.init(NTOK, N3, gridDim.x, blockIdx.x);
        Epi3 E{(bf16*)(args.ws + WS_P), (const float*)(args.ws + WS_SSQ1)}; DUP(6) pg8::gemm_phase<Epi3, pg8::StaticOrder, true, true>(lds, g, S, E); } SEAM(6);
    if (IN(7)) { pg8::Gemm g{(const bf16*)(args.ws + WS_P), (const bf16*)(args.ws + WS_BT4), NTOK, DM, DFF}; pg8::StaticOrder S; S.init(NTOK, DM, gridDim.x, blockIdx.x);
        if (gridDim.x == 256) {
            EpiFinal E{(const bf16*)(args.ws + WS_ST), args.out, (float*)(args.ws + WS_SSQ2), (unsigned*)(args.ws + WS_CNT), args.in[17]}; pg8::gemm_phase<EpiFinal, pg8::StaticOrder, true, true>(lds, g, S, E); }
        else { EpiRes<1> E{nullptr, (const bf16*)(args.ws + WS_ST), (const float*)args.out, nullptr, (float*)(args.ws + WS_SSQ2)}; pg8::gemm_phase<EpiRes<1>, pg8::StaticOrder, true, true>(lds, g, S, E); } }
    if (gridDim.x != 256) SEAM(7);
    if (IN(8) && gridDim.x != 256) { final_norm(args, tid, args.out); }
#undef IN
#undef SEAM
}

extern "C" void kernel_launch(void* const* d_in, const int* in_sizes, int n_in, void* d_out, int out_size, void* d_ws, size_t ws_size, hipStream_t stream) {
    static int grid = 0;
    if (grid == 0) {
        if (n_in != 18 || out_size != NTOK * DM || ws_size < WS_END) { fprintf(stderr, "kernel_launch: unexpected shapes (n_in %d out %d ws %zu)\n", n_in, out_size, ws_size); grid = -1; return; }
        int dev = 0, cus = 0, per_cu = 0;
        hipGetDevice(&dev); hipDeviceGetAttribute(&cus, hipDeviceAttributeMultiprocessorCount, dev);
        if (hipFuncSetAttribute((const void*)fwd_kernel, hipFuncAttributeMaxDynamicSharedMemorySize, LDS_BYTES) != hipSuccess) { fprintf(stderr, "kernel_launch: hipFuncSetAttribute failed\n"); grid = -1; return; }
        if (hipOccupancyMaxActiveBlocksPerMultiprocessor(&per_cu, (const void*)fwd_kernel, 512, LDS_BYTES) != hipSuccess || per_cu < 1) { fprintf(stderr, "kernel_launch: occupancy query says %d\n", per_cu); per_cu = 1; }
        (void)hipGetLastError();
        grid = cus * 1;
        fprintf(stderr, "kernel_launch: grid %d (cus %d, per_cu %d)\n", grid, cus, per_cu);
    }
    if (grid < 0) return;
    Args a{};
    for (int i = 0; i < 18; ++i) a.in[i] = (const float*)d_in[i];
    a.out = (float*)d_out; a.ws = (unsigned char*)d_ws;
    if (hipMemsetAsync((char*)d_ws + WS_BAR, 0, WS_BAR_BYTES, stream) != hipSuccess) { fprintf(stderr, "kernel_launch: memset failed\n"); return; }
#if MK_N_LAUNCHES == 1
    a.ph_lo = 0; a.ph_hi = NPH;
    void* kargs[] = {&a};
    hipError_t e = hipLaunchCooperativeKernel((const void*)fwd_kernel, dim3(grid), dim3(512), kargs, LDS_BYTES, stream);
    if (e != hipSuccess) fprintf(stderr, "kernel_launch: cooperative launch failed: %s (grid %d)\n", hipGetErrorString(e), grid);
#else
    for (int ph = 0; ph < 9; ++ph) { a.ph_lo = ph; a.ph_hi = ph + 1; hipLaunchKernelGGL(fwd_kernel, dim3(grid), dim3(512), LDS_BYTES, stream, a); }
#endif
}
```

```cpp
#include <hip/hip_runtime.h>
#include <hip/hip_cooperative_groups.h>
#include <cstdio>
#include <cstdint>
namespace pg8 {
#define PG8_LAS __attribute__((address_space(3)))
typedef unsigned short bf16_t;
typedef short bf16x8 __attribute__((ext_vector_type(8)));
typedef float f32x4 __attribute__((ext_vector_type(4)));
typedef unsigned u32x4 __attribute__((ext_vector_type(4)));
constexpr int BM = 256, BK = 64, HALF = 128, HTB = HALF * BK * 2  , STAGE_BYTES = 8 * HTB, NXCD = 8, WGM = 8;

__host__ __device__ __forceinline__ int lds_byte(int r, int c) { const int st = (r >> 4) * 2 + (c >> 5), rr = r & 15, cc = c & 31, ob = rr * 64 + cc * 2; return st * 1024 + (ob ^ (((ob >> 9) & 1) << 5)); }
__host__ __device__ __forceinline__ void stage_rc(int b, int& R, int& C) { const int st = b / 1024, sb = b % 1024, swz = sb ^ (((sb >> 9) & 1) << 5); R = (st >> 1) * 16 + swz / 64; C = (st & 1) * 32 + (swz % 64) / 2; }
__host__ __device__ __forceinline__ int perm32(int rho) { const int n = rho >> 4, i = rho & 15; return 8 * (i >> 2) + 4 * n + (i & 3); }

struct Unit { int pm, pn; };
struct Gemm { const bf16_t* A; const bf16_t* Bt; int M, N, K; };

struct StaticOrder {
    int nM, nN, nwg, G, c, wgm;
    __host__ __device__ void init(int M, int N, int G_, int c_, int wgm_ = WGM) { nM = M / BM; nN = N / BM; nwg = nM * nN; G = G_; c = c_; wgm = wgm_; }
    __host__ __device__ bool next(int i, Unit& u) const {
        const long L = (long)i * G + c; if (L >= nwg) return false;
        int wgid = (int)L; { const int q = nwg / NXCD, r = nwg % NXCD, xcd = wgid % NXCD, off = wgid / NXCD; wgid = (xcd < r ? xcd * (q + 1) : r * (q + 1) + (xcd - r) * q) + off; }
        const int nig = wgm * nN, gid = wgid / nig, fm = gid * wgm, gsz = (nM - fm) < wgm ? (nM - fm) : wgm;
        u.pm = fm + ((wgid % nig) % gsz); u.pn = (wgid % nig) / gsz; return true;
    }
    __device__ __forceinline__ void a_ready(const Unit&) const {}
    __device__ __forceinline__ void done(const Unit&) const {}
};
__device__ __forceinline__ unsigned cvt_pk_bf16(float lo, float hi) { unsigned r; asm volatile("v_cvt_pk_bf16_f32 %0, %1, %2" : "=v"(r) : "v"(lo), "v"(hi)); return r; }
typedef float f32x2 __attribute__((ext_vector_type(2)));
__device__ __forceinline__ f32x2 gelu_pk(f32x2 v) {
    const f32x2 av = __builtin_elementwise_abs(v), d = av * 0.2316418882f + 1.0f;
    f32x2 t; t.x = __builtin_amdgcn_rcpf(d.x); t.y = __builtin_amdgcn_rcpf(d.y);
    f32x2 q = t * 0.5307027145f + (-0.7265760135f); q = q * t + 0.7107068705f; q = q * t + (-0.142248368f); q = q * t + 0.127414796f; q = q * t;
    const f32x2 s = (v * v) * (-0.72134752044f);
    f32x2 e; e.x = __builtin_amdgcn_exp2f(s.x); e.y = __builtin_amdgcn_exp2f(s.y);
    const f32x2 m = v * (q * e), r = v - m;
    f32x2 o; o.x = v.x < 0.f ? m.x : r.x; o.y = v.y < 0.f ? m.y : r.y; return o;
}
template <class Epi, class Sched, bool ALIGN_EPI = false, bool SP2 = false, int NARROW_PN = -1  >
__device__ __forceinline__ void gemm_phase(PG8_LAS unsigned char* lds, const Gemm g, const Sched& S, const Epi& E) {
    const int tid = threadIdx.x, wid = __builtin_amdgcn_readfirstlane(tid >> 6), lane = tid & 63, wr = wid >> 2, wc = wid & 3, fr = lane & 15, fq = lane >> 4;
    const int K = g.K, nt = K / BK;
    unsigned voffA[2], voffB[2];
#pragma unroll
    for (int i = 0; i < 2; ++i) { int R, C; stage_rc(tid * 16 + i * 8192, R, C); const int Rb = Epi::PERM ? ((R & ~31) + perm32(R & 31)) : R;
        voffA[i] = (unsigned)(R * K + C) * 2u; voffB[i] = (unsigned)(Rb * K + C) * 2u; }
    const size_t kstep = (size_t)(BK * 2);
    const size_t hstep = (size_t)HALF * K * 2;
    const size_t tstep = 2 * hstep;
    const unsigned ldsw = (unsigned)wid * 1024u;
    const int aoff = lds_byte(wr * 64 + fr, fq * 8), boff = lds_byte(wc * 32 + fr, fq * 8);
#define PG8_SA(b, h) (((b) * 2 + (h)) * HTB)
#define PG8_SB(b, h) ((4 + (b) * 2 + (h)) * HTB)
#define PG8_STAGE(bufoff, gbase, voff) do { _Pragma("unroll") for (int _i = 0; _i < 2; ++_i) \
        __builtin_amdgcn_global_load_lds((const unsigned*)((const char*)(gbase) + (voff)[_i]), (PG8_LAS unsigned*)(lds + (bufoff) + ldsw + _i * 8192), 16, 0, 0); } while (0)
#define PG8_LDA(dst, b, h) do { _Pragma("unroll") for (int m = 0; m < 4; ++m) _Pragma("unroll") for (int k = 0; k < 2; ++k) dst[m][k] = *(const PG8_LAS bf16x8*)(lds + PG8_SA(b, h) + aoff + m * 2048 + k * 1024); } while (0)
#define PG8_LDB(dst, b, h) do { _Pragma("unroll") for (int n = 0; n < 2; ++n) _Pragma("unroll") for (int k = 0; k < 2; ++k) dst[n][k] = *(const PG8_LAS bf16x8*)(lds + PG8_SB(b, h) + boff + n * 2048 + k * 1024); } while (0)
#define PG8_MMA(ai, bj, At, Bt) do { __builtin_amdgcn_s_setprio(1); _Pragma("unroll") for (int m = 0; m < 4; ++m) _Pragma("unroll") for (int n = 0; n < 2; ++n) _Pragma("unroll") for (int k = 0; k < 2; ++k) \
        acc[ai][bj][m][n] = __builtin_amdgcn_mfma_f32_16x16x32_bf16(Bt[n][k], At[m][k], acc[ai][bj][m][n], 0, 0, 0); __builtin_amdgcn_s_setprio(0); } while (0)
#define PG8_WAIT_V(n) asm volatile("s_waitcnt vmcnt(" #n ")" ::: "memory")
#define PG8_WAIT_L(n) asm volatile("s_waitcnt lgkmcnt(" #n ")" ::: "memory")
#define PG8_BAR __builtin_amdgcn_s_barrier()
#define PG8_SCHED __builtin_amdgcn_sched_barrier(0)
    Unit cur, nxt; int ui = 0;
    if (!S.next(0, cur)) return;
    f32x4 acc[2][2][4][2];
#pragma unroll
    for (int a = 0; a < 2; ++a)
#pragma unroll
        for (int b = 0; b < 2; ++b)
#pragma unroll
            for (int m = 0; m < 4; ++m)
#pragma unroll
                for (int n = 0; n < 2; ++n) acc[a][b][m][n] = (f32x4){0.f, 0.f, 0.f, 0.f};
    bf16x8 At[4][2], B0[2][2], B1[2][2];
    const char* cA = (const char*)g.A + (size_t)cur.pm * tstep; const char* cB = (const char*)g.Bt + (size_t)cur.pn * tstep;
    S.a_ready(cur);
    if constexpr (SP2) {
        PG8_STAGE(PG8_SB(0, 0), cB, voffB); PG8_STAGE(PG8_SB(0, 1), cB + hstep, voffB); PG8_STAGE(PG8_SA(0, 0), cA, voffA); PG8_STAGE(PG8_SA(0, 1), cA + hstep, voffA);
        if (wr == 1) PG8_BAR;
        PG8_WAIT_V(2); PG8_BAR;
        PG8_STAGE(PG8_SB(1, 0), cB + kstep, voffB); PG8_STAGE(PG8_SA(1, 0), cA + kstep, voffA); PG8_STAGE(PG8_SB(1, 1), cB + hstep + kstep, voffB);
        PG8_WAIT_V(6); PG8_BAR;
    } else {
        PG8_STAGE(PG8_SB(0, 0), cB, voffB); PG8_STAGE(PG8_SA(0, 0), cA, voffA); PG8_STAGE(PG8_SB(0, 1), cB + hstep, voffB); PG8_STAGE(PG8_SA(0, 1), cA + hstep, voffA);
        if (wr == 1) PG8_BAR;
        PG8_WAIT_V(4); PG8_BAR;
        PG8_STAGE(PG8_SB(1, 0), cB + kstep, voffB); PG8_STAGE(PG8_SA(1, 0), cA + kstep, voffA); PG8_STAGE(PG8_SB(1, 1), cB + hstep + kstep, voffB);
        PG8_WAIT_V(6); PG8_BAR;
    }
    for (;;) {
        const bool has_next = S.next(ui + 1, nxt); const bool narrow = (NARROW_PN >= 0) && (cur.pn == NARROW_PN);
        const char* nA = has_next ? (const char*)g.A + (size_t)nxt.pm * tstep : cA; const char* nB = has_next ? (const char*)g.Bt + (size_t)nxt.pn * tstep : cB;
        for (int t = 0; t < nt; t += 2) {
            const bool last = (t == nt - 2);
            const char* a1 = cA + (size_t)(t + 1) * kstep;
            const char* a2 = last ? nA : cA + (size_t)(t + 2) * kstep; const char* b2 = last ? nB : cB + (size_t)(t + 2) * kstep;
            const char* a3 = a2 + kstep; const char* b3 = b2 + kstep;
            if (last && has_next) S.a_ready(nxt);
            if constexpr (SP2) {
            PG8_LDB(B0, 0, 0); PG8_LDB(B1, 0, 1); PG8_SCHED; PG8_LDA(At, 0, 0); PG8_STAGE(PG8_SA(1, 1), a1 + hstep, voffA);
            PG8_WAIT_V(8); PG8_WAIT_L(0); PG8_BAR; PG8_MMA(0, 0, At, B0); if (NARROW_PN < 0 || !narrow) PG8_MMA(0, 1, At, B1); PG8_BAR; PG8_SCHED;
            PG8_LDA(At, 0, 1); PG8_STAGE(PG8_SB(0, 0), b2, voffB); PG8_STAGE(PG8_SB(0, 1), b2 + hstep, voffB); PG8_STAGE(PG8_SA(0, 0), a2, voffA);
            PG8_WAIT_V(8); PG8_WAIT_L(0); PG8_BAR; PG8_MMA(1, 0, At, B0); if (NARROW_PN < 0 || !narrow) PG8_MMA(1, 1, At, B1); PG8_BAR; PG8_SCHED;
            PG8_LDB(B0, 1, 0); PG8_LDB(B1, 1, 1); PG8_SCHED; PG8_LDA(At, 1, 0); PG8_STAGE(PG8_SA(0, 1), a2 + hstep, voffA);
            PG8_WAIT_V(8); PG8_WAIT_L(0); PG8_BAR; PG8_MMA(0, 0, At, B0); if (NARROW_PN < 0 || !narrow) PG8_MMA(0, 1, At, B1); PG8_BAR; PG8_SCHED;
            PG8_LDA(At, 1, 1); PG8_STAGE(PG8_SB(1, 0), b3, voffB); PG8_STAGE(PG8_SB(1, 1), b3 + hstep, voffB); PG8_STAGE(PG8_SA(1, 0), a3, voffA);
            PG8_WAIT_V(8); PG8_WAIT_L(0); PG8_BAR; PG8_MMA(1, 0, At, B0); if (NARROW_PN < 0 || !narrow) PG8_MMA(1, 1, At, B1); PG8_BAR; PG8_SCHED;
            } else {
            PG8_LDB(B0, 0, 0); PG8_SCHED; PG8_LDA(At, 0, 0); PG8_STAGE(PG8_SA(1, 1), a1 + hstep, voffA);
            PG8_WAIT_L(8); PG8_BAR; PG8_WAIT_L(0); PG8_MMA(0, 0, At, B0); PG8_BAR; PG8_SCHED;
            PG8_LDB(B1, 0, 1); PG8_STAGE(PG8_SB(0, 0), b2, voffB);
            PG8_BAR; PG8_WAIT_L(0); PG8_MMA(0, 1, At, B1); PG8_BAR;
            PG8_LDA(At, 0, 1); PG8_STAGE(PG8_SA(0, 0), a2, voffA);
            PG8_BAR; PG8_WAIT_L(0); PG8_MMA(1, 0, At, B0); PG8_BAR; PG8_SCHED;
            PG8_STAGE(PG8_SB(0, 1), b2 + hstep, voffB);
            PG8_WAIT_V(6); PG8_BAR; PG8_MMA(1, 1, At, B1); PG8_BAR;
            PG8_LDB(B0, 1, 0); PG8_SCHED; PG8_LDA(At, 1, 0); PG8_STAGE(PG8_SA(0, 1), a2 + hstep, voffA);
            PG8_WAIT_L(8); PG8_BAR; PG8_WAIT_L(0); PG8_MMA(0, 0, At, B0); PG8_BAR; PG8_SCHED;
            PG8_LDB(B1, 1, 1); PG8_STAGE(PG8_SB(1, 0), b3, voffB);
            PG8_BAR; PG8_WAIT_L(0); PG8_MMA(0, 1, At, B1); PG8_BAR;
            PG8_LDA(At, 1, 1); PG8_STAGE(PG8_SA(1, 0), a3, voffA);
            PG8_BAR; PG8_WAIT_L(0); PG8_MMA(1, 0, At, B0); PG8_BAR; PG8_SCHED;
            PG8_STAGE(PG8_SB(1, 1), b3 + hstep, voffB);
            PG8_WAIT_V(6); PG8_BAR; PG8_MMA(1, 1, At, B1); PG8_BAR;
            }
        }
        if constexpr (ALIGN_EPI) { if (wr == 0) PG8_BAR; }
        if constexpr (!Epi::AFTER_DRAIN) { E(acc, cur, wr, wc, fr, fq); S.done(cur); }
        if (!has_next) break;
#pragma unroll
        for (int a = 0; a < 2; ++a)
#pragma unroll
            for (int b = 0; b < 2; ++b)
#pragma unroll
                for (int m = 0; m < 4; ++m)
#pragma unroll
                    for (int n = 0; n < 2; ++n) acc[a][b][m][n] = (f32x4){0.f, 0.f, 0.f, 0.f};
        cur = nxt; cA = nA; cB = nB; ++ui;
        if constexpr (ALIGN_EPI) { if (wr == 1) PG8_BAR; }
    }
    PG8_WAIT_V(0);
    if constexpr (!ALIGN_EPI) { if (wr == 0) PG8_BAR; }
    PG8_BAR;
    if constexpr (Epi::AFTER_DRAIN) { E.fused(acc, cur, wr, wc, fr, fq, lds, wid, lane); S.done(cur); }
#undef PG8_SA
#undef PG8_SB
#undef PG8_STAGE
#undef PG8_LDA
#undef PG8_LDB
#undef PG8_MMA
#undef PG8_WAIT_V
#undef PG8_WAIT_L
#undef PG8_BAR
#undef PG8_SCHED
}
}

namespace cg = cooperative_groups;
#define LAS __attribute__((address_space(3)))
#define DI __device__ __forceinline__
typedef unsigned short bf16;
typedef short bf16x8 __attribute__((ext_vector_type(8)));
typedef float f32x4 __attribute__((ext_vector_type(4)));
typedef unsigned u32x4 __attribute__((ext_vector_type(4)));
typedef unsigned u32x2 __attribute__((ext_vector_type(2)));

#ifndef MK_N_LAUNCHES
#define MK_N_LAUNCHES 1
#endif
#define PROBE_DUP 0
#define DUP(bit) for (int rep_ = 0; rep_ < (((PROBE_DUP) >> (bit)) & 1) + 1; ++rep_)
constexpr int NPH = 10;
constexpr int NTOK = 32768, DM = 1024, PWSRC = 2592, N1 = 2816, PHS = 384, PUS = 1024, DFF = 2816, N3 = 5632;
constexpr float EPS = 1e-6f;
constexpr size_t MiB = 1u << 20;
constexpr size_t WS_SSQ1 = 0, WS_SSQ2 = 128 * 1024, WS_XSC = 256 * 1024, WS_WSB = 1 * MiB, WS_RSW = 1 * MiB + 256 * 1024, WS_BT1 = 2 * MiB, WS_BT2 = 8 * MiB, WS_BT3 = 10 * MiB, WS_BT4 = 21 * MiB,
                 WS_DEC = 27 * MiB, WS_LR = 28 * MiB, WS_H = 32 * MiB  , WS_ST = 96 * MiB  ,
                 WS_P = 160 * MiB  , WS_Y = 336 * MiB  , WS_END = 400 * MiB;
constexpr size_t WS_BAR = 512 * 1024, WS_CNT = WS_BAR + 16384, WS_BAR_BYTES = 16384 + 32768;
constexpr size_t WS_PU = WS_P + (size_t)4 * NTOK * PHS * 2;
constexpr int LDS_BYTES = 151552;

typedef float f32x2_t __attribute__((ext_vector_type(2))); typedef __bf16 bf16x2_t __attribute__((ext_vector_type(2)));
DI unsigned pk2(float lo, float hi) { f32x2_t v = {lo, hi}; bf16x2_t b = __builtin_convertvector(v, bf16x2_t); return __builtin_bit_cast(unsigned, b); }
DI float bflo(unsigned u) { return __uint_as_float(u << 16); }
DI float bfhi(unsigned u) { return __uint_as_float(u & 0xffff0000u); }
DI float silu_f(float g) { return g * __builtin_amdgcn_rcpf(1.0f + __expf(-g)); }
DI float logsig(float z) { return fminf(z, 0.f) - __logf(1.0f + __expf(-fabsf(z))); }
DI void lds_barrier() { asm volatile("s_waitcnt lgkmcnt(0)" ::: "memory"); __builtin_amdgcn_s_barrier(); asm volatile("" ::: "memory"); }
DI bf16x8 lds_frag(LAS const unsigned char* p) { return *(LAS const bf16x8*)p; }
DI f32x4 mfma16(bf16x8 a, bf16x8 b, f32x4 c) { return __builtin_amdgcn_mfma_f32_16x16x32_bf16(a, b, c, 0, 0, 0); }

#define XB_TMO      128
#define XB_XCNT(j)  (256  + 64 * (j))
#define XB_XSUB(j)  (1280 + 64 * (j))
#define XB_XGEN(j)  (2304 + 64 * (j))
#define XB_TOP      3328
#define XB_TOPGEN   3392
#define XCD_BAR_WORDS 3456
#define XB_SPIN_CAP (1u << 18)

__device__ __forceinline__ unsigned xb_ld(unsigned* p)              { return __hip_atomic_load(p, __ATOMIC_RELAXED, __HIP_MEMORY_SCOPE_AGENT); }
__device__ __forceinline__ unsigned xb_add(unsigned* p, unsigned v) { return __hip_atomic_fetch_add(p, v, __ATOMIC_RELAXED, __HIP_MEMORY_SCOPE_AGENT); }
__device__ __forceinline__ unsigned xb_xcc_id() { return (unsigned)__builtin_amdgcn_s_getreg((3 << 11) | 20) & 0xFu; }
#define XB_SPIN(cond, bar) do { unsigned _sp = 0; while (cond) { __builtin_amdgcn_s_sleep(1); \
    if ((++_sp & 255u) == 0u) { if (xb_ld(&(bar)[XB_TMO])) break; if (_sp > XB_SPIN_CAP) { atomicAdd(&(bar)[XB_TMO], 1u); break; } } } } while (0)

struct XcdBarrier {
    unsigned* bar; unsigned x;
    volatile LAS unsigned* st;
};

__device__ __forceinline__ XcdBarrier xcd_barrier_post(unsigned* bar, volatile LAS unsigned* st) {
    XcdBarrier b; b.bar = bar; b.x = xb_xcc_id(); b.st = st;
    if (threadIdx.x == 0) (void)xb_add(&bar[XB_XCNT(b.x)], 1u);
    return b;
}
__device__ __forceinline__ void xcd_barrier_complete(unsigned* bar, unsigned x, unsigned& nloc, unsigned& nx) {
    const unsigned G = gridDim.x * gridDim.y * gridDim.z;
    unsigned sum, cnt, mine, sp = 0u;
    for (;;) {
        sum = 0u; cnt = 0u; mine = 0u;
#pragma unroll
        for (unsigned j = 0; j < 16; ++j) { const unsigned c = xb_ld(&bar[XB_XCNT(j)]); sum += c; cnt += (c > 0u) ? 1u : 0u; mine = (j == x) ? c : mine; }
        if (sum == G) break;
        __builtin_amdgcn_s_sleep(1);
        if ((++sp & 255u) == 0u) { if (xb_ld(&bar[XB_TMO])) break; if (sp > XB_SPIN_CAP) { atomicAdd(&bar[XB_TMO], 1u); break; } }
    }
    nloc = mine > 0u ? mine : 1u; nx = cnt > 0u ? cnt : 1u;
}

__device__ __forceinline__ void xcd_barrier(const XcdBarrier& b) {
    asm volatile("s_waitcnt vmcnt(0)" ::: "memory");
    __syncthreads();
    if (threadIdx.x == 0) {
        unsigned* bar = b.bar;
        __builtin_amdgcn_s_waitcnt(0);
        unsigned nloc = b.st[0], nx = b.st[1];
        if (nloc == 0u) { xcd_barrier_complete(bar, b.x, nloc, nx); b.st[0] = nloc; b.st[1] = nx; }
        const unsigned old = xb_add(&bar[XB_XSUB(b.x)], 1u);
        const unsigned gen = old / nloc;
        if (old + 1u == (gen + 1u) * nloc) {
            __builtin_amdgcn_fence(__ATOMIC_RELEASE, "agent");
            asm volatile("s_waitcnt vmcnt(0)" ::: "memory");
            const unsigned og = xb_add(&bar[XB_TOP], 1u);
            const unsigned tg = og / nx;
            if (og + 1u == (tg + 1u) * nx) xb_add(&bar[XB_TOPGEN], 1u);
            else XB_SPIN(xb_ld(&bar[XB_TOPGEN]) == tg, bar);
            __builtin_amdgcn_fence(__ATOMIC_ACQUIRE, "agent");
            xb_add(&bar[XB_XGEN(b.x)], 1u);
            asm volatile("s_waitcnt vmcnt(0)" ::: "memory");
        } else {
            XB_SPIN(xb_ld(&bar[XB_XGEN(b.x)]) == gen, bar);
            __builtin_amdgcn_fence(__ATOMIC_ACQUIRE, "agent");
            asm volatile("s_waitcnt vmcnt(0)" ::: "memory");
        }
    }
    __syncthreads();
}

struct OrderG1 { pg8::StaticOrder full, all; bool special; int c;
    __device__ void init(int G, int c_) { special = (G == 256); c = c_; full.init(NTOK, 2560, G, c_, 4); all.init(NTOK, N1, G, c_); }
    __device__ bool next(int i, pg8::Unit& u) const { if (!special) return all.next(i, u); if (i < 5) return full.next(i, u); if (i == 5 && c < 128) { u.pm = c; u.pn = 10; return true; } return false; }
    __device__ __forceinline__ void a_ready(const pg8::Unit&) const {}
    __device__ __forceinline__ void done(const pg8::Unit&) const {}
};
struct Args { const float* in[18]; float* out; unsigned char* ws; int ph_lo, ph_hi; };

struct Epi1 {
    static constexpr bool PERM = true, AFTER_DRAIN = false;
    bf16* P; bf16* PU; bf16* LR;
    DI void operator()(const f32x4 (&acc)[2][2][4][2], const pg8::Unit& u, int wr, int wc, int fr, int fq) const {
        const int row0 = u.pm * 256 + wr * 64 + fr;
        if (u.pn == 10) {
            if (wc == 0) {
#pragma unroll
                for (int ai = 0; ai < 2; ++ai)
#pragma unroll
                    for (int m = 0; m < 4; ++m) { bf16* p = LR + (size_t)(row0 + ai * 128 + m * 16) * 64 + (fq >> 1) * 32 + (fq & 1) * 8; u32x4 hv, lv;
#pragma unroll
                        for (int e = 0; e < 4; ++e) { const float x0 = acc[ai][0][m][e >> 1][(e & 1) * 2], x1 = acc[ai][0][m][e >> 1][(e & 1) * 2 + 1]; const unsigned hp = pk2(x0, x1);
                            hv[e] = hp; lv[e] = pk2(x0 - bflo(hp), x1 - bfhi(hp)); }
                        *(u32x4*)p = hv; *(u32x4*)(p + 16) = lv; }
            }
            return;
        }
        const bool act = u.pn >= 6;
        const int col0 = u.pn * 256 + wc * 32 + 8 * fq;
#pragma unroll
        for (int ai = 0; ai < 2; ++ai)
#pragma unroll
            for (int m = 0; m < 4; ++m) { const int row = row0 + ai * 128 + m * 16;
#pragma unroll
                for (int bj = 0; bj < 2; ++bj) { const int col = col0 + bj * 128;
                    bf16* dst = act ? PU + (size_t)row * PUS + (col - 1536) : P + ((size_t)(col / 384) * NTOK + row) * PHS + col % 384;
                    f32x4 v0 = acc[ai][bj][m][0], v1 = acc[ai][bj][m][1];
                    if (act) { pg8::f32x2 a = pg8::gelu_pk((pg8::f32x2){v0[0], v0[1]}), b = pg8::gelu_pk((pg8::f32x2){v0[2], v0[3]}), c = pg8::gelu_pk((pg8::f32x2){v1[0], v1[1]}), d = pg8::gelu_pk((pg8::f32x2){v1[2], v1[3]});
                        v0 = (f32x4){a.x, a.y, b.x, b.y}; v1 = (f32x4){c.x, c.y, d.x, d.y}; }
                    u32x4 w; w.x = pk2(v0[0], v0[1]); w.y = pk2(v0[2], v0[3]); w.z = pk2(v1[0], v1[1]); w.w = pk2(v1[2], v1[3]);
                    *(u32x4*)dst = w; } }
    }
};
template <int MODE> struct EpiRes {
    static constexpr bool PERM = true, AFTER_DRAIN = false;
    const float* xsc; const bf16* baseb; const float* aux  ; bf16* ob; float* ssq;
    DI void operator()(const f32x4 (&acc)[2][2][4][2], const pg8::Unit& u, int wr, int wc, int fr, int fq) const {
        const int row0 = u.pm * 256 + wr * 64 + fr, col0 = u.pn * 256 + wc * 32 + 8 * fq;
        f32x4 gi[2][2];
        if (MODE == 0) {
#pragma unroll
            for (int bj = 0; bj < 2; ++bj)
#pragma unroll
                for (int n = 0; n < 2; ++n) { const f32x4 gq = *(const f32x4*)(aux + col0 + bj * 128 + n * 4); gi[bj][n] = (f32x4){1.0f / gq[0], 1.0f / gq[1], 1.0f / gq[2], 1.0f / gq[3]}; } }
#pragma unroll
        for (int ai = 0; ai < 2; ++ai) {
            u32x4 bw[4][2]; float sc[4];
#pragma unroll
            for (int m = 0; m < 4; ++m) { if (MODE == 0) sc[m] = xsc[row0 + ai * 128 + m * 16];
#pragma unroll
                for (int bj = 0; bj < 2; ++bj) bw[m][bj] = *(const u32x4*)(baseb + (size_t)(row0 + ai * 128 + m * 16) * DM + col0 + bj * 128); }
#pragma unroll
            for (int m = 0; m < 4; ++m) { const int row = row0 + ai * 128 + m * 16; float s = 0.f;
#pragma unroll
                for (int bj = 0; bj < 2; ++bj) { const size_t o = (size_t)row * DM + col0 + bj * 128; const u32x4 w = bw[m][bj];
                    f32x4 v0 = (f32x4){bflo(w.x), bfhi(w.x), bflo(w.y), bfhi(w.y)}, v1 = (f32x4){bflo(w.z), bfhi(w.z), bflo(w.w), bfhi(w.w)};
                    if (MODE == 0) { v0 = v0 * sc[m] * gi[bj][0]; v1 = v1 * sc[m] * gi[bj][1]; }
                    v0 = v0 + acc[ai][bj][m][0]; v1 = v1 + acc[ai][bj][m][1];
                    s += ((v0[0] * v0[0] + v0[1] * v0[1]) + (v0[2] * v0[2] + v0[3] * v0[3])) + ((v1[0] * v1[0] + v1[1] * v1[1]) + (v1[2] * v1[2] + v1[3] * v1[3]));
                    if (MODE == 0) { u32x4 wo; wo.x = pk2(v0[0], v0[1]); wo.y = pk2(v0[2], v0[3]); wo.z = pk2(v1[0], v1[1]); wo.w = pk2(v1[2], v1[3]); *(u32x4*)(ob + o) = wo; }
                    else { *(f32x4*)((float*)aux + o) = v0; *(f32x4*)((float*)aux + o + 4) = v1; } }
                s += __shfl_xor(s, 16); s += __shfl_xor(s, 32);
                if (fq == 0) atomicAdd(ssq + row, s); }
        }
    }
};
struct EpiFinal {
    static constexpr bool PERM = true, AFTER_DRAIN = false;
    const bf16* base; float* out; float* ssq; unsigned* cnt; const float* gf;
    DI void operator()(f32x4 (&acc)[2][2][4][2], const pg8::Unit& u, int wr, int wc, int fr, int fq) const {
        const int row0 = u.pm * 256 + wr * 64 + fr, col0 = u.pn * 256 + wc * 32 + 8 * fq;
        u32x4 bw[2][4][2];
#pragma unroll
        for (int ai = 0; ai < 2; ++ai)
#pragma unroll
            for (int m = 0; m < 4; ++m)
#pragma unroll
                for (int bj = 0; bj < 2; ++bj) bw[ai][m][bj] = *(const u32x4*)(base + (size_t)(row0 + ai * 128 + m * 16) * DM + col0 + bj * 128);
        f32x4 gv[2][2];
#pragma unroll
        for (int bj = 0; bj < 2; ++bj)
#pragma unroll
            for (int n = 0; n < 2; ++n) gv[bj][n] = *(const f32x4*)(gf + col0 + bj * 128 + n * 4);
#pragma unroll
        for (int ai = 0; ai < 2; ++ai)
#pragma unroll
            for (int m = 0; m < 4; ++m) { const int row = row0 + ai * 128 + m * 16; float s = 0.f;
#pragma unroll
                for (int bj = 0; bj < 2; ++bj) { const u32x4 w = bw[ai][m][bj];
                    const f32x4 v0 = (f32x4){bflo(w.x), bfhi(w.x), bflo(w.y), bfhi(w.y)} + acc[ai][bj][m][0], v1 = (f32x4){bflo(w.z), bfhi(w.z), bflo(w.w), bfhi(w.w)} + acc[ai][bj][m][1];
                    acc[ai][bj][m][0] = v0; acc[ai][bj][m][1] = v1;
                    s += ((v0[0] * v0[0] + v0[1] * v0[1]) + (v0[2] * v0[2] + v0[3] * v0[3])) + ((v1[0] * v1[0] + v1[1] * v1[1]) + (v1[2] * v1[2] + v1[3] * v1[3])); }
                s += __shfl_xor(s, 16); s += __shfl_xor(s, 32);
                if (fq == 0) atomicAdd(ssq + row, s); }
        asm volatile("s_waitcnt vmcnt(0)" ::: "memory");
        unsigned* c = cnt + 64 * u.pm;
        if (fr == 0 && fq == 0) __hip_atomic_fetch_add(c, 1u, __ATOMIC_RELAXED, __HIP_MEMORY_SCOPE_AGENT);
        { unsigned sp = 0; while ((unsigned)__builtin_amdgcn_readfirstlane(__hip_atomic_load(c, __ATOMIC_RELAXED, __HIP_MEMORY_SCOPE_AGENT)) < 32u) { __builtin_amdgcn_s_sleep(2); if (++sp > (1u << 22)) break; } }
        float sv[8];
#pragma unroll
        for (int i = 0; i < 8; ++i) sv[i] = __hip_atomic_load(ssq + row0 + (i >> 2) * 128 + (i & 3) * 16, __ATOMIC_RELAXED, __HIP_MEMORY_SCOPE_AGENT);
#pragma unroll
        for (int ai = 0; ai < 2; ++ai)
#pragma unroll
            for (int m = 0; m < 4; ++m) { const int row = row0 + ai * 128 + m * 16; const float rs = rsqrtf(sv[ai * 4 + m] * (1.0f / 1024.0f) + EPS);
#pragma unroll
                for (int bj = 0; bj < 2; ++bj)
#pragma unroll
                    for (int n = 0; n < 2; ++n) *(f32x4*)(out + (size_t)row * DM + col0 + bj * 128 + n * 4) = acc[ai][bj][m][n] * rs * gv[bj][n]; }
    }
};
struct Epi3 {
    static constexpr bool PERM = true, AFTER_DRAIN = false;
    bf16* ACT; const float* ssq;
    DI void operator()(const f32x4 (&acc)[2][2][4][2], const pg8::Unit& u, int wr, int wc, int fr, int fq) const {
        const int row0 = u.pm * 256 + wr * 64 + fr, col0 = u.pn * 128 + wc * 32 + 8 * fq;
        float sv[8];
#pragma unroll
        for (int i = 0; i < 8; ++i) sv[i] = ssq[row0 + (i >> 2) * 128 + (i & 3) * 16];
#pragma unroll
        for (int ai = 0; ai < 2; ++ai)
#pragma unroll
            for (int m = 0; m < 4; ++m) { const int row = row0 + ai * 128 + m * 16; const float rs = rsqrtf(sv[ai * 4 + m] * (1.0f / 1024.0f) + EPS);
                float o[8];
#pragma unroll
                for (int n = 0; n < 2; ++n)
#pragma unroll
                    for (int e = 0; e < 4; ++e) o[n * 4 + e] = silu_f(acc[ai][0][m][n][e] * rs) * (acc[ai][1][m][n][e] * rs);
                u32x4 w; w.x = pk2(o[0], o[1]); w.y = pk2(o[2], o[3]); w.z = pk2(o[4], o[5]); w.w = pk2(o[6], o[7]);
                *(u32x4*)(ACT + (size_t)row * DFF + col0) = w; }
    }
};

DI void p0_item(const Args& A, int it, LAS float* scr, int tid) {
    int mat, ntile, kt;
    if (it < 704) { mat = 1; ntile = it >> 4; kt = it & 15; }
    else if (it < 960) { it -= 704; mat = 2; ntile = it >> 4; kt = it & 15; }
    else if (it < 2368) { it -= 960; mat = 3; ntile = it >> 4; kt = it & 15; }
    else { it -= 2368; mat = 4; ntile = it / 44; kt = it % 44; }
    const int kl = tid >> 3, n8 = tid & 7, nd = ntile * 64 + n8 * 8, k = kt * 64 + kl;
    const float* src = nullptr; int ldw = 0, sc = 0; float scale = 1.f; bf16* dst; int K = 1024;
    if (mat == 1) { ldw = PWSRC; dst = (bf16*)(A.ws + WS_BT1);
        if (nd < 1536) { const int hh = nd / 384, c = nd % 384; sc = c < 64 ? hh * 64 + c : (c < 128 ? 256 + hh * 64 + (c - 64) : (c < 256 ? 512 + hh * 128 + (c - 128) : 1024 + hh * 128 + (c - 256))); if (c < 64) scale = 0.125f; }
        else if (nd < 2560) sc = nd + 32; else if (nd < 2592) sc = nd - 2560 + 1536; else sc = -1;
        if (sc >= 0) src = A.in[2]; }
    else if (mat == 2) { ldw = 1024; dst = (bf16*)(A.ws + WS_BT2); sc = nd; src = A.in[12]; }
    else if (mat == 3) { ldw = DFF; dst = (bf16*)(A.ws + WS_BT3); const int tl = nd >> 8, r = nd & 255; if (r < 128) { src = A.in[14]; sc = tl * 128 + r; } else { src = A.in[15]; sc = tl * 128 + r - 128; } scale = A.in[13][k]; }
    else { ldw = 1024; dst = (bf16*)(A.ws + WS_BT4); sc = nd; src = A.in[16]; K = DFF; }
    f32x4 a = (f32x4){0.f, 0.f, 0.f, 0.f}, b = a;
    if (src) { const float* p = src + (size_t)k * ldw + sc; a = *(const f32x4*)p * scale; b = *(const f32x4*)(p + 4) * scale; }
    LAS float* w = scr + kl * 65 + n8 * 8;
    w[0] = a[0]; w[1] = a[1]; w[2] = a[2]; w[3] = a[3]; w[4] = b[0]; w[5] = b[1]; w[6] = b[2]; w[7] = b[3];
    __syncthreads();
    const int nl = tid >> 3, k8 = tid & 7; float v[8];
#pragma unroll
    for (int j = 0; j < 8; ++j) v[j] = scr[(k8 * 8 + j) * 65 + nl];
    u32x4 o; o.x = pk2(v[0], v[1]); o.y = pk2(v[2], v[3]); o.z = pk2(v[4], v[5]); o.w = pk2(v[6], v[7]);
    *(u32x4*)(dst + (size_t)(ntile * 64 + nl) * K + kt * 64 + k8 * 8) = o;
    __syncthreads();
}
DI void p0_prologue(const Args& A, LAS unsigned char* lds, int tid) {
    const int G = gridDim.x, bx = blockIdx.x, lane = tid & 63, wid = tid >> 6;
    for (int i = bx * 512 + tid; i < 65536; i += G * 512) ((float*)(A.ws + WS_SSQ1))[i] = 0.f;
    for (int i = bx * 512 + tid; i < 65536; i += G * 512) { ((bf16*)(A.ws + WS_WSB))[i] = (bf16)(pk2(A.in[10][i], 0.f) & 0xffffu); }
    for (int i = bx * 512 + tid; i < 512; i += G * 512) { const float* w = A.in[10] + (size_t)i * 128; float r = 0.f;
        for (int j = 0; j < 128; j += 4) { const f32x4 v = *(const f32x4*)(w + j); r += (v[0] + v[1]) + (v[2] + v[3]); }
        ((float*)(A.ws + WS_RSW))[i] = r; }
    for (int it = bx; it < 3072; it += G) p0_item(A, it, (LAS float*)lds, tid);
    const float* x = A.in[0]; const float* g1 = A.in[1]; bf16* H = (bf16*)(A.ws + WS_H);
    f32x4 gv[4];
#pragma unroll
    for (int j = 0; j < 4; ++j) gv[j] = *(const f32x4*)(g1 + lane * 4 + 256 * j);
    for (int row = bx * 8 + wid; row < NTOK; row += G * 8) {
        const float* xr = x + (size_t)row * DM; f32x4 v[4]; float s = 0.f;
#pragma unroll
        for (int j = 0; j < 4; ++j) { v[j] = *(const f32x4*)(xr + lane * 4 + 256 * j); s += (v[j][0] * v[j][0] + v[j][1] * v[j][1]) + (v[j][2] * v[j][2] + v[j][3] * v[j][3]); }
#pragma unroll
        for (int o = 1; o < 64; o <<= 1) s += __shfl_xor(s, o);
        const float rs = rsqrtf(s * (1.0f / 1024.0f) + EPS);
        if (lane == 0) ((float*)(A.ws + WS_XSC))[row] = sqrtf(s * (1.0f / 1024.0f) + EPS);
#pragma unroll
        for (int j = 0; j < 4; ++j) { const f32x4 y = v[j] * rs * gv[j]; u32x2 w; w.x = pk2(y[0], y[1]); w.y = pk2(y[2], y[3]); *(u32x2*)(H + (size_t)row * DM + lane * 4 + 256 * j) = w; }
    }
}

constexpr int GM_VTS = 136, GM_PART = (128 * GM_VTS + 16) * 2  , GM_LN = 4 * GM_PART;
static_assert(GM_LN + 4096 <= 151552 - 16, "gMLP LDS map");
DI void gmlp_phase(const Args& A, LAS unsigned char* lds, int tid) {
    const int lane = tid & 63, wid = tid >> 6, fr = lane & 15, fq = lane >> 4;
    const bf16* PU = (const bf16*)(A.ws + WS_PU); bf16* Y = (bf16*)(A.ws + WS_Y); const bf16* WS = (const bf16*)(A.ws + WS_WSB); const float* RSW = (const float*)(A.ws + WS_RSW);
    const float* bsp = A.in[11];
    LAS float* LN = (LAS float*)(lds + GM_LN);
    for (int unit = blockIdx.x; unit < 256; unit += gridDim.x) {
        const int tok0 = (gridDim.x == 256 ? (unit & 7) * 32 + (unit >> 3) : unit) * 128, j = tid >> 2, part = tid & 3, irow = wid * 16 + fr;
        u32x4 w[16];
        { const bf16* p = PU + (size_t)(tok0 + j) * PUS + 512 + part * 128;
#pragma unroll
          for (int i = 0; i < 16; ++i) w[i] = *(const u32x4*)(p + i * 8); }
        bf16x8 wfn[4]; u32x4 uvn[4];
#define GM_LOADG(g_) do { _Pragma("unroll") for (int ks_ = 0; ks_ < 4; ++ks_) wfn[ks_] = *(const bf16x8*)(WS + (size_t)(g_) * 16384 + irow * 128 + ks_ * 32 + fq * 8); \
        _Pragma("unroll") for (int pp_ = 0; pp_ < 4; ++pp_) uvn[pp_] = *(const u32x4*)(PU + (size_t)(tok0 + irow) * PUS + (g_) * 128 + pp_ * 32 + 8 * fq); } while (0)
        lds_barrier();
        LN[tid] = A.in[8][tid]; LN[512 + tid] = A.in[9][tid];
        float sm = 0.f, sq = 0.f;
#pragma unroll
        for (int i = 0; i < 16; ++i)
#pragma unroll
            for (int e = 0; e < 4; ++e) { const float a = bflo(w[i][e]), b = bfhi(w[i][e]); sm += a + b; sq += a * a + b * b; }
        sm += __shfl_xor(sm, 1); sm += __shfl_xor(sm, 2); sq += __shfl_xor(sq, 1); sq += __shfl_xor(sq, 2);
        const float mean = sm * (1.0f / 512.0f), rstd = rsqrtf(fmaxf(sq * (1.0f / 512.0f) - mean * mean, 0.f) + EPS);
        LAS unsigned short* vt = (LAS unsigned short*)(lds + part * GM_PART) + j;
#pragma unroll
        for (int i = 0; i < 16; ++i)
#pragma unroll
            for (int e = 0; e < 4; ++e) { const unsigned pv = pk2((bflo(w[i][e]) - mean) * rstd, (bfhi(w[i][e]) - mean) * rstd); const int c = i * 8 + e * 2;
                vt[c * GM_VTS] = (unsigned short)(pv & 0xffffu); vt[(c + 1) * GM_VTS] = (unsigned short)(pv >> 16); }
        GM_LOADG(0);
        lds_barrier();
        for (int g = 0; g < 4; ++g) {
            bf16x8 wf[4]; u32x4 uv[4];
#pragma unroll
            for (int ks = 0; ks < 4; ++ks) wf[ks] = wfn[ks];
#pragma unroll
            for (int pp = 0; pp < 4; ++pp) uv[pp] = uvn[pp];
            if (g < 3) GM_LOADG(g + 1);
            const float bias = bsp[g * 128 + irow], rsw = RSW[g * 128 + irow];
#pragma unroll
            for (int pp = 0; pp < 4; ++pp) {
                f32x4 a0 = (f32x4){0.f, 0.f, 0.f, 0.f}, a1 = a0;
#pragma unroll
                for (int ks = 0; ks < 4; ++ks) { a0 = mfma16(lds_frag(lds + g * GM_PART + ((32 * pp + 8 * (fr >> 2) + (fr & 3)) * GM_VTS + ks * 32 + fq * 8) * 2), wf[ks], a0);
                    a1 = mfma16(lds_frag(lds + g * GM_PART + ((32 * pp + 8 * (fr >> 2) + 4 + (fr & 3)) * GM_VTS + ks * 32 + fq * 8) * 2), wf[ks], a1); }
                const int c = 32 * pp + 8 * fq; const u32x4 uu = uv[pp];
                const f32x4 lg0 = *(LAS const f32x4*)(LN + g * 128 + c), lg1 = *(LAS const f32x4*)(LN + g * 128 + c + 4), lb0 = *(LAS const f32x4*)(LN + 512 + g * 128 + c), lb1 = *(LAS const f32x4*)(LN + 512 + g * 128 + c + 4);
                u32x4 o; o.x = pk2(bflo(uu.x) * (lg0[0] * a0[0] + lb0[0] * rsw + bias), bfhi(uu.x) * (lg0[1] * a0[1] + lb0[1] * rsw + bias));
                o.y = pk2(bflo(uu.y) * (lg0[2] * a0[2] + lb0[2] * rsw + bias), bfhi(uu.y) * (lg0[3] * a0[3] + lb0[3] * rsw + bias));
                o.z = pk2(bflo(uu.z) * (lg1[0] * a1[0] + lb1[0] * rsw + bias), bfhi(uu.z) * (lg1[1] * a1[1] + lb1[1] * rsw + bias));
                o.w = pk2(bflo(uu.w) * (lg1[2] * a1[2] + lb1[2] * rsw + bias), bfhi(uu.w) * (lg1[3] * a1[3] + lb1[3] * rsw + bias));
                *(u32x4*)(Y + (size_t)(tok0 + irow) * DM + 512 + g * 128 + c) = o; }
        }
#undef GM_LOADG
    }
}

constexpr int G_LR = 0, G_WD = 8192, G_BD = 16384, G_SEG = 16896, G_LA = 18944, G_A0 = 52224, RS72 = 72;
constexpr int GA_KTF = G_A0, GA_KTB = G_A0 + 9216, GA_VT = G_A0 + 18432;
constexpr int GC_QDF = G_A0, GC_QDB = G_A0 + 9216, GC_KDF = G_A0 + 18432, GC_KDB = G_A0 + 27648, GC_VT = G_A0 + 36864, GC_SS = GC_VT + 18432, GC_RS = GC_SS + 9216;
constexpr int GC_STF = 0, GC_STB = 132096;
static_assert(GC_RS + 512 <= 131072 && GC_STF + 18432 <= G_LA && GC_STB + 18432 <= 151552 - 16, "GLA LDS map");
struct DecayW { bf16x8 bh, bl; float bias; };
DI unsigned hi16(float x) { return pk2(x, 0.f) & 0xffffu; }
DI DecayW gla_decay_w(const Args& A, int h, int wid, int fr, int fq) {
    const int dir = wid >> 2, d = h * 64 + 16 * (wid & 3) + fr; const float* w = (dir ? A.in[5] : A.in[3]) + ((fq & 1) * 8) * 256 + d;
    DecayW o; unsigned hh[8], ll[8];
#pragma unroll
    for (int j = 0; j < 8; ++j) { const float x = w[j * 256]; hh[j] = hi16(x); ll[j] = (fq < 2) ? hi16(x - __uint_as_float(hh[j] << 16)) : 0u; }
    u32x4 a, b;
#pragma unroll
    for (int e = 0; e < 4; ++e) { a[e] = hh[2 * e] | (hh[2 * e + 1] << 16); b[e] = ll[2 * e] | (ll[2 * e + 1] << 16); }
    o.bh = __builtin_bit_cast(bf16x8, a); o.bl = __builtin_bit_cast(bf16x8, b); o.bias = (dir ? A.in[6] : A.in[4])[d];
    return o;
}
struct LrRows { bf16x8 v[4]; };
DI LrRows gla_load_lr(const bf16* LRg, int tok0, int wid, int fr, int fq) {
    LrRows o; const bf16* p = LRg + (size_t)(tok0 + fr) * 64 + (wid >> 2) * 32 + fq * 8;
#pragma unroll
    for (int tt = 0; tt < 4; ++tt) o.v[tt] = *(const bf16x8*)(p + tt * 1024);
    return o;
}
DI void gla_decay(LAS unsigned char* lds, const LrRows& L, const DecayW& W, int wid, int fr, int fq) {
    LAS float* LA = (LAS float*)(lds + G_LA); const int dir = wid >> 2, d = 16 * (wid & 3) + fr;
    float la[4][4], p[4][4], S[4], ex[4], tot[4];
#pragma unroll
    for (int tt = 0; tt < 4; ++tt) {
        const bf16x8 a1 = L.v[tt]; const bf16x8 a2 = (fq < 2) ? a1 : (bf16x8){0, 0, 0, 0, 0, 0, 0, 0};
        f32x4 z = (f32x4){0.f, 0.f, 0.f, 0.f};
        z = mfma16(a1, W.bh, z); z = mfma16(a2, W.bl, z);
#pragma unroll
        for (int r = 0; r < 4; ++r) la[tt][r] = logsig(z[r] + W.bias) * (1.0f / 16.0f);
        p[tt][0] = la[tt][0]; p[tt][1] = p[tt][0] + la[tt][1]; p[tt][2] = p[tt][1] + la[tt][2]; p[tt][3] = p[tt][2] + la[tt][3]; S[tt] = p[tt][3];
    }
#pragma unroll
    for (int tt = 0; tt < 4; ++tt) { const float s1 = __shfl_xor(S[tt], 16), s2 = __shfl_xor(S[tt], 32), s3 = __shfl_xor(s1, 32);
        tot[tt] = (S[tt] + s1) + (s2 + s3); ex[tt] = fq == 0 ? 0.f : (fq == 1 ? s1 : (fq == 2 ? s2 + s3 : s1 + s2 + s3)); }
    const float T = (tot[0] + tot[1]) + (tot[2] + tot[3]); float base = 0.f;
#pragma unroll
    for (int tt = 0; tt < 4; ++tt) {
#pragma unroll
        for (int r = 0; r < 4; ++r) { const float pre = base + ex[tt] + p[tt][r]; LA[(dir * 64 + 16 * tt + 4 * fq + r) * 65 + d] = dir ? (T - pre + la[tt][r]) : pre; }
        base += tot[tt]; }
    lds_barrier();
}
DI int vt_rot(int dv) { return 8 * ((dv >> 3) & 3); }
DI int kt_rot(int d) { return 4 * ((d >> 2) & 7); }
DI bf16x8 rot_frag(LAS const unsigned char* img, int row, int ks, int fq, int rot) { return *(LAS const bf16x8*)(img + row * (RS72 * 2) + (((16 * ks + 4 * fq) + rot) & 31) * 4); }
DI void gla_build_vt(const u32x4 a, const u32x4 b, LAS unsigned char* vtb, int tid) {
    const int sp = tid >> 4, dvb = tid & 15, col = (sp + vt_rot(dvb * 8)) & 31; LAS unsigned* vt = (LAS unsigned*)vtb;
#pragma unroll
    for (int e = 0; e < 4; ++e) { const int dv = dvb * 8 + 2 * e;
        vt[dv * (RS72 / 2) + col] = (a[e] & 0xffffu) | (b[e] << 16);
        vt[(dv + 1) * (RS72 / 2) + col] = (a[e] >> 16) | (b[e] & 0xffff0000u); }
}
DI int u_h(int un) { return gridDim.x == 256 ? ((un & 255) >> 3) & 3 : un & 3; }
DI int u_cn(int un) { return gridDim.x == 256 ? 64 * (un & 7) + ((un & 255) >> 5) + 8 * (un >> 8) : un >> 2; }
DI size_t st_off(int dir, int b, int h, int n) { return ((size_t)((dir * 4 + b) * 4 + h) * 128 + n) * 8192; }
DI void gla_pass_a(const Args& A, LAS unsigned char* lds, int tid) {
    const int lane = tid & 63, wid = tid >> 6, fr = lane & 15, fq = lane >> 4;
    const bf16* P = (const bf16*)(A.ws + WS_P); bf16* ST = (bf16*)(A.ws + WS_ST); float* DEC = (float*)(A.ws + WS_DEC);
    LAS float* LA = (LAS float*)(lds + G_LA);
    const bf16* LRg = (const bf16*)(A.ws + WS_LR); int h_loaded = -1; DecayW dw; dw.bh = (bf16x8){0,0,0,0,0,0,0,0}; dw.bl = dw.bh; dw.bias = 0.f;
    const int sp = tid >> 4, db = tid & 15;
    LrRows lrn; u32x2 k0n, k1n; u32x4 van, vbn;
#define GA_LOAD(un) do { const int h_ = u_h(un), tok_ = u_cn(un) * 64; lrn = gla_load_lr(LRg, tok_, wid, fr, fq); \
        const bf16* kp_ = P + ((size_t)h_ * NTOK + tok_ + 2 * sp) * PHS + 64 + db * 4; k0n = *(const u32x2*)kp_; k1n = *(const u32x2*)(kp_ + PHS); \
        const bf16* vp_ = P + ((size_t)h_ * NTOK + tok_ + 2 * sp) * PHS + 128 + db * 8; van = *(const u32x4*)vp_; vbn = *(const u32x4*)(vp_ + PHS); } while (0)
    if (blockIdx.x < 2048) GA_LOAD(blockIdx.x);
    for (int unit = blockIdx.x; unit < 2048; unit += gridDim.x) {
        const int h = u_h(unit), cn = u_cn(unit), b = cn >> 7, n = cn & 127;
        if (h != h_loaded) { dw = gla_decay_w(A, h, wid, fr, fq); h_loaded = h; }
        const LrRows lrc = lrn; const u32x2 k0 = k0n, k1 = k1n; const u32x4 va = van, vb = vbn;
        if (unit + (int)gridDim.x < 2048) GA_LOAD(unit + gridDim.x);
        gla_decay(lds, lrc, dw, wid, fr, fq);
        {
            const float kk0[4] = {bflo(k0.x), bfhi(k0.x), bflo(k0.y), bfhi(k0.y)}, kk1[4] = {bflo(k1.x), bfhi(k1.x), bflo(k1.y), bfhi(k1.y)};
#pragma unroll
            for (int dir = 0; dir < 2; ++dir) { LAS unsigned* kt = (LAS unsigned*)(lds + (dir ? GA_KTB : GA_KTF));
#pragma unroll
                for (int j = 0; j < 4; ++j) { const int d = db * 4 + j; const float be = LA[(dir * 64 + (dir ? 0 : 63)) * 65 + d];
                    const float e0 = __expf(be - LA[(dir * 64 + 2 * sp) * 65 + d]), e1 = __expf(be - LA[(dir * 64 + 2 * sp + 1) * 65 + d]);
                    kt[d * (RS72 / 2) + ((sp + kt_rot(d)) & 31)] = pk2(kk0[j] * e0, kk1[j] * e1); } }
            if (tid < 128) { const int dir = tid >> 6, d = tid & 63; DEC[((size_t)((dir * 4 + b) * 4 + h) * 128 + n) * 64 + d] = __expf(LA[(dir * 64 + (dir ? 0 : 63)) * 65 + d]); }
        }
        gla_build_vt(va, vb, lds + GA_VT, tid);
        lds_barrier();
        {
            const int dir = wid >> 2, dvt0 = (wid & 3) * 2; LAS const unsigned char* kt = lds + (dir ? GA_KTB : GA_KTF);
            bf16x8 yv[2][2];
#pragma unroll
            for (int dvi = 0; dvi < 2; ++dvi)
#pragma unroll
                for (int ks = 0; ks < 2; ++ks) yv[dvi][ks] = rot_frag(lds + GA_VT, (dvt0 + dvi) * 16 + fr, ks, fq, vt_rot((dvt0 + dvi) * 16 + fr));
            bf16* stp = ST + st_off(dir, b, h, n);
#pragma unroll
            for (int pp = 0; pp < 2; ++pp) {
                bf16x8 x[2][2];
#pragma unroll
                for (int nn = 0; nn < 2; ++nn)
#pragma unroll
                    for (int ks = 0; ks < 2; ++ks) { const int dkr = 32 * pp + 8 * (fr >> 2) + 4 * nn + (fr & 3); x[nn][ks] = rot_frag(kt, dkr, ks, fq, kt_rot(dkr)); }
#pragma unroll
                for (int dvi = 0; dvi < 2; ++dvi) { f32x4 a0 = (f32x4){0.f, 0.f, 0.f, 0.f}, a1 = a0;
                    a0 = mfma16(x[0][0], yv[dvi][0], a0); a0 = mfma16(x[0][1], yv[dvi][1], a0); a1 = mfma16(x[1][0], yv[dvi][0], a1); a1 = mfma16(x[1][1], yv[dvi][1], a1);
                    u32x4 w; w.x = pk2(a0[0], a0[1]); w.y = pk2(a0[2], a0[3]); w.z = pk2(a1[0], a1[1]); w.w = pk2(a1[2], a1[3]);
                    *(u32x4*)(stp + ((dvt0 + dvi) * 16 + fr) * 64 + 32 * pp + 8 * fq) = w; } }
        }
    }
    lds_barrier();
#undef GA_LOAD
}
DI void gla_scan(const Args& A, LAS unsigned char* lds, int tid) {
    unsigned* ST = (unsigned*)(A.ws + WS_ST); const float* DEC = (const float*)(A.ws + WS_DEC); LAS float* DL = (LAS float*)lds;
    for (int g0 = blockIdx.x * 512; g0 < 131072; g0 += gridDim.x * 512) {
        const int gt = g0 + tid, seq = g0 >> 12, e2 = gt & 4095, dir = seq >> 4, dk = (2 * e2) & 63;
        __syncthreads();
#pragma unroll
        for (int i = 0; i < 4; ++i) *(LAS f32x4*)(DL + (tid + 512 * i) * 4) = *(const f32x4*)(DEC + (size_t)seq * 8192 + (tid + 512 * i) * 4);
        __syncthreads();
        unsigned* sp = ST + (size_t)seq * 128 * 4096 + e2;
        float s0 = 0.f, s1 = 0.f;
        unsigned nx[32];
#pragma unroll
        for (int j = 0; j < 32; ++j) { const int n = dir ? 127 - j : j; nx[j] = __builtin_nontemporal_load(sp + (size_t)n * 4096); }
#pragma unroll 1
        for (int i0 = 0; i0 < 128; i0 += 32) {
            unsigned ds[32];
#pragma unroll
            for (int j = 0; j < 32; ++j) ds[j] = nx[j];
            if (i0 + 32 < 128) {
#pragma unroll
                for (int j = 0; j < 32; ++j) { const int n = dir ? 127 - (i0 + 32 + j) : i0 + 32 + j; nx[j] = __builtin_nontemporal_load(sp + (size_t)n * 4096); } }
#pragma unroll
            for (int j = 0; j < 32; ++j) { const int n = dir ? 127 - (i0 + j) : i0 + j; const float d0 = DL[n * 64 + dk], d1 = DL[n * 64 + dk + 1];
                sp[(size_t)n * 4096] = pk2(s0, s1); s0 = d0 * s0 + bflo(ds[j]); s1 = d1 * s1 + bfhi(ds[j]); }
        }
    }
}
DI void gla_pass_c(const Args& A, LAS unsigned char* lds, int tid) {
    const int lane = tid & 63, wid = tid >> 6, fr = lane & 15, fq = lane >> 4;
    const bf16* P = (const bf16*)(A.ws + WS_P); const bf16* ST = (const bf16*)(A.ws + WS_ST); bf16* Y = (bf16*)(A.ws + WS_Y);
    LAS float* LA = (LAS float*)(lds + G_LA); LAS float* RS = (LAS float*)(lds + GC_RS);
    const bf16* LRg = (const bf16*)(A.ws + WS_LR); int h_loaded = -1; DecayW dw; dw.bh = (bf16x8){0,0,0,0,0,0,0,0}; dw.bl = dw.bh; dw.bias = 0.f;
    const int t = tid >> 3, d8 = (tid & 7) * 8, vsp = tid >> 4, vdb = tid & 15, ott = wid & 3, odvh = wid >> 2, ot = ott * 16 + fr;
    LrRows lrn; u32x4 qn, kn, van, vbn, stn[4], ggn[2]; f32x4 ngv[4];
#pragma unroll
    for (int i = 0; i < 4; ++i) ngv[i] = (f32x4){0.f, 0.f, 0.f, 0.f};
#define GC_LOAD(un) do { const int h_ = u_h(un), cn_ = u_cn(un), tok_ = cn_ * 64; lrn = gla_load_lr(LRg, tok_, wid, fr, fq); \
        const bf16* qp_ = P + ((size_t)h_ * NTOK + tok_ + t) * PHS + d8; qn = *(const u32x4*)qp_; kn = *(const u32x4*)(qp_ + 64); \
        const bf16* vp_ = P + ((size_t)h_ * NTOK + tok_ + 2 * vsp) * PHS + 128 + vdb * 8; van = *(const u32x4*)vp_; vbn = *(const u32x4*)(vp_ + PHS); \
        _Pragma("unroll") for (int i_ = 0; i_ < 4; ++i_) { const int ci_ = tid + 512 * i_; stn[i_] = *(const u32x4*)(ST + st_off(ci_ >> 10, cn_ >> 7, h_, cn_ & 127) + (ci_ & 1023) * 8); } \
        _Pragma("unroll") for (int pp_ = 0; pp_ < 2; ++pp_) ggn[pp_] = *(const u32x4*)(P + ((size_t)h_ * NTOK + tok_ + ot) * PHS + 256 + odvh * 64 + 32 * pp_ + 8 * fq); } while (0)
    if (blockIdx.x < 2048) GC_LOAD(blockIdx.x);
    for (int unit = blockIdx.x; unit < 2048; unit += gridDim.x) {
        const int h = u_h(unit), cn = u_cn(unit), tok0 = cn * 64;
        if (h != h_loaded) { dw = gla_decay_w(A, h, wid, fr, fq); h_loaded = h;
#pragma unroll
            for (int dvi = 0; dvi < 4; ++dvi) ngv[dvi] = *(const f32x4*)(A.in[7] + h * 128 + odvh * 64 + 32 * (dvi >> 1) + 8 * fq + 4 * (dvi & 1)); }
        const LrRows lrc = lrn; const u32x4 q = qn, k = kn, va = van, vb = vbn; u32x4 stc[4]; const u32x4 gg[2] = {ggn[0], ggn[1]};
#pragma unroll
        for (int i = 0; i < 4; ++i) stc[i] = stn[i];
        if (unit + (int)gridDim.x < 2048) GC_LOAD(unit + gridDim.x);
        DUP(13) gla_decay(lds, lrc, dw, wid, fr, fq);
        DUP(10) {
#pragma unroll
            for (int dir = 0; dir < 2; ++dir) { u32x4 qo, ko;
#pragma unroll
                for (int e = 0; e < 4; ++e) { const float b0 = LA[(dir * 64 + t) * 65 + d8 + 2 * e], b1 = LA[(dir * 64 + t) * 65 + d8 + 2 * e + 1];
                    qo[e] = pk2(bflo(q[e]) * __expf(b0), bfhi(q[e]) * __expf(b1)); ko[e] = pk2(bflo(k[e]) * __expf(-b0), bfhi(k[e]) * __expf(-b1)); }
                *(LAS u32x4*)(lds + (dir ? GC_QDB : GC_QDF) + (t * RS72 + d8) * 2) = qo; *(LAS u32x4*)(lds + (dir ? GC_KDB : GC_KDF) + (t * RS72 + d8) * 2) = ko; }
        }
        gla_build_vt(va, vb, lds + GC_VT, tid);
#pragma unroll
        for (int i = 0; i < 4; ++i) { const int ci = tid + 512 * i, cc = ci & 1023; *(LAS u32x4*)(lds + ((ci >> 10) ? GC_STB : GC_STF) + ((cc >> 3) * RS72 + (cc & 7) * 8) * 2) = stc[i]; }
        lds_barrier();
        DUP(11) {
#pragma unroll
            for (int ti = 0; ti < 2; ++ti) { const int tile = wid * 2 + ti, tt = tile >> 2, st = tile & 3;
                f32x4 af = (f32x4){0.f, 0.f, 0.f, 0.f}, ab = af;
                if (st <= tt) {
#pragma unroll
                    for (int ks = 0; ks < 2; ++ks) af = mfma16(lds_frag(lds + GC_KDF + ((st * 16 + fr) * RS72 + ks * 32 + fq * 8) * 2), lds_frag(lds + GC_QDF + ((tt * 16 + fr) * RS72 + ks * 32 + fq * 8) * 2), af); }
                if (st >= tt) {
#pragma unroll
                    for (int ks = 0; ks < 2; ++ks) ab = mfma16(lds_frag(lds + GC_KDB + ((st * 16 + fr) * RS72 + ks * 32 + fq * 8) * 2), lds_frag(lds + GC_QDB + ((tt * 16 + fr) * RS72 + ks * 32 + fq * 8) * 2), ab); }
                const int t = tt * 16 + fr, s0 = st * 16 + 4 * fq; float v[4];
#pragma unroll
                for (int r = 0; r < 4; ++r) v[r] = ((s0 + r) <= t ? af[r] : 0.f) + ((s0 + r) >= t ? ab[r] : 0.f);
                u32x2 w; w.x = pk2(v[0], v[1]); w.y = pk2(v[2], v[3]);
                *(LAS u32x2*)(lds + GC_SS + (t * RS72 + s0) * 2) = w; }
        }
        lds_barrier();
        DUP(12) {
            const int tt = wid & 3, dvh = wid >> 2, t = tt * 16 + fr;
            bf16x8 yv[6];
#pragma unroll
            for (int ks = 0; ks < 2; ++ks) { yv[ks] = lds_frag(lds + GC_SS + (t * RS72 + ks * 32 + fq * 8) * 2); yv[2 + ks] = lds_frag(lds + GC_QDF + (t * RS72 + ks * 32 + fq * 8) * 2); yv[4 + ks] = lds_frag(lds + GC_QDB + (t * RS72 + ks * 32 + fq * 8) * 2); }
            f32x4 acc[4]; float q = 0.f;
#pragma unroll
            for (int dvi = 0; dvi < 4; ++dvi) { const int dvr = dvh * 64 + 32 * (dvi >> 1) + 8 * (fr >> 2) + 4 * (dvi & 1) + (fr & 3); f32x4 a = (f32x4){0.f, 0.f, 0.f, 0.f};
#pragma unroll
                for (int ks = 0; ks < 2; ++ks) { a = mfma16(rot_frag(lds + GC_VT, dvr, ks, fq, vt_rot(dvr)), yv[ks], a);
                    a = mfma16(lds_frag(lds + GC_STF + (dvr * RS72 + ks * 32 + fq * 8) * 2), yv[2 + ks], a); a = mfma16(lds_frag(lds + GC_STB + (dvr * RS72 + ks * 32 + fq * 8) * 2), yv[4 + ks], a); }
                acc[dvi] = a; q += (a[0] * a[0] + a[1] * a[1]) + (a[2] * a[2] + a[3] * a[3]); }
            q += __shfl_xor(q, 16); q += __shfl_xor(q, 32);
            if (fq == 0) RS[dvh * 64 + t] = q;
            lds_barrier();
            const float rn = rsqrtf((RS[t] + RS[64 + t]) * (1.0f / 128.0f) + EPS);
#pragma unroll
            for (int pp = 0; pp < 2; ++pp) { const int col = h * 128 + dvh * 64 + 32 * pp + 8 * fq; const u32x4 g4 = gg[pp];
                const f32x4 n0 = ngv[2 * pp], n1 = ngv[2 * pp + 1], a0 = acc[2 * pp], a1 = acc[2 * pp + 1];
                u32x4 w; w.x = pk2(a0[0] * rn * n0[0] * silu_f(bflo(g4.x)), a0[1] * rn * n0[1] * silu_f(bfhi(g4.x))); w.y = pk2(a0[2] * rn * n0[2] * silu_f(bflo(g4.y)), a0[3] * rn * n0[3] * silu_f(bfhi(g4.y)));
                w.z = pk2(a1[0] * rn * n1[0] * silu_f(bflo(g4.z)), a1[1] * rn * n1[1] * silu_f(bfhi(g4.z))); w.w = pk2(a1[2] * rn * n1[2] * silu_f(bflo(g4.w)), a1[3] * rn * n1[3] * silu_f(bfhi(g4.w)));
                *(u32x4*)(Y + (size_t)(tok0 + t) * DM + col) = w; }
        }
    }
    lds_barrier();
#undef GC_LOAD
}
DI void final_norm(const Args& A, int tid, float* dst) {
    const int lane = tid & 63, wid = tid >> 6; const float* ssq = (const float*)(A.ws + WS_SSQ2); const float* gf = A.in[17];
    f32x4 gv[4];
#pragma unroll
    for (int j = 0; j < 4; ++j) gv[j] = *(const f32x4*)(gf + lane * 4 + 256 * j);
    for (int row = blockIdx.x * 8 + wid; row < NTOK; row += gridDim.x * 8) { float* xr = A.out + (size_t)row * DM; float* dr = dst + (size_t)row * DM; const float rs = rsqrtf(ssq[row] * (1.0f / 1024.0f) + EPS);
#pragma unroll
        for (int j = 0; j < 4; ++j) { const int o = lane * 4 + 256 * j; *(f32x4*)(dr + o) = *(const f32x4*)(xr + o) * rs * gv[j]; } }
}

__global__ void __launch_bounds__(512, 2) fwd_kernel(Args args) {
    extern __shared__ __attribute__((aligned(16))) unsigned char lds_raw[];
    LAS unsigned char* lds = (LAS unsigned char*)lds_raw;
    const int tid = threadIdx.x, lo = args.ph_lo, hi = args.ph_hi;
#define IN(k) (lo <= (k) && (k) < hi)
    volatile LAS unsigned* xst = (volatile LAS unsigned*)(lds + LDS_BYTES - 16);
    if (tid < 2) xst[tid] = 0u;
    __syncthreads();
    const XcdBarrier xbar = xcd_barrier_post((unsigned*)(args.ws + WS_BAR), xst);
    if (hi > NPH) cg::this_grid().sync();
#define SEAM(k) do { if (IN(k) && IN((k) + 1)) xcd_barrier(xbar); } while (0)
    if (IN(0)) { DUP(0) p0_prologue(args, lds, tid); } SEAM(0);
    if (IN(1)) { pg8::Gemm g{(const bf16*)(args.ws + WS_H), (const bf16*)(args.ws + WS_BT1), NTOK, N1, DM}; OrderG1 S; S.init(gridDim.x, blockIdx.x);
        Epi1 E{(bf16*)(args.ws + WS_P), (bf16*)(args.ws + WS_PU), (bf16*)(args.ws + WS_LR)};
        pg8::gemm_phase<Epi1, OrderG1, true, true, 10>(lds, g, S, E); } SEAM(1);
    if (IN(2)) { DUP(2) { gmlp_phase(args, lds, tid); __syncthreads(); } DUP(3) { gla_pass_a(args, lds, tid); } } SEAM(2);
    if (IN(3)) { gla_scan(args, lds, tid); if ((PROBE_DUP >> 9) & 1) { xcd_barrier(xbar); gla_pass_a(args, lds, tid); xcd_barrier(xbar); gla_scan(args, lds, tid); } } SEAM(3);
    if (IN(4)) { DUP(4) gla_pass_c(args, lds, tid); } SEAM(4);
    if (IN(5)) { pg8::Gemm g{(const bf16*)(args.ws + WS_Y), (const bf16*)(args.ws + WS_BT2), NTOK, DM, DM}; pg8::StaticOrder S; S.init(NTOK, DM, gridDim.x, blockIdx.x);
        EpiRes<0> E{(const float*)(args.ws + WS_XSC), (const bf16*)(args.ws + WS_H), args.in[1], (bf16*)(args.ws + WS_ST), (float*)(args.ws + WS_SSQ1)}; pg8::gemm_phase<EpiRes<0>, pg8::StaticOrder, true, true>(lds, g, S, E); } SEAM(5);
    if (IN(6)) { pg8::Gemm g{(const bf16*)(args.ws + WS_ST), (const bf16*)(args.ws + WS_BT3), NTOK, N3, DM}; pg8::StaticOrder S; S.init(NTOK, N3, gridDim.x, blockIdx.x);
        Epi3 E{(bf16*)(args.ws + WS_P), (const float*)(args.ws + WS_SSQ1)}; DUP(6) pg8::gemm_phase<Epi3, pg8::StaticOrder, true, true>(lds, g, S, E); } SEAM(6);
    if (IN(7)) { pg8::Gemm g{(const bf16*)(args.ws + WS_P), (const bf16*)(args.ws + WS_BT4), NTOK, DM, DFF}; pg8::StaticOrder S; S.init(NTOK, DM, gridDim.x, blockIdx.x);
        if (gridDim.x == 256) {
            EpiFinal E{(const bf16*)(args.ws + WS_ST), args.out, (float*)(args.ws + WS_SSQ2), (unsigned*)(args.ws + WS_CNT), args.in[17]}; pg8::gemm_phase<EpiFinal, pg8::StaticOrder, true, true>(lds, g, S, E); }
        else { EpiRes<1> E{nullptr, (const bf16*)(args.ws + WS_ST), (const float*)args.out, nullptr, (float*)(args.ws + WS_SSQ2)}; pg8::gemm_phase<EpiRes<1>, pg8::StaticOrder, true, true>(lds, g, S, E); } }
    if (gridDim.x != 256) SEAM(7);
    if (IN(8) && gridDim.x != 256) { final_norm(args, tid, args.out); }
#undef IN
#undef SEAM
}

extern "C" void kernel_launch(void* const* d_in, const int* in_sizes, int n_in, void* d_out, int out_size, void* d_ws, size_t ws_size, hipStream_t stream) {
    static int grid = 0;
    if (grid == 0) {
        if (n_in != 18 || out_size != NTOK * DM || ws_size < WS_END) { fprintf(stderr, "kernel_launch: unexpected shapes (n_in %d out %d ws %zu)\n", n_in, out_size, ws_size); grid = -1; return; }
        int dev = 0, cus = 0, per_cu = 0;
        hipGetDevice(&dev); hipDeviceGetAttribute(&cus, hipDeviceAttributeMultiprocessorCount, dev);
        if (hipFuncSetAttribute((const void*)fwd_kernel, hipFuncAttributeMaxDynamicSharedMemorySize, LDS_BYTES) != hipSuccess) { fprintf(stderr, "kernel_launch: hipFuncSetAttribute failed\n"); grid = -1; return; }
        if (hipOccupancyMaxActiveBlocksPerMultiprocessor(&per_cu, (const void*)fwd_kernel, 512, LDS_BYTES) != hipSuccess || per_cu < 1) { fprintf(stderr, "kernel_launch: occupancy query says %d\n", per_cu); per_cu = 1; }
        (void)hipGetLastError();
        grid = cus * 1;
        fprintf(stderr, "kernel_launch: grid %d (cus %d, per_cu %d)\n", grid, cus, per_cu);
    }
    if (grid < 0) return;
    Args a{};
    for (int i = 0; i < 18; ++i) a.in[i] = (const float*)d_in[i];
    a.out = (float*)d_out; a.ws = (unsigned char*)d_ws;
    if (hipMemsetAsync((char*)d_ws + WS_BAR, 0, WS_BAR_BYTES, stream) != hipSuccess) { fprintf(stderr, "kernel_launch: memset failed\n"); return; }
#if MK_N_LAUNCHES == 1
    a.ph_lo = 0; a.ph_hi = NPH;
    void* kargs[] = {&a};
    hipError_t e = hipLaunchCooperativeKernel((const void*)fwd_kernel, dim3(grid), dim3(512), kargs, LDS_BYTES, stream);
    if (e != hipSuccess) fprintf(stderr, "kernel_launch: cooperative launch failed: %s (grid %d)\n", hipGetErrorString(e), grid);
#else
    for (int ph = 0; ph < 9; ++ph) { a.ph_lo = ph; a.ph_hi = ph + 1; hipLaunchKernelGGL(fwd_kernel, dim3(grid), dim3(512), LDS_BYTES, stream, a); }
#endif
}
```
